# Optimizing an MI355X kernel written in HIP

```python
import math
import jax, jax.numpy as jnp
from jax import lax
import numpy as np

D_MODEL = 2048
BATCH = 2
SEQ = 4096
DEPTH = 2

N_MIXERS = 2
A_HEADS = 8
A_HEAD_DIM = 128
A_V_DIM = 2 * A_HEAD_DIM
A_IN = 2 * A_HEADS * 2 * A_HEAD_DIM + A_HEADS * A_V_DIM
A_Q_BLOCK = 128
B_HEADS = 16
B_GROUPS = 4
B_HPG = B_HEADS // B_GROUPS
B_DK = 128
B_DV = 128
B_IN = B_HEADS * B_DK + 3 * B_GROUPS * (B_DK + B_DV) + 3 * B_HEADS
CMP_LEN = 32
CMP_STRIDE = 16
CMP_HID = 256
SLC_BLOCK = 64
SLC_TOPN = 16
WINDOW = 512
B_Q_BLOCK = 64
FORCE = 1e4
N_GROUPS = 4
EXPERTS_PER_GROUP = 8
N_EXPERTS = N_GROUPS * EXPERTS_PER_GROUP
TOP_K = 2
D_EXPERT = 1024
MOE_ROW_BLOCK = 128
EPS = 1e-6
NEG = -1e30

kernel_name = 'hybrid_diffattn_nsa_hmoe'


def rmsnorm(x, w):
    xf = x.astype(jnp.float32)
    y = xf * lax.rsqrt(jnp.mean(xf * xf, axis=-1, keepdims=True) + EPS)
    return (y * w.astype(jnp.float32)).astype(x.dtype)


def alibi_slopes(n):
    return jnp.asarray(np.array([2.0 ** (-8.0 * (i + 1) / n) for i in range(n)], dtype=np.float32))


def diff_attention(xn, w_in, lam, subln_w, w_out, lambda_init):
    B, S, _ = xn.shape
    H, dh = A_HEADS, A_HEAD_DIM
    qkv = xn @ w_in
    q, k, v = jnp.split(qkv, [H * 2 * dh, 2 * H * 2 * dh], axis=-1)
    q = q.reshape(B, S, H, 2, dh) * (dh ** -0.5)
    k = k.reshape(B, S, H, 2, dh)
    v = v.reshape(B, S, H, A_V_DIM)
    lf = lam.astype(jnp.float32)
    lmbda = jnp.exp(jnp.sum(lf[0] * lf[1])) - jnp.exp(jnp.sum(lf[2] * lf[3])) + lambda_init
    slopes = alibi_slopes(H)[:, None, None, None]
    kpos = jnp.arange(S)

    def q_block(i):
        start = i * A_Q_BLOCK
        qb = lax.dynamic_slice_in_dim(q, start, A_Q_BLOCK, axis=1)
        qpos = start + jnp.arange(A_Q_BLOCK)
        s = jnp.einsum('bqhcd,bkhcd->bhcqk', qb, k, preferred_element_type=jnp.float32)
        dist = (qpos[:, None] - kpos[None, :]).astype(jnp.float32)
        s = jnp.where(dist >= 0, s - slopes * dist, NEG)
        p = jax.nn.softmax(s, axis=-1)
        a = p[:, :, 0] - lmbda * p[:, :, 1]
        return jnp.einsum('bhqk,bkhv->bqhv', a.astype(v.dtype), v)

    o = lax.map(q_block, jnp.arange(S // A_Q_BLOCK))
    o = jnp.moveaxis(o, 0, 1).reshape(B, S, H, A_V_DIM)
    o = rmsnorm(o, subln_w) * (1.0 - lambda_init)
    return o.reshape(B, S, H * A_V_DIM) @ w_out


def nsa_attention(xn, w_in, cmp_pos, cmp_w1, cmp_w2, w_out):
    B, S, _ = xn.shape
    H, G, HPG, dk, dv = B_HEADS, B_GROUPS, B_HPG, B_DK, B_DV
    proj = xn @ w_in
    splits = np.cumsum([H * dk, G * dk, G * dv, G * dk, G * dv, G * dk, G * dv]).tolist()
    q, kc, vc, ks, vs, kw, vw, gate = jnp.split(proj, splits, axis=-1)
    q = q.reshape(B, S, G, HPG, dk) * (dk ** -0.5)
    kc, ks, kw = (t.reshape(B, S, G, dk) for t in (kc, ks, kw))
    vc, vs, vw = (t.reshape(B, S, G, dv) for t in (vc, vs, vw))
    gate = jax.nn.sigmoid(gate.astype(jnp.float32)).reshape(B, S, G, HPG, 3)
    slopes = alibi_slopes(H).reshape(G, HPG)[:, :, None, None]
    pos = jnp.arange(S)

    nc = (S - CMP_LEN) // CMP_STRIDE + 1
    blk_idx = np.arange(nc)[:, None] * CMP_STRIDE + np.arange(CMP_LEN)[None, :]

    def compress(t, pe, w1, w2):
        tb = t[:, blk_idx] + pe[None, None, :, None, :]
        tb = jnp.moveaxis(tb, 3, 2).reshape(B, nc, G, CMP_LEN * t.shape[-1])
        return jax.nn.gelu(tb @ w1) @ w2

    kcmp = compress(kc, cmp_pos[0], cmp_w1[0], cmp_w2[0])
    vcmp = compress(vc, cmp_pos[1], cmp_w1[1], cmp_w2[1])
    cmp_end = jnp.arange(nc) * CMP_STRIDE + CMP_LEN - 1
    s = jnp.einsum('bsghd,bcgd->bghsc', q, kcmp, preferred_element_type=jnp.float32)
    dist = (pos[:, None] - cmp_end[None, :]).astype(jnp.float32)
    valid = dist >= 0
    s = jnp.where(valid, s - slopes * dist, NEG)
    p_cmp = jax.nn.softmax(s, axis=-1) * jnp.any(valid, axis=-1)[:, None]
    o_cmp = jnp.einsum('bghsc,bcgd->bsghd', p_cmp.astype(vcmp.dtype), vcmp)

    nsb = S // SLC_BLOCK
    cs = np.arange(nc) * CMP_STRIDE
    ss = np.arange(nsb) * SLC_BLOCK
    overlap = np.clip(np.minimum(cs[:, None] + CMP_LEN, ss[None, :] + SLC_BLOCK)
                      - np.maximum(cs[:, None], ss[None, :]), 0, None) / CMP_LEN
    imp = jnp.einsum('bghsc,cj->bgsj', p_cmp, jnp.asarray(overlap, dtype=jnp.float32))
    jb = jnp.arange(nsb)[None, :]
    cur = (pos // SLC_BLOCK)[:, None]
    forced = (jb == 0) | (jb == cur) | (jb == cur - 1)
    causal_blk = jb * SLC_BLOCK <= pos[:, None]
    score = jnp.where(forced, FORCE, jnp.where(causal_blk, imp, -FORCE))
    n_sel = min(SLC_TOPN, nsb)
    _, sel = lax.top_k(score, n_sel)
    sel = jnp.moveaxis(sel, 1, 2)

    kw_pad = jnp.pad(kw, ((0, 0), (WINDOW, 0), (0, 0), (0, 0)))
    vw_pad = jnp.pad(vw, ((0, 0), (WINDOW, 0), (0, 0), (0, 0)))
    bidx = jnp.arange(B)[:, None, None, None]
    gidx = jnp.arange(G)[None, None, :, None]
    offs = jnp.arange(SLC_BLOCK)
    n_keys = n_sel * SLC_BLOCK

    def q_block(i):
        start = i * B_Q_BLOCK
        qb = lax.dynamic_slice_in_dim(q, start, B_Q_BLOCK, axis=1)
        qpos = start + jnp.arange(B_Q_BLOCK)
        selb = lax.dynamic_slice_in_dim(sel, start, B_Q_BLOCK, axis=1)
        kpos = (selb[..., None] * SLC_BLOCK + offs).reshape(B, B_Q_BLOCK, G, n_keys)
        ksel = ks[bidx, kpos, gidx]
        vsel = vs[bidx, kpos, gidx]
        s1 = jnp.einsum('bqghd,bqgld->bghql', qb, ksel, preferred_element_type=jnp.float32)
        d1 = jnp.moveaxis(qpos[None, :, None, None] - kpos, 2, 1).astype(jnp.float32)[:, :, None]
        s1 = jnp.where(d1 >= 0, s1 - slopes * d1, NEG)
        p1 = jax.nn.softmax(s1, axis=-1)
        o_slc = jnp.einsum('bghql,bqgld->bqghd', p1.astype(vsel.dtype), vsel)
        kwb = lax.dynamic_slice_in_dim(kw_pad, start, WINDOW + B_Q_BLOCK, axis=1)
        vwb = lax.dynamic_slice_in_dim(vw_pad, start, WINDOW + B_Q_BLOCK, axis=1)
        wpos = start - WINDOW + jnp.arange(WINDOW + B_Q_BLOCK)
        dw = qpos[:, None] - wpos[None, :]
        vis = (dw >= 0) & (dw < WINDOW) & (wpos[None, :] >= 0)
        s2 = jnp.einsum('bqghd,bkgd->bghqk', qb, kwb, preferred_element_type=jnp.float32)
        s2 = jnp.where(vis, s2 - slopes * dw.astype(jnp.float32), NEG)
        p2 = jax.nn.softmax(s2, axis=-1)
        o_win = jnp.einsum('bghqk,bkgd->bqghd', p2.astype(vwb.dtype), vwb)
        return o_slc, o_win

    o_slc, o_win = lax.map(q_block, jnp.arange(S // B_Q_BLOCK))
    o_slc = jnp.moveaxis(o_slc, 0, 1).reshape(B, S, G, HPG, dv)
    o_win = jnp.moveaxis(o_win, 0, 1).reshape(B, S, G, HPG, dv)
    o = gate[..., 0:1] * o_cmp + gate[..., 1:2] * o_slc + gate[..., 2:3] * o_win
    return o.reshape(B, S, H * dv).astype(xn.dtype) @ w_out


def hier_moe(xn, w_group, b_group, w_expert, b_expert, w_gate, w_up, w_down):
    B, S, D = xn.shape
    T = B * S
    xt = xn.reshape(T, D)
    lg = (xt @ w_group).astype(jnp.float32) + b_group.astype(jnp.float32)
    pg = jax.nn.softmax(lg, axis=-1)
    g_top = jnp.argmax(lg, axis=-1)
    wg = jnp.take_along_axis(pg, g_top[:, None], axis=-1)
    le = ((xt @ w_expert).astype(jnp.float32) + b_expert.astype(jnp.float32)).reshape(T, N_GROUPS, EXPERTS_PER_GROUP)
    le = jnp.take_along_axis(le, g_top[:, None, None], axis=1)[:, 0]
    pe = jax.nn.softmax(le, axis=-1)
    pk, ik = lax.top_k(pe, TOP_K)
    wk = wg * pk / jnp.sum(pk, axis=-1, keepdims=True)
    eid = (g_top[:, None] * EXPERTS_PER_GROUP + ik).reshape(-1)
    tok = jnp.repeat(jnp.arange(T, dtype=jnp.int32), TOP_K)
    wslot = wk.reshape(-1)
    n_slots = T * TOP_K
    RB = MOE_ROW_BLOCK
    n_rows = -(-(n_slots + N_EXPERTS * (RB - 1)) // RB) * RB
    n_blk = n_rows // RB
    order = jnp.argsort(eid)
    e_sorted = eid[order]
    counts = jnp.bincount(eid, length=N_EXPERTS)
    padded = (counts + RB - 1) // RB * RB
    start_unpadded = jnp.cumsum(counts) - counts
    end_padded = jnp.cumsum(padded)
    start_padded = end_padded - padded
    dest = start_padded[e_sorted] + (jnp.arange(n_slots) - start_unpadded[e_sorted])
    row_tok = jnp.full((n_rows,), T, dtype=jnp.int32).at[dest].set(tok[order])
    row_w = jnp.zeros((n_rows,), jnp.float32).at[dest].set(wslot[order])
    blk_expert = jnp.clip(jnp.searchsorted(end_padded, jnp.arange(n_blk) * RB, side='right'), 0, N_EXPERTS - 1)
    x_pad = jnp.concatenate([xt, jnp.zeros((1, D), xt.dtype)], axis=0)

    def run(args):
        rows, e = args
        xr = x_pad[rows]
        h = jax.nn.silu(xr @ w_gate[e]) * (xr @ w_up[e])
        return h @ w_down[e]

    y = lax.map(run, (row_tok.reshape(n_blk, RB), blk_expert)).reshape(n_rows, D)
    y = y * row_w[:, None].astype(y.dtype)
    out = jax.ops.segment_sum(y, row_tok, num_segments=T + 1)[:T]
    return out.reshape(B, S, D).astype(xn.dtype)


def setup_inputs(seed: int = 0) -> dict:
    key = jax.random.key(seed)
    ks = jax.random.split(key, 20)
    n_a = (DEPTH + 1) // 2
    n_b = DEPTH // 2
    f = jnp.float32

    def nrm(k, shape, scale):
        return jax.random.normal(k, shape, f) * scale

    return {
        'x': nrm(ks[0], (BATCH, SEQ, D_MODEL), 1.0),
        'attn_norm_w': 1.0 + nrm(ks[1], (DEPTH, D_MODEL), 0.02),
        'ffn_norm_w': 1.0 + nrm(ks[2], (DEPTH, D_MODEL), 0.02),
        'final_norm_w': 1.0 + nrm(ks[3], (D_MODEL,), 0.02),
        'a_w_in': nrm(ks[4], (n_a, D_MODEL, A_IN), D_MODEL ** -0.5),
        'a_lambda': nrm(ks[5], (n_a, 4, A_HEAD_DIM), 0.1),
        'a_subln_w': 1.0 + nrm(ks[6], (n_a, A_V_DIM), 0.02),
        'a_w_out': nrm(ks[7], (n_a, A_HEADS * A_V_DIM, D_MODEL), (A_HEADS * A_V_DIM) ** -0.5),
        'b_w_in': nrm(ks[8], (n_b, D_MODEL, B_IN), D_MODEL ** -0.5),
        'b_cmp_pos': nrm(ks[9], (n_b, 2, CMP_LEN, B_DK), 0.1),
        'b_cmp_w1': nrm(ks[10], (n_b, 2, CMP_LEN * B_DK, CMP_HID), (CMP_LEN * B_DK) ** -0.5),
        'b_cmp_w2': nrm(ks[11], (n_b, 2, CMP_HID, B_DK), CMP_HID ** -0.5),
        'b_w_out': nrm(ks[12], (n_b, B_HEADS * B_DV, D_MODEL), (B_HEADS * B_DV) ** -0.5),
        'moe_w_group': nrm(ks[13], (DEPTH, D_MODEL, N_GROUPS), D_MODEL ** -0.5),
        'moe_b_group': nrm(ks[14], (DEPTH, N_GROUPS), 0.01),
        'moe_w_expert': nrm(ks[15], (DEPTH, D_MODEL, N_EXPERTS), D_MODEL ** -0.5),
        'moe_b_expert': nrm(ks[16], (DEPTH, N_EXPERTS), 0.01),
        'moe_w_gate': nrm(ks[17], (DEPTH, N_EXPERTS, D_MODEL, D_EXPERT), D_MODEL ** -0.5),
        'moe_w_up': nrm(ks[18], (DEPTH, N_EXPERTS, D_MODEL, D_EXPERT), D_MODEL ** -0.5),
        'moe_w_down': nrm(ks[19], (DEPTH, N_EXPERTS, D_EXPERT, D_MODEL), D_EXPERT ** -0.5),
    }


def reference(x, attn_norm_w, ffn_norm_w, final_norm_w, a_w_in, a_lambda, a_subln_w, a_w_out,
              b_w_in, b_cmp_pos, b_cmp_w1, b_cmp_w2, b_w_out, moe_w_group, moe_b_group,
              moe_w_expert, moe_b_expert, moe_w_gate, moe_w_up, moe_w_down):
    h = x
    for i in range(DEPTH):
        xn = rmsnorm(h, attn_norm_w[i])
        j = i // N_MIXERS
        if i % N_MIXERS == 0:
            lambda_init = 0.8 - 0.6 * math.exp(-0.3 * i)
            h = h + diff_attention(xn, a_w_in[j], a_lambda[j], a_subln_w[j], a_w_out[j], lambda_init)
        else:
            h = h + nsa_attention(xn, b_w_in[j], b_cmp_pos[j], b_cmp_w1[j], b_cmp_w2[j], b_w_out[j])
        xn = rmsnorm(h, ffn_norm_w[i])
        h = h + hier_moe(xn, moe_w_group[i], moe_b_group[i], moe_w_expert[i], moe_b_expert[i],
                         moe_w_gate[i], moe_w_up[i], moe_w_down[i])
    return rmsnorm(h, final_norm_w)
```

```cpp
#include <hip/hip_runtime.h>
#include <stdint.h>
#include <stdio.h>
#include <string.h>

#ifndef CONV_MODE
#define CONV_MODE 2
#endif
#ifndef MOE_G8
#define MOE_G8 0
#endif
#ifndef PP_MODE
#define PP_MODE 1
#endif
#ifndef N_LAUNCH_MODE
#define N_LAUNCH_MODE 1
#endif

#define D_MODEL 2048
#define BATCH 2
#define SEQ 4096
#define T_TOK (BATCH * SEQ)
#define A_HEADS 8
#define A_IN 6144
#define B_HEADS 16
#define B_GROUPS 4
#define B_IN 5168
#define B_MAIN 5120
#define NC 255
#define N_EXPERTS 32
#define D_EXPERT 1024
#define LIST_CAP 8192
#define MAX_ROWS (16384 + 32 * 256)
#define EPS 1e-6f

typedef unsigned short bf16_t;
typedef short bf16x8 __attribute__((ext_vector_type(8)));
typedef short s16x4 __attribute__((ext_vector_type(4)));
typedef float f32x4 __attribute__((ext_vector_type(4)));
typedef float f32x16 __attribute__((ext_vector_type(16)));
typedef unsigned u32x4 __attribute__((ext_vector_type(4)));
typedef unsigned u32x2 __attribute__((ext_vector_type(2)));

#define NTHREADS 512
#define LDS_BYTES (160 * 1024 - 256)

__device__ __forceinline__ unsigned cvtpk(float lo, float hi) {
    unsigned r; asm volatile("v_cvt_pk_bf16_f32 %0, %1, %2" : "=v"(r) : "v"(lo), "v"(hi)); return r;
}
__device__ __forceinline__ float bf2f(bf16_t v) { return __uint_as_float(((unsigned)v) << 16); }
__device__ __forceinline__ bf16_t f2bf(float f) { return (bf16_t)(cvtpk(f, 0.f) & 0xffffu); }
__device__ __forceinline__ int tidx() { int t = threadIdx.x; asm volatile("" : "+v"(t)); return t; }
template <int O> __device__ __forceinline__ int shx_i(int v) {
    if constexpr (O < 32) return __builtin_amdgcn_ds_swizzle(v, (O << 10) | 0x1f);
    else { const int l = tidx(); return __builtin_amdgcn_ds_bpermute(((l & 63) ^ 32) << 2, v); }
}
template <int O> __device__ __forceinline__ float shx(float v) { return __int_as_float(shx_i<O>(__float_as_int(v))); }
__device__ __forceinline__ float wave_sum(float v) {
    v += shx<32>(v); v += shx<16>(v); v += shx<8>(v); v += shx<4>(v); v += shx<2>(v); v += shx<1>(v);
    return v;
}

#define XB_TMO      128
#define XB_XCNT(j)  (256  + 64 * (j))
#define XB_XSUB(j)  (1280 + 64 * (j))
#define XB_XGEN(j)  (2304 + 64 * (j))
#define XB_TOP      3328
#define XB_TOPGEN   3392
#define XCD_BAR_WORDS 3456
#define XB_SPIN_CAP (1u << 22)
#define LAS __attribute__((address_space(3)))

__device__ __forceinline__ unsigned xb_ld(unsigned* p)              { return __hip_atomic_load(p, __ATOMIC_RELAXED, __HIP_MEMORY_SCOPE_AGENT); }
__device__ __forceinline__ unsigned xb_add(unsigned* p, unsigned v) { return __hip_atomic_fetch_add(p, v, __ATOMIC_RELAXED, __HIP_MEMORY_SCOPE_AGENT); }
__device__ __forceinline__ unsigned xb_xcc_id() { return (unsigned)__builtin_amdgcn_s_getreg((3 << 11) | 20) & 0xFu; }
#define XB_SPIN(cond, bar) do { unsigned _sp = 0; while (cond) { __builtin_amdgcn_s_sleep(1); \
    if ((++_sp & 255u) == 0u) { if (xb_ld(&(bar)[XB_TMO])) break; if (_sp > XB_SPIN_CAP) { atomicAdd(&(bar)[XB_TMO], 1u); break; } } } } while (0)

struct XcdBarrier { unsigned* bar; unsigned x; volatile LAS unsigned* st; unsigned rank; };

__device__ __forceinline__ XcdBarrier xcd_barrier_post(unsigned* bar, volatile LAS unsigned* st) {
    XcdBarrier b; b.bar = bar; b.x = xb_xcc_id(); b.st = st; b.rank = 0u;
    if (threadIdx.x == 0) b.rank = xb_add(&bar[XB_XCNT(b.x)], 1u);
    return b;
}
__device__ __forceinline__ void xcd_barrier_complete(unsigned* bar, unsigned x, unsigned& nloc, unsigned& nx) {
    const unsigned G = gridDim.x * gridDim.y * gridDim.z;
    unsigned sum, cnt, mine, sp = 0u;
    for (;;) {
        sum = 0u; cnt = 0u; mine = 0u;
#pragma unroll
        for (unsigned j = 0; j < 16; ++j) { const unsigned c = xb_ld(&bar[XB_XCNT(j)]); sum += c; cnt += (c > 0u) ? 1u : 0u; mine = (j == x) ? c : mine; }
        if (sum == G) break;
        __builtin_amdgcn_s_sleep(1);
        if ((++sp & 255u) == 0u) { if (xb_ld(&bar[XB_TMO])) break; if (sp > XB_SPIN_CAP) { atomicAdd(&bar[XB_TMO], 1u); break; } }
    }
    nloc = mine > 0u ? mine : 1u; nx = cnt > 0u ? cnt : 1u;
}
__device__ __forceinline__ void xcd_barrier(const XcdBarrier& b) {
    asm volatile("s_waitcnt vmcnt(0)" ::: "memory");
    __syncthreads();
    if (threadIdx.x == 0) {
        unsigned* bar = b.bar;
        __builtin_amdgcn_s_waitcnt(0);
        unsigned nloc = b.st[0], nx = b.st[1];
        if (nloc == 0u) { xcd_barrier_complete(bar, b.x, nloc, nx); b.st[0] = nloc; b.st[1] = nx; }
        const unsigned old = xb_add(&bar[XB_XSUB(b.x)], 1u);
        const unsigned gen = old / nloc;
        if (old + 1u == (gen + 1u) * nloc) {
            __builtin_amdgcn_fence(__ATOMIC_RELEASE, "agent");
            asm volatile("s_waitcnt vmcnt(0)" ::: "memory");
            const unsigned og = xb_add(&bar[XB_TOP], 1u);
            const unsigned tg = og / nx;
            if (og + 1u == (tg + 1u) * nx) xb_add(&bar[XB_TOPGEN], 1u);
            else XB_SPIN(xb_ld(&bar[XB_TOPGEN]) == tg, bar);
            __builtin_amdgcn_fence(__ATOMIC_ACQUIRE, "agent");
            xb_add(&bar[XB_XGEN(b.x)], 1u);
            asm volatile("s_waitcnt vmcnt(0)" ::: "memory");
        } else {
            XB_SPIN(xb_ld(&bar[XB_XGEN(b.x)]) == gen, bar);
            __builtin_amdgcn_fence(__ATOMIC_ACQUIRE, "agent");
            asm volatile("s_waitcnt vmcnt(0)" ::: "memory");
        }
    }
    __syncthreads();
}

__device__ __forceinline__ int wgid_v(char* lds);
struct Params {
    const float* x; const float* attn_norm_w; const float* ffn_norm_w; const float* final_norm_w;
    const float* a_w_in; const float* a_lambda; const float* a_subln_w; const float* a_w_out;
    const float* b_w_in; const float* b_cmp_pos; const float* b_cmp_w1; const float* b_cmp_w2; const float* b_w_out;
    const float* moe_w_group; const float* moe_b_group; const float* moe_w_expert; const float* moe_b_expert;
    const float* moe_w_gate; const float* moe_w_up; const float* moe_w_down;
    float* out;
    unsigned* bar;
    unsigned* cnt;
    bf16_t* xn;
    bf16_t* qkv;
    float* gate;
    bf16_t* attn_o;
    bf16_t* h1;
    bf16_t* h2;
    bf16_t* rw_hi;
    bf16_t* rw_lo;
    bf16_t* hmid;
    bf16_t* ybuf;
    int* list_tok;
    float* list_w;
    int* slot_ref;
    float* cbias;
    float* cslab;
    bf16_t* chid;
    bf16_t* kvcmp;
    bf16_t* wt_a_in; bf16_t* wt_a_out; bf16_t* wt_b_in; bf16_t* wt_b_out;
    bf16_t* wgu_t; bf16_t* wd_t;
    unsigned* diag;
    int phase_lo, phase_hi;
};
typedef const __attribute__((address_space(4))) Params CParams;

__device__ __forceinline__ int lds_byte(int r, int c) { const int st = (r >> 4) * 2 + (c >> 5), rr = r & 15, cc = c & 31, ob = rr * 64 + cc * 2; return st * 1024 + (ob ^ (((ob >> 9) & 1) << 5)); }

#define G_BM 256
#define G_BN 128
#define G_BK 64
#define G_ABYTES (G_BM * G_BK * 2)
#define G_BBYTES (G_BN * G_BK * 2)
#define G_BUF (G_ABYTES + G_BBYTES)

template <bool LIGHT = false, class AF, class BF, class EP>
__device__ __forceinline__ void gemm_tile(const AF& af, const BF& bf, const EP& ep, const int K, char* lds, const unsigned rowmask  ) {
    const int tid = tidx(), wid = tid >> 6, lane = tid & 63, wr = wid >> 1, wc = wid & 1, fr = lane & 15, fq = lane >> 4;
    f32x4 acc[4][4];
#pragma unroll
    for (int m = 0; m < 4; ++m)
#pragma unroll
        for (int n = 0; n < 4; ++n) acc[m][n] = (f32x4){0.f, 0.f, 0.f, 0.f};
    const int a_r0 = tid >> 3, a_kc = (tid & 7) * 8;
    const bf16_t* ap[4]; unsigned avm = 0u;
#pragma unroll
    for (int i = 0; i < 4; ++i) { ap[i] = af.a_row(a_r0 + 64 * i); if (ap[i]) avm |= 1u << i; else ap[i] = af.safe(); }
    const int b_nb = (lane & 7) + 8 * (wid >> 1), b_kb = (lane >> 3) + 8 * (wid & 1);
    const float* bp = bf.colptr(4 * b_nb); const bool bvm = bp != nullptr; if (!bvm) bp = bf.safe();
    const bf16_t* bt16 = bf.bt16();
    const size_t ldb = bf.ldb;
    u32x4 ar0[4], ar1[4], ar2[4]; f32x4 br0[4], br1[4], br2[4];
    const int nk = K / G_BK;
    const bool act = (rowmask >> wr) & 1u;
    const int sa_base = lds_byte(a_r0, a_kc), sb_base = lds_byte(4 * b_nb, 4 * b_kb);
    const int fa_base = lds_byte(wr * 64 + fr, fq * 8), fb_base = lds_byte(wc * 64 + fr, fq * 8);

#define G_LOAD(kt, AR, BR) do { const int k0_ = (kt) * G_BK; const int ko_ = af.koff(k0_) + a_kc; \
        _Pragma("unroll") for (int i = 0; i < 4; ++i) AR[i] = *(const u32x4*)(ap[i] + ko_); \
        if (BF::IS_BF16) { _Pragma("unroll") for (int i = 0; i < 2; ++i) BR[i] = *(const f32x4*)(bt16 + (size_t)(a_r0 + 64 * i) * ldb + k0_ + a_kc); } \
        else { _Pragma("unroll") for (int i = 0; i < 4; ++i) BR[i] = *(const f32x4*)(bp + (size_t)(k0_ + 4 * b_kb + i) * ldb); } } while (0)
#define G_STORE(kt, AR, BR) do { char* A_ = lds + ((kt) & 1) * G_BUF; char* B_ = A_ + G_ABYTES; \
        _Pragma("unroll") for (int i = 0; i < 4; ++i) *(u32x4*)(A_ + sa_base + i * 8192) = ((avm >> i) & 1u) ? AR[i] : (u32x4){0u, 0u, 0u, 0u}; \
        _Pragma("unroll") for (int j = 0; j < 4; ++j) { u32x2 w_; w_.x = cvtpk(BR[0][j], BR[1][j]); w_.y = cvtpk(BR[2][j], BR[3][j]); if (!bvm) { w_.x = 0u; w_.y = 0u; } \
            *(u32x2*)(B_ + sb_base + j * 64) = w_; } } while (0)
#define G_COMPUTE(kt) do { if (act) { const char* A_ = lds + ((kt) & 1) * G_BUF; const char* B_ = A_ + G_ABYTES; \
        _Pragma("unroll") for (int ks = 0; ks < 2; ++ks) { bf16x8 a[4], b[4]; \
            _Pragma("unroll") for (int m = 0; m < 4; ++m) a[m] = *(const bf16x8*)(A_ + fa_base + m * 2048 + ks * 1024); \
            _Pragma("unroll") for (int n = 0; n < 4; ++n) b[n] = *(const bf16x8*)(B_ + fb_base + n * 2048 + ks * 1024); \
            _Pragma("unroll") for (int m = 0; m < 4; ++m) _Pragma("unroll") for (int n = 0; n < 4; ++n) \
                acc[m][n] = __builtin_amdgcn_mfma_f32_16x16x32_bf16(b[n], a[m], acc[m][n], 0, 0, 0); } } } while (0)
#define G_STEP(kt, ARc, BRc, ARn, BRn) do { G_LOAD((kt) + 3, ARc, BRc); G_COMPUTE(kt); G_STORE((kt) + 1, ARn, BRn); __syncthreads(); } while (0)
#define G_TAIL(kt, ARn, BRn) do { if ((kt) < nk) { G_COMPUTE(kt); if ((kt) + 1 < nk) G_STORE((kt) + 1, ARn, BRn); __syncthreads(); } } while (0)

    if (LIGHT) {
        G_LOAD(0, ar0, br0); G_STORE(0, ar0, br0); __syncthreads();
        for (int k1 = 0; k1 < nk; ++k1) { if (k1 + 1 < nk) G_LOAD(k1 + 1, ar0, br0); G_COMPUTE(k1); if (k1 + 1 < nk) G_STORE(k1 + 1, ar0, br0); __syncthreads(); }
        if (act) ep(acc, wr, wc, fr, fq);
        __syncthreads();
        return;
    }
#if PP_MODE == 0
    G_LOAD(0, ar0, br0); G_LOAD(1, ar1, br1); G_LOAD(2, ar2, br2);
    G_STORE(0, ar0, br0);
    __syncthreads();
    { int kt = 0;
      for (; kt + 5 < nk; kt += 3) { G_STEP(kt, ar0, br0, ar1, br1); G_STEP(kt + 1, ar1, br1, ar2, br2); G_STEP(kt + 2, ar2, br2, ar0, br0); }
      if (kt + 3 < nk) G_LOAD(kt + 3, ar0, br0);
      G_COMPUTE(kt); if (kt + 1 < nk) G_STORE(kt + 1, ar1, br1); __syncthreads();
      if (kt + 4 < nk) G_LOAD(kt + 4, ar1, br1);
      G_TAIL(kt + 1, ar2, br2); G_TAIL(kt + 2, ar0, br0); G_TAIL(kt + 3, ar1, br1); G_TAIL(kt + 4, ar2, br2); }
#else
#define PP_STAGE(t) (lds + ((t) % 3) * G_BUF)
#define PP_STORE(t, AR, BR) do { char* A_ = PP_STAGE(t); char* B_ = A_ + G_ABYTES; \
        _Pragma("unroll") for (int i = 0; i < 4; ++i) *(u32x4*)(A_ + sa_base + i * 8192) = ((avm >> i) & 1u) ? AR[i] : (u32x4){0u, 0u, 0u, 0u}; \
        if (BF::IS_BF16) { _Pragma("unroll") for (int i = 0; i < 2; ++i) *(f32x4*)(B_ + sa_base + i * 8192) = BR[i]; } \
        else { _Pragma("unroll") for (int j = 0; j < 4; ++j) { u32x2 w_; w_.x = cvtpk(BR[0][j], BR[1][j]); w_.y = cvtpk(BR[2][j], BR[3][j]); if (!bvm) { w_.x = 0u; w_.y = 0u; } \
            *(u32x2*)(B_ + sb_base + j * 64) = w_; } } } while (0)
#define PP_READ(t, ks) do { if (act) { const char* A_ = PP_STAGE(t); const char* B_ = A_ + G_ABYTES; \
        _Pragma("unroll") for (int m = 0; m < 4; ++m) fa[m] = *(const bf16x8*)(A_ + fa_base + m * 2048 + (ks) * 1024); \
        _Pragma("unroll") for (int n = 0; n < 4; ++n) fb[n] = *(const bf16x8*)(B_ + fb_base + n * 2048 + (ks) * 1024); } } while (0)
#define PP_MMA() do { if (act) { __builtin_amdgcn_s_setprio(1); \
        _Pragma("unroll") for (int m = 0; m < 4; ++m) _Pragma("unroll") for (int n = 0; n < 4; ++n) \
            acc[m][n] = __builtin_amdgcn_mfma_f32_16x16x32_bf16(fb[n], fa[m], acc[m][n], 0, 0, 0); \
        __builtin_amdgcn_s_setprio(0); } } while (0)
#define PP_BAR() __builtin_amdgcn_s_barrier()
#define PP_WL() asm volatile("s_waitcnt lgkmcnt(0)" ::: "memory")
#define PP_STEP(kt, ARs, BRs, DOLOAD, DOSTORE) do { \
        PP_READ(kt, 0); PP_BAR(); PP_WL(); PP_MMA(); PP_BAR(); \
        PP_READ(kt, 1); if (DOSTORE) PP_STORE((kt) + 2, ARs, BRs); if (DOLOAD) G_LOAD((kt) + 5, ARs, BRs); PP_BAR(); PP_WL(); PP_MMA(); PP_BAR(); } while (0)
    bf16x8 fa[4], fb[4];
    const bool grp1 = wid >= 4;
    G_LOAD(0, ar0, br0); G_LOAD(1, ar1, br1); G_LOAD(2, ar2, br2);
    PP_STORE(0, ar0, br0); G_LOAD(3, ar0, br0);
    PP_STORE(1, ar1, br1); G_LOAD(4, ar1, br1);
    asm volatile("s_waitcnt lgkmcnt(0)" ::: "memory");
    __syncthreads();
    if (grp1) PP_BAR();
    int kt = 0;
    for (; kt + 7 < nk; kt += 3) {
        PP_STEP(kt, ar2, br2, true, true);
        PP_STEP(kt + 1, ar0, br0, true, true);
        PP_STEP(kt + 2, ar1, br1, true, true);
    }
#define PP_TAIL(kk, ARs, BRs) do { if ((kk) < nk) { const bool ld_ = (kk) + 5 < nk, st_ = (kk) + 2 < nk; \
        PP_READ(kk, 0); PP_BAR(); PP_WL(); PP_MMA(); PP_BAR(); \
        PP_READ(kk, 1); if (st_) PP_STORE((kk) + 2, ARs, BRs); if (ld_) G_LOAD((kk) + 5, ARs, BRs); PP_BAR(); PP_WL(); PP_MMA(); PP_BAR(); } } while (0)
    PP_TAIL(kt, ar2, br2); PP_TAIL(kt + 1, ar0, br0); PP_TAIL(kt + 2, ar1, br1);
    PP_TAIL(kt + 3, ar2, br2); PP_TAIL(kt + 4, ar0, br0); PP_TAIL(kt + 5, ar1, br1); PP_TAIL(kt + 6, ar2, br2);
    if (!grp1) PP_BAR();
#endif
#undef PP_STAGE
#undef PP_STORE
#undef PP_READ
#undef PP_MMA
#undef PP_BAR
#undef PP_WL
#undef PP_STEP
#undef PP_TAIL
#undef G_LOAD
#undef G_STORE
#undef G_COMPUTE
#undef G_STEP
#undef G_TAIL
    if (act) ep(acc, wr, wc, fr, fq);
    __syncthreads();
}

#define G2_BUF (G_ABYTES + 2 * G_BBYTES)
__device__ __forceinline__ void stage_rc(int b, int& R, int& C);
__device__ __forceinline__ void glds16_asm(const void* gsrc, unsigned lds_dst) {
    unsigned keep;
    asm volatile("s_mov_b32 %0, m0\n\ts_mov_b32 m0, %2\n\ts_nop 0\n\tglobal_load_lds_dwordx4 %1, off\n\ts_mov_b32 m0, %0" : "=&s"(keep) : "v"(gsrc), "s"(lds_dst) : "memory");
}
__device__ __forceinline__ void glds16_asm_s(const void* sbase, unsigned voff, unsigned lds_dst) {
    unsigned keep;
    asm volatile("s_mov_b32 %0, m0\n\ts_mov_b32 m0, %3\n\ts_nop 0\n\tglobal_load_lds_dwordx4 %1, %2\n\ts_mov_b32 m0, %0" : "=&s"(keep) : "v"(voff), "s"(sbase), "s"(lds_dst) : "memory");
}
template <class AF, class BF, class EP>
__device__ __forceinline__ void gemm_tile256(const AF& af, const BF& bf, const EP& ep, const int K, char* lds, const unsigned rowmask) {
    const int tid = tidx(), wid = __builtin_amdgcn_readfirstlane(tid >> 6), lane = tid & 63, wr = wid >> 1, wc = wid & 1, fr = lane & 15, fq = lane >> 4;
    f32x4 acc[4][8];
#pragma unroll
    for (int m = 0; m < 4; ++m)
#pragma unroll
        for (int n = 0; n < 8; ++n) acc[m][n] = (f32x4){0.f, 0.f, 0.f, 0.f};
    const bf16_t* abase = af.safe(); unsigned aoff[4];
#pragma unroll
    for (int i = 0; i < 4; ++i) { int R, C; stage_rc(tid * 16 + (i & 1) * 8192, R, C);
        aoff[i] = 2u * (af.a_off((i >> 1) * 128 + R) + (unsigned)C); }
    const unsigned lds_a = (unsigned)(uintptr_t)lds + (unsigned)wid * 1024u;
    const int b_nl = (lane & 3) + 4 * ((lane >> 5) & 1), b_kl = ((lane >> 2) & 3) + 4 * ((lane >> 4) & 1);
    const size_t ldb = bf.ldb;
    const unsigned boff = (unsigned)((4 * (b_kl + 8 * (wid & 1))) * (int)ldb + 4 * (b_nl + 8 * (wid >> 1))) * 4u;
    const __amdgpu_buffer_rsrc_t rs0 = __builtin_amdgcn_make_buffer_rsrc((void*)bf.base(0), 0, 0x7fffffff, 0x00020000);
    const __amdgpu_buffer_rsrc_t rs1 = __builtin_amdgcn_make_buffer_rsrc((void*)bf.base(1), 0, 0x7fffffff, 0x00020000);
    const unsigned lpk = (unsigned)lds_byte(lane & 15, (lane >> 4) * 8) | ((unsigned)lds_byte((lane & 15) ^ ((lane >> 2) & 1), (lane >> 4) * 8) << 10)
                       | ((unsigned)(lds_byte(4 * b_nl, 4 * b_kl) + (lane & 1) * 64) << 20);
    const int s_fa = (wid >> 1) * 8192, s_fb = (wid & 1) * 16384, s_sb = lds_byte(BF::wrow(wid >> 1), 32 * (wid & 1));
    f32x4 br[8];
    const int nk = K / G_BK;
    const bool act = __builtin_amdgcn_readfirstlane((int)((rowmask >> wr) & 1u)) != 0;
#define G2_SB() ((int)(lpk >> 20) + s_sb)
#define G2_SB1(sb0_) ((sb0_) ^ 64)
#define G2_FA() ((int)(lpk & 1023u) + s_fa)
#define G2_FB() ((int)((lpk >> 10) & 1023u) + s_fb)
#define G2_ADMA(kt) do { const int ko_ = af.koff((kt) * G_BK); const unsigned d_ = lds_a + (unsigned)(((kt) & 1) * G2_BUF); \
        _Pragma("unroll") for (int i = 0; i < 4; ++i) glds16_asm_s(abase + ko_, aoff[i], d_ + (unsigned)(i * 8192)); } while (0)
#define G2_BLOADH(kt, hh) do { const int so_ = (kt) * G_BK * (int)ldb * 4; \
        _Pragma("unroll") for (int i = 0; i < 4; ++i) br[4 * (hh) + i] = __builtin_bit_cast(f32x4, __builtin_amdgcn_raw_buffer_load_b128((hh) ? rs1 : rs0, (int)boff, so_ + i * (int)ldb * 4, 0)); } while (0)
#define G2_PIECE(Bw_, sb_, sb1_, pc) do { u32x2 w_; \
        w_.x = cvtpk(br[4 * ((pc) >> 2) + 0][(pc) & 3], br[4 * ((pc) >> 2) + 1][(pc) & 3]); w_.y = cvtpk(br[4 * ((pc) >> 2) + 2][(pc) & 3], br[4 * ((pc) >> 2) + 3][(pc) & 3]); \
        *(u32x2*)(Bw_ + (((pc) & 1) ? sb1_ : sb_) + ((pc) >> 2) * (BF::HROW * 128) + (((pc) >> 1) & 1) * 128) = w_; } while (0)
#define G2_BSTORE(kt) do { char* Bw_ = lds + ((kt) & 1) * G2_BUF + G_ABYTES; const int sb_ = G2_SB(), sb1_ = G2_SB1(sb_); \
        _Pragma("unroll") for (int pc = 0; pc < 8; ++pc) G2_PIECE(Bw_, sb_, sb1_, pc); } while (0)
#define G2_COMPUTE(kt, ST, RL, ACT, DMA) do { char* Bw_ = lds + (((kt) + 1) & 1) * G2_BUF + G_ABYTES; const int sb_ = (ST) ? G2_SB() : 0, sb1_ = (ST) ? G2_SB1(sb_) : 0; \
        const char* A_ = lds + ((kt) & 1) * G2_BUF; const char* B_ = A_ + G_ABYTES; const int fa_base = (ACT) ? G2_FA() : 0, fb_base = (ACT) ? G2_FB() : 0; \
        bf16x8 a[4], bc; \
        if (ACT) { _Pragma("unroll") for (int m = 0; m < 4; ++m) a[m] = *(const bf16x8*)(A_ + fa_base + m * 2048); \
                   bc = *(const bf16x8*)(B_ + fb_base); } \
        if (DMA) G2_ADMA((kt) + 1);                                  \
        __builtin_amdgcn_sched_barrier(0); \
        _Pragma("unroll") for (int ks = 0; ks < 2; ++ks) { \
            _Pragma("unroll") for (int n = 0; n < 8; ++n) { \
                if (ACT) { const bf16x8 bn = bc; \
                    if (n < 7) bc = *(const bf16x8*)(B_ + fb_base + (n + 1) * 2048 + ks * 1024); \
                    else if (ks == 0) bc = *(const bf16x8*)(B_ + fb_base + 1024); \
                    __builtin_amdgcn_s_setprio(1); \
                    _Pragma("unroll") for (int m = 0; m < 4; ++m) { acc[m][n] = __builtin_amdgcn_mfma_f32_16x16x32_bf16(bn, a[m], acc[m][n], 0, 0, 0); \
                        if (ks == 0 && n == 7) { __builtin_amdgcn_sched_barrier(0); a[m] = *(const bf16x8*)(A_ + fa_base + m * 2048 + 1024); } }     \
                    __builtin_amdgcn_s_setprio(0); } \
                if ((ST) && (n & 1)) G2_PIECE(Bw_, sb_, sb1_, ks * 4 + (n >> 1)); \
                if ((RL) && n == 7) G2_BLOADH((kt) + 2, ks); \
                __builtin_amdgcn_sched_barrier(0); } } } while (0)
    G2_ADMA(0); G2_BLOADH(0, 0); G2_BLOADH(0, 1);
    G2_BSTORE(0);
    __builtin_amdgcn_sched_barrier(0);
    if (nk > 1) { G2_BLOADH(1, 0); G2_BLOADH(1, 1); asm volatile("s_waitcnt vmcnt(8)" ::: "memory"); }
    else asm volatile("s_waitcnt vmcnt(0)" ::: "memory");
    __syncthreads();
#define G2_LOOP(ACT) do { int kt = 0; \
    for (; kt + 2 < nk; ++kt) { G2_COMPUTE(kt, 1, 1, ACT, 1); asm volatile("s_waitcnt vmcnt(8)" ::: "memory"); __syncthreads(); } \
    if (kt + 1 < nk) { G2_COMPUTE(kt, 1, 0, ACT, 1); asm volatile("s_waitcnt vmcnt(0)" ::: "memory"); __syncthreads(); ++kt; } \
    G2_COMPUTE(kt, 0, 0, ACT, 0); \
    __syncthreads(); } while (0)
    if (act) G2_LOOP(1); else G2_LOOP(0);
#undef G2_LOOP
#undef G2_BLOADH
#undef G2_PIECE
#undef G2_SB
#undef G2_SB1
#undef G2_FA
#undef G2_FB
#undef G2_ADMA
#undef G2_BSTORE
#undef G2_COMPUTE
    { const int l2_ = tidx() & 63; if (act) ep(acc, wr, wc, l2_ & 15, l2_ >> 4); }
    __syncthreads();
}
template <class UN>
__device__ __forceinline__ void gemm_tile256_seq(UN& un, const int K, char* lds) {
    typedef typename UN::BFT BF;
    const int tid = tidx(), wid = __builtin_amdgcn_readfirstlane(tid >> 6), lane = tid & 63, wr = wid >> 1, wc = wid & 1, fr = lane & 15, fq = lane >> 4;
    f32x4 acc[4][8];
    const bf16_t* abase = nullptr; unsigned aoff[4] = {0u, 0u, 0u, 0u};
    const unsigned lds_a = (unsigned)(uintptr_t)lds + (unsigned)wid * 1024u;
    const int b_nl = (lane & 3) + 4 * ((lane >> 5) & 1), b_kl = ((lane >> 2) & 3) + 4 * ((lane >> 4) & 1);
    const size_t ldb = UN::LDB;
    const int s_bo = ((32 * (wid & 1)) * (int)ldb + 32 * (wid >> 1)) * 4;
    __amdgpu_buffer_rsrc_t rs0 = __builtin_amdgcn_make_buffer_rsrc((void*)nullptr, 0, 0x7fffffff, 0x00020000), rs1 = rs0;
#define T2_SETUP() do { abase = un.af.safe(); \
        _Pragma("unroll") for (int i = 0; i < 4; ++i) { int R, C; stage_rc(tidx() * 16 + (i & 1) * 8192, R, C); aoff[i] = 2u * (un.af.a_off((i >> 1) * 128 + R) + (unsigned)C); } \
        rs0 = __builtin_amdgcn_make_buffer_rsrc((void*)un.bf.base(0), 0, 0x7fffffff, 0x00020000); rs1 = __builtin_amdgcn_make_buffer_rsrc((void*)un.bf.base(1), 0, 0x7fffffff, 0x00020000); } while (0)
    const unsigned lpk = (unsigned)lds_byte(lane & 15, (lane >> 4) * 8) | ((unsigned)lds_byte((lane & 15) ^ ((lane >> 2) & 1), (lane >> 4) * 8) << 10)
                       | ((unsigned)(lds_byte(4 * b_nl, 4 * b_kl) + (lane & 1) * 64) << 20);
    const int s_fa = (wid >> 1) * 8192, s_fb = (wid & 1) * 16384, s_sb = lds_byte(BF::wrow(wid >> 1), 32 * (wid & 1));
    f32x4 br[8];
    const int nk = K / G_BK;
#define G2_SB() ((int)(lpk >> 20) + s_sb)
#define G2_SB1(sb0_) ((sb0_) ^ 64)
#define G2_FA() ((int)(lpk & 1023u) + s_fa)
#define G2_FB() ((int)((lpk >> 10) & 1023u) + s_fb)
#define G2_ADMA(kt) do { const int ko_ = (kt) * G_BK; const unsigned d_ = lds_a + (unsigned)(((kt) & 1) * G2_BUF); \
        _Pragma("unroll") for (int i = 0; i < 4; ++i) glds16_asm_s(abase + ko_, aoff[i], d_ + (unsigned)(i * 8192)); } while (0)
#define G2_BLOADH(kt, hh) do { const int so_ = (kt) * G_BK * (int)ldb * 4 + s_bo; const int l_ = tidx() & 63; \
        const int bo_ = (((l_ >> 2) & 3) + 4 * ((l_ >> 4) & 1)) * (16 * (int)ldb) + ((l_ & 3) + 4 * ((l_ >> 5) & 1)) * 16;        \
        _Pragma("unroll") for (int i = 0; i < 4; ++i) br[4 * (hh) + i] = __builtin_bit_cast(f32x4, __builtin_amdgcn_raw_buffer_load_b128((hh) ? rs1 : rs0, bo_, so_ + i * (int)ldb * 4, 0)); } while (0)
#define G2_PIECE(Bw_, sb_, sb1_, pc) do { u32x2 w_; \
        w_.x = cvtpk(br[4 * ((pc) >> 2) + 0][(pc) & 3], br[4 * ((pc) >> 2) + 1][(pc) & 3]); w_.y = cvtpk(br[4 * ((pc) >> 2) + 2][(pc) & 3], br[4 * ((pc) >> 2) + 3][(pc) & 3]); \
        *(u32x2*)(Bw_ + (((pc) & 1) ? sb1_ : sb_) + ((pc) >> 2) * (BF::HROW * 128) + (((pc) >> 1) & 1) * 128) = w_; } while (0)
#define G2_BSTORE(kt) do { char* Bw_ = lds + ((kt) & 1) * G2_BUF + G_ABYTES; const int sb_ = G2_SB(), sb1_ = G2_SB1(sb_); \
        _Pragma("unroll") for (int pc = 0; pc < 8; ++pc) G2_PIECE(Bw_, sb_, sb1_, pc); } while (0)
#define G2_COMPUTE(kt, ST, RL, ACT, DMA) do { char* Bw_ = lds + (((kt) + 1) & 1) * G2_BUF + G_ABYTES; const int sb_ = (ST) ? G2_SB() : 0, sb1_ = (ST) ? G2_SB1(sb_) : 0; \
        const char* A_ = lds + ((kt) & 1) * G2_BUF; const char* B_ = A_ + G_ABYTES; const int fa_base = (ACT) ? G2_FA() : 0, fb_base = (ACT) ? G2_FB() : 0; \
        bf16x8 a[4], bc; \
        if (ACT) { _Pragma("unroll") for (int m = 0; m < 4; ++m) a[m] = *(const bf16x8*)(A_ + fa_base + m * 2048); \
                   bc = *(const bf16x8*)(B_ + fb_base); } \
        if (DMA) G2_ADMA((kt) + 1);                                  \
        __builtin_amdgcn_sched_barrier(0); \
        _Pragma("unroll") for (int ks = 0; ks < 2; ++ks) { \
            _Pragma("unroll") for (int n = 0; n < 8; ++n) { \
                if (ACT) { const bf16x8 bn = bc; \
                    if (n < 7) bc = *(const bf16x8*)(B_ + fb_base + (n + 1) * 2048 + ks * 1024); \
                    else if (ks == 0) bc = *(const bf16x8*)(B_ + fb_base + 1024); \
                    __builtin_amdgcn_s_setprio(1); \
                    _Pragma("unroll") for (int m = 0; m < 4; ++m) { acc[m][n] = __builtin_amdgcn_mfma_f32_16x16x32_bf16(bn, a[m], acc[m][n], 0, 0, 0); \
                        if (ks == 0 && n == 7) { __builtin_amdgcn_sched_barrier(0); a[m] = *(const bf16x8*)(A_ + fa_base + m * 2048 + 1024); } }     \
                    __builtin_amdgcn_s_setprio(0); } \
                if ((ST) && (n & 1)) G2_PIECE(Bw_, sb_, sb1_, ks * 4 + (n >> 1)); \
                if ((RL) && n == 7) G2_BLOADH((kt) + 2, ks); \
                __builtin_amdgcn_sched_barrier(0); } } } while (0)
#define G2_LOOP(ACT) do { int kt = 0; \
    for (; kt + 2 < nk; ++kt) { G2_COMPUTE(kt, 1, 1, ACT, 1); asm volatile("s_waitcnt vmcnt(8)" ::: "memory"); __syncthreads(); } \
    if (kt + 1 < nk) { G2_COMPUTE(kt, 1, 0, ACT, 1); asm volatile("s_waitcnt vmcnt(0)" ::: "memory"); __syncthreads(); ++kt; } \
    G2_COMPUTE(kt, 0, 0, ACT, 0); \
    __syncthreads(); } while (0)
    bool have = un.first();
    if (have) { T2_SETUP(); G2_ADMA(0); G2_BLOADH(0, 0); G2_BLOADH(0, 1); }
#pragma unroll 1
    while (have) {
        const typename UN::EPT ep = un.ep;
        const bool act = __builtin_amdgcn_readfirstlane((int)((un.rowmask >> wr) & 1u)) != 0;
#pragma unroll
        for (int m = 0; m < 4; ++m)
#pragma unroll
            for (int n = 0; n < 8; ++n) acc[m][n] = (f32x4){0.f, 0.f, 0.f, 0.f};
        G2_BSTORE(0);
        __builtin_amdgcn_sched_barrier(0);
        if (nk > 1) { G2_BLOADH(1, 0); G2_BLOADH(1, 1); asm volatile("s_waitcnt vmcnt(8)" ::: "memory"); }
        else asm volatile("s_waitcnt vmcnt(0)" ::: "memory");
        __syncthreads();
        if (act) G2_LOOP(1); else G2_LOOP(0);
        have = un.next();
        if (have) { T2_SETUP(); G2_ADMA(0); G2_BLOADH(0, 0); G2_BLOADH(0, 1); }
        __builtin_amdgcn_sched_barrier(0);
        { const int l2_ = tidx() & 63; if (act) ep(acc, wr, wc, l2_ & 15, l2_ >> 4); }
    }
    __syncthreads();
#undef G2_LOOP
#undef T2_SETUP
#undef G2_BLOADH
#undef G2_PIECE
#undef G2_SB
#undef G2_SB1
#undef G2_FA
#undef G2_FB
#undef G2_ADMA
#undef G2_BSTORE
#undef G2_COMPUTE
}
struct ARows {
    const bf16_t* base; int lda; int row0; int mlim;
    __device__ __forceinline__ const bf16_t* a_row(int r) const { const int g = row0 + r; return g < mlim ? base + (size_t)g * lda : nullptr; }
    __device__ __forceinline__ unsigned a_off(int r) const { const int g = row0 + r; return g < mlim ? (unsigned)g * (unsigned)lda : 0u; }
    __device__ __forceinline__ const bf16_t* safe() const { return base; }
    __device__ __forceinline__ int koff(int k0) const { return k0; }
};
struct AGather {
    const bf16_t* base; int lda; const int* list; int r0; int cnt;
    __device__ __forceinline__ const bf16_t* a_row(int r) const { const int g = r0 + r; return g < cnt ? base + (size_t)list[g] * lda : nullptr; }
    __device__ __forceinline__ unsigned a_off(int r) const { const int g = r0 + r; return g < cnt ? (unsigned)list[g] * (unsigned)lda : 0u; }
    __device__ __forceinline__ const bf16_t* safe() const { return base; }
    __device__ __forceinline__ int koff(int k0) const { return k0; }
};
struct ACompress {
    const bf16_t* src; int col0; int row0; int kbase;
    __device__ __forceinline__ const bf16_t* a_row(int r) const {
        const int g = row0 + r; const int b = g >> 10, c = (g >> 2) & 255, gg = g & 3;
        if (c >= NC) return nullptr;
        return src + ((size_t)(b * SEQ + 16 * c)) * B_MAIN + col0 + gg * 128;
    }
    __device__ __forceinline__ const bf16_t* safe() const { return src; }
    __device__ __forceinline__ int koff(int k0) const { const int k = kbase + k0; return (k >> 7) * B_MAIN + (k & 127); }
};
struct BPlain {           static constexpr bool IS_BF16 = false;
    const float* base; size_t ldb; int n0; int nlim;
    __device__ __forceinline__ const float* colptr(int nl) const { const int c = n0 + nl; return c < nlim ? base + c : nullptr; }
    __device__ __forceinline__ const float* safe() const { return base; }
    __device__ __forceinline__ const bf16_t* bt16() const { return nullptr; }
};
struct BGateUp {          static constexpr bool IS_BF16 = false;
    const float* wg; long long du; size_t ldb; int c0;
    __device__ __forceinline__ const float* colptr(int nl) const {
        const int wc = nl >> 6, q = (nl >> 4) & 3, w = nl & 15; const int col = c0 + wc * 32 + (q & 1) * 16 + w;
        return wg + (long long)(q >> 1) * du + col;
    }
    __device__ __forceinline__ const float* safe() const { return wg; }
    __device__ __forceinline__ const bf16_t* bt16() const { return nullptr; }
};

struct BGateUp256 {
    static constexpr int HROW = 64;
    const float* wg; long long du; size_t ldb; int c0;
    __device__ __forceinline__ const float* base(int hh) const { return wg + (hh ? du : 0ll) + c0; }
    static __device__ __forceinline__ int wrow(int wq) { return (wq >> 1) * 128 + (wq & 1) * 32; }
};
struct BPlain256 {
    static constexpr int HROW = 128;
    const float* wbase; size_t ldb; int n0;
    __device__ __forceinline__ const float* base(int hh) const { return wbase + n0 + 128 * hh; }
    static __device__ __forceinline__ int wrow(int wq) { return wq * 32; }
};
struct EpSiluMul256 {
    bf16_t* out; int row0; int c0;
    __device__ __forceinline__ void operator()(const f32x4 (&acc)[4][8], int wr, int wc, int fr, int fq) const {
#pragma unroll
        for (int m = 0; m < 4; ++m) { const int r = row0 + wr * 64 + m * 16 + fr;
#pragma unroll
            for (int n = 0; n < 4; ++n) { const int c = c0 + wc * 64 + n * 16 + fq * 4; float hh[4];
#pragma unroll
                for (int j = 0; j < 4; ++j) { const float g = acc[m][n][j]; hh[j] = g / (1.f + __expf(-g)) * acc[m][n + 4][j]; }
                u32x2 w; w.x = cvtpk(hh[0], hh[1]); w.y = cvtpk(hh[2], hh[3]);
                *(u32x2*)(out + (size_t)r * D_EXPERT + c) = w; } }
    }
};
struct EpScaleRow256 {
    bf16_t* out; const float* roww; int rw0; int cnt; int row0; int col0;
    __device__ __forceinline__ void operator()(const f32x4 (&acc)[4][8], int wr, int wc, int fr, int fq) const {
#pragma unroll
        for (int m = 0; m < 4; ++m) { const int rl = wr * 64 + m * 16 + fr; const float s = (rw0 + rl < cnt) ? roww[rw0 + rl] : 0.f; const int r = row0 + rl;
#pragma unroll
            for (int n = 0; n < 8; ++n) { const int c = col0 + wc * 128 + n * 16 + fq * 4;
                u32x2 w; w.x = cvtpk(acc[m][n][0] * s, acc[m][n][1] * s); w.y = cvtpk(acc[m][n][2] * s, acc[m][n][3] * s);
                *(u32x2*)(out + (size_t)r * D_MODEL + c) = w; } }
    }
};
struct BBf16T {           static constexpr bool IS_BF16 = true;
    const bf16_t* base; size_t ldb; int n0;
    __device__ __forceinline__ const float* colptr(int) const { return nullptr; }
    __device__ __forceinline__ const float* safe() const { return nullptr; }
    __device__ __forceinline__ const bf16_t* bt16() const { return base + (size_t)n0 * ldb; }
};
struct EpBf16 {
    bf16_t* out; int ldc; int row0; int col0; int mlim; int nlim;
    __device__ __forceinline__ void operator()(const f32x4 (&acc)[4][4], int wr, int wc, int fr, int fq) const {
#pragma unroll
        for (int m = 0; m < 4; ++m) { const int r = row0 + wr * 64 + m * 16 + fr; if (r >= mlim) continue;
#pragma unroll
            for (int n = 0; n < 4; ++n) { const int c = col0 + wc * 64 + n * 16 + fq * 4; if (c >= nlim) continue;
                u32x2 w; w.x = cvtpk(acc[m][n][0], acc[m][n][1]); w.y = cvtpk(acc[m][n][2], acc[m][n][3]);
                *(u32x2*)(out + (size_t)r * ldc + c) = w; } }
    }
};
struct EpResF32 {
    float* out; const float* res; int ldc; int row0; int col0;
    __device__ __forceinline__ void operator()(const f32x4 (&acc)[4][4], int wr, int wc, int fr, int fq) const {
#pragma unroll
        for (int m = 0; m < 4; ++m) { const int r = row0 + wr * 64 + m * 16 + fr;
#pragma unroll
            for (int n = 0; n < 4; ++n) { const int c = col0 + wc * 64 + n * 16 + fq * 4;
                const f32x4 rv = *(const f32x4*)(res + (size_t)r * ldc + c);
                *(f32x4*)(out + (size_t)r * ldc + c) = rv + acc[m][n]; } }
    }
};
struct EpF32 {
    float* out; int ldc; int row0; int col0;
    __device__ __forceinline__ void operator()(const f32x4 (&acc)[4][4], int wr, int wc, int fr, int fq) const {
#pragma unroll
        for (int m = 0; m < 4; ++m) { const int r = row0 + wr * 64 + m * 16 + fr;
#pragma unroll
            for (int n = 0; n < 4; ++n) { const int c = col0 + wc * 64 + n * 16 + fq * 4; *(f32x4*)(out + (size_t)r * ldc + c) = acc[m][n]; } }
    }
};
struct EpProj {
    bf16_t* out; float* gate; int row0; int col0;
    __device__ __forceinline__ void operator()(const f32x4 (&acc)[4][4], int wr, int wc, int fr, int fq) const {
#pragma unroll
        for (int m = 0; m < 4; ++m) { const int r = row0 + wr * 64 + m * 16 + fr;
#pragma unroll
            for (int n = 0; n < 4; ++n) { const int c = col0 + wc * 64 + n * 16 + fq * 4;
                if (c < B_MAIN) { u32x2 w; w.x = cvtpk(acc[m][n][0], acc[m][n][1]); w.y = cvtpk(acc[m][n][2], acc[m][n][3]);
                    *(u32x2*)(out + (size_t)r * B_MAIN + c) = w; }
                else if (c < B_IN) { f32x4 g;
#pragma unroll
                    for (int j = 0; j < 4; ++j) g[j] = 1.f / (1.f + __expf(-acc[m][n][j]));
                    *(f32x4*)(gate + (size_t)r * 48 + (c - B_MAIN)) = g; } } }
    }
};
struct EpSiluMul {
    bf16_t* out; int row0; int c0;
    __device__ __forceinline__ void operator()(const f32x4 (&acc)[4][4], int wr, int wc, int fr, int fq) const {
#pragma unroll
        for (int m = 0; m < 4; ++m) { const int r = row0 + wr * 64 + m * 16 + fr;
#pragma unroll
            for (int n = 0; n < 2; ++n) { const int c = c0 + wc * 32 + n * 16 + fq * 4; float h[4];
#pragma unroll
                for (int j = 0; j < 4; ++j) { const float g = acc[m][n][j]; h[j] = g / (1.f + __expf(-g)) * acc[m][n + 2][j]; }
                u32x2 w; w.x = cvtpk(h[0], h[1]); w.y = cvtpk(h[2], h[3]);
                *(u32x2*)(out + (size_t)r * D_EXPERT + c) = w; } }
    }
};
struct EpScaleRow {
    bf16_t* out; const float* roww; int rw0; int cnt; int row0; int col0;
    __device__ __forceinline__ void operator()(const f32x4 (&acc)[4][4], int wr, int wc, int fr, int fq) const {
#pragma unroll
        for (int m = 0; m < 4; ++m) { const int rl = wr * 64 + m * 16 + fr; const float s = (rw0 + rl < cnt) ? roww[rw0 + rl] : 0.f; const int r = row0 + rl;
#pragma unroll
            for (int n = 0; n < 4; ++n) { const int c = col0 + wc * 64 + n * 16 + fq * 4;
                u32x2 w; w.x = cvtpk(acc[m][n][0] * s, acc[m][n][1] * s); w.y = cvtpk(acc[m][n][2] * s, acc[m][n][3] * s);
                *(u32x2*)(out + (size_t)r * D_MODEL + c) = w; } }
    }
};
__device__ __forceinline__ float gelu_tanh(float x) {
    const float u = 0.7978845608028654f * (x + 0.044715f * x * x * x);
    const float e = __expf(2.f * u); const float t = 1.f - 2.f / (e + 1.f);
    return 0.5f * x * (1.f + t);
}
struct EpGeluBias {
    bf16_t* out; const float* bias; int row0; int col0;
    __device__ __forceinline__ void operator()(const f32x4 (&acc)[4][4], int wr, int wc, int fr, int fq) const {
#pragma unroll
        for (int m = 0; m < 4; ++m) { const int r = row0 + wr * 64 + m * 16 + fr;
#pragma unroll
            for (int n = 0; n < 4; ++n) { const int c = col0 + wc * 64 + n * 16 + fq * 4; const f32x4 bv = *(const f32x4*)(bias + c); float h[4];
#pragma unroll
                for (int j = 0; j < 4; ++j) h[j] = gelu_tanh(acc[m][n][j] + bv[j]);
                u32x2 w; w.x = cvtpk(h[0], h[1]); w.y = cvtpk(h[2], h[3]);
                *(u32x2*)(out + (size_t)r * 256 + c) = w; } }
    }
};

__device__ __forceinline__ void stage_rc(int b, int& R, int& C) { const int st = b / 1024, sb = b % 1024, swz = sb ^ (((sb >> 9) & 1) << 5); R = (st >> 1) * 16 + swz / 64; C = (st & 1) * 32 + (swz % 64) / 2; }
#define G8_HT 16384
template <bool GATHER, class EP>
__device__ __forceinline__ void gemm8_unit(const bf16_t* __restrict__ A, const unsigned (&ao)[2][2], const int lda, const bf16_t* __restrict__ Bt, const unsigned (&bo2)[2], const int K, char* lds, const EP& ep, const bool hi_act) {
    const int tid = tidx(), wid = tid >> 6, lane = tid & 63, wr = wid >> 2, wc = wid & 3, fr = lane & 15, fq = lane >> 4;
#define SA(b, h) (((b) * 2 + (h)) * G8_HT)
#define SB(b, h) ((4 + (b) * 2 + (h)) * G8_HT)
#define STG(P, BASE, OFF, kt) do { const bf16_t* g_ = (BASE) + (kt) * 64; \
        __builtin_amdgcn_global_load_lds((const unsigned*)(g_ + (OFF)[0]), (unsigned*)(lds + (P) + tid * 16), 16, 0, 0); \
        __builtin_amdgcn_global_load_lds((const unsigned*)(g_ + (OFF)[1]), (unsigned*)(lds + (P) + 8192 + tid * 16), 16, 0, 0); } while (0)
#define LDA(dst, b, h) _Pragma("unroll") for (int m = 0; m < 4; ++m) _Pragma("unroll") for (int k = 0; k < 2; ++k) \
        dst[m][k] = *reinterpret_cast<const bf16x8*>(lds + SA(b, h) + fa_base + m * 2048 + k * 1024)
#define LDB(dst, b, h) _Pragma("unroll") for (int n = 0; n < 2; ++n) _Pragma("unroll") for (int k = 0; k < 2; ++k) \
        dst[n][k] = *reinterpret_cast<const bf16x8*>(lds + SB(b, h) + fb_base + n * 2048 + k * 1024)
#define MMA(ai, bj, At_, Bt_) do { __builtin_amdgcn_s_setprio(1); \
        _Pragma("unroll") for (int m = 0; m < 4; ++m) _Pragma("unroll") for (int n = 0; n < 2; ++n) _Pragma("unroll") for (int k = 0; k < 2; ++k) \
            acc[ai][bj][m][n] = __builtin_amdgcn_mfma_f32_16x16x32_bf16(Bt_[n][k], At_[m][k], acc[ai][bj][m][n], 0, 0, 0); \
        __builtin_amdgcn_s_setprio(0); } while (0)
#define MMAH(bj, At_, Bt_) do { if (hi_act) MMA(1, bj, At_, Bt_); } while (0)
#define WAIT_V(n) asm volatile("s_waitcnt vmcnt(" #n ")" ::: "memory")
#define WAIT_L(n) asm volatile("s_waitcnt lgkmcnt(" #n ")" ::: "memory")
#define BAR __builtin_amdgcn_s_barrier()
#define SCHED __builtin_amdgcn_sched_barrier(0)
    const int fa_base = lds_byte(wr * 64 + fr, fq * 8), fb_base = lds_byte(wc * 32 + fr, fq * 8);
    f32x4 acc[2][2][4][2];
#pragma unroll
    for (int a = 0; a < 2; ++a)
#pragma unroll
        for (int b = 0; b < 2; ++b)
#pragma unroll
            for (int m = 0; m < 4; ++m)
#pragma unroll
                for (int n = 0; n < 2; ++n) acc[a][b][m][n] = (f32x4){0.f, 0.f, 0.f, 0.f};
    bf16x8 At[4][2], B0[2][2], B1[2][2];
    const int nt = K / 64;
    const bf16_t* Bt1 = Bt + (size_t)128 * K;
    const bf16_t* A1 = GATHER ? A : A + (size_t)128 * lda;
#define AO1 ao[GATHER ? 1 : 0]
    STG(SB(0, 0), Bt, bo2, 0); STG(SA(0, 0), A, ao[0], 0);
    STG(SB(0, 1), Bt1, bo2, 0); STG(SA(0, 1), A1, AO1, 0);
    if (wr == 1) BAR;
    WAIT_V(4); BAR;
    STG(SB(1, 0), Bt, bo2, 1); STG(SA(1, 0), A, ao[0], 1); STG(SB(1, 1), Bt1, bo2, 1);
    WAIT_V(6); BAR;
    for (int t = 0; t < nt - 2; t += 2) {
        LDB(B0, 0, 0); SCHED; LDA(At, 0, 0); STG(SA(1, 1), A1, AO1, t + 1);
        WAIT_L(8); BAR; WAIT_L(0); MMA(0, 0, At, B0); BAR; SCHED;
        LDB(B1, 0, 1); STG(SB(0, 0), Bt, bo2, t + 2);
        BAR; WAIT_L(0); MMA(0, 1, At, B1); BAR;
        LDA(At, 0, 1); STG(SA(0, 0), A, ao[0], t + 2);
        BAR; WAIT_L(0); MMAH(0, At, B0); BAR; SCHED;
        STG(SB(0, 1), Bt1, bo2, t + 2);
        WAIT_V(6); BAR; MMAH(1, At, B1); BAR;
        LDB(B0, 1, 0); SCHED; LDA(At, 1, 0); STG(SA(0, 1), A1, AO1, t + 2);
        WAIT_L(8); BAR; WAIT_L(0); MMA(0, 0, At, B0); BAR; SCHED;
        LDB(B1, 1, 1); STG(SB(1, 0), Bt, bo2, t + 3);
        BAR; WAIT_L(0); MMA(0, 1, At, B1); BAR;
        LDA(At, 1, 1); STG(SA(1, 0), A, ao[0], t + 3);
        BAR; WAIT_L(0); MMAH(0, At, B0); BAR; SCHED;
        STG(SB(1, 1), Bt1, bo2, t + 3);
        WAIT_V(6); BAR; MMAH(1, At, B1); BAR;
    }
    { LDB(B0, 0, 0); WAIT_V(0); LDA(At, 0, 0); STG(SA(1, 1), A1, AO1, nt - 1);
      BAR; WAIT_L(0); MMA(0, 0, At, B0); BAR;
      LDB(B1, 0, 1); BAR; WAIT_L(0); MMA(0, 1, At, B1); BAR;
      LDA(At, 0, 1); WAIT_V(4); BAR; WAIT_L(0); MMAH(0, At, B0); MMAH(1, At, B1); BAR; }
    { LDB(B0, 1, 0); LDA(At, 1, 0); WAIT_V(2); BAR; WAIT_L(0); MMA(0, 0, At, B0); BAR;
      LDB(B1, 1, 1); WAIT_V(0); BAR; WAIT_L(0); MMA(0, 1, At, B1); BAR;
      LDA(At, 1, 1); BAR; WAIT_L(0); MMAH(0, At, B0); MMAH(1, At, B1); BAR; }
    if (wr == 0) BAR;
    ep(acc, wr, wc, fr, fq);
    __syncthreads();
#undef SA
#undef AO1
#undef SB
#undef STG
#undef LDA
#undef LDB
#undef MMA
#undef MMAH
#undef WAIT_V
#undef WAIT_L
#undef BAR
#undef SCHED
}
__device__ __forceinline__ void g8_offsets2(unsigned (&o)[2], int row0, int ld) {
    const int tid = tidx();
#pragma unroll
    for (int i = 0; i < 2; ++i) { int R, C; stage_rc(tid * 16 + i * 8192, R, C); o[i] = (unsigned)((row0 + R) * ld + C); }
}
__device__ __forceinline__ void g8_offsets2_perm(unsigned (&o)[2], int row0, int ld) {
    const int tid = tidx();
#pragma unroll
    for (int i = 0; i < 2; ++i) { int R, C; stage_rc(tid * 16 + i * 8192, R, C); const int rho = R & 31, nn = rho >> 4, ii = rho & 15;
        const int Rp = (R & ~31) + 8 * (ii >> 2) + 4 * nn + (ii & 3); o[i] = (unsigned)((row0 + Rp) * ld + C); }
}
__device__ __forceinline__ void g8_offsets(unsigned (&o)[2][2], int row0, int ld) {
    const int tid = tidx();
#pragma unroll
    for (int i = 0; i < 2; ++i) { int R, C; stage_rc(tid * 16 + i * 8192, R, C);
#pragma unroll
        for (int h = 0; h < 2; ++h) o[h][i] = (unsigned)((row0 + h * 128 + R) * ld + C); }
}
__device__ __forceinline__ int wgid_v(char* lds) {
#if N_LAUNCH_MODE == 1
    return __builtin_amdgcn_readfirstlane((int)((volatile LAS unsigned*)(lds + LDS_BYTES - 16))[2]);
#else
    (void)lds; return (int)blockIdx.x;
#endif
}
__device__ __forceinline__ void g8_order_c(int L, int nM, int nN, int& pm, int& pn) {
    const int nig = 8 * nN, gid = L / nig, fm = gid * 8, gsz = (nM - fm) < 8 ? (nM - fm) : 8;
    pm = fm + ((L % nig) % gsz); pn = (L % nig) / gsz;
}
__device__ __forceinline__ void g8_order(int L, int nM, int nN, int& pm, int& pn) {
    const int nwg = nM * nN; int wgid = L; { const int q = nwg / 8, r = nwg % 8, xcd = wgid % 8, off = wgid / 8; wgid = (xcd < r ? xcd * (q + 1) : r * (q + 1) + (xcd - r) * q) + off; }
    const int nig = 8 * nN, gid = wgid / nig, fm = gid * 8, gsz = (nM - fm) < 8 ? (nM - fm) : 8;
    pm = fm + ((wgid % nig) % gsz); pn = (wgid % nig) / gsz;
}
struct E8Bf16 {
    bf16_t* out; int ldc; int row0; int col0; int nlim;
    __device__ __forceinline__ void operator()(const f32x4 (&acc)[2][2][4][2], int wr, int wc, int fr, int fq) const {
#pragma unroll
        for (int ai = 0; ai < 2; ++ai)
#pragma unroll
            for (int m = 0; m < 4; ++m) { const int r = row0 + ai * 128 + wr * 64 + m * 16 + fr;
#pragma unroll
                for (int bj = 0; bj < 2; ++bj) { const int c = col0 + bj * 128 + wc * 32 + 8 * fq; if (c >= nlim) continue;
                    const f32x4 v0 = acc[ai][bj][m][0], v1 = acc[ai][bj][m][1];
                    u32x4 w; w.x = cvtpk(v0[0], v0[1]); w.y = cvtpk(v0[2], v0[3]); w.z = cvtpk(v1[0], v1[1]); w.w = cvtpk(v1[2], v1[3]);
                    *(u32x4*)(out + (size_t)r * ldc + c) = w; } }
    }
};
template <bool RB>
struct E8ResBf16 {
    bf16_t* out; const void* res; int row0; int col0;
    __device__ __forceinline__ void operator()(const f32x4 (&acc)[2][2][4][2], int wr, int wc, int fr, int fq) const {
#pragma unroll
        for (int ai = 0; ai < 2; ++ai)
#pragma unroll
            for (int m = 0; m < 4; ++m) { const int r = row0 + ai * 128 + wr * 64 + m * 16 + fr;
#pragma unroll
                for (int bj = 0; bj < 2; ++bj) { const int c = col0 + bj * 128 + wc * 32 + 8 * fq;
                    f32x4 r0, r1;
                    if (RB) { const u32x4 rw = *(const u32x4*)((const bf16_t*)res + (size_t)r * D_MODEL + c);
                        r0[0] = __uint_as_float(rw.x << 16); r0[1] = __uint_as_float(rw.x & 0xffff0000u); r0[2] = __uint_as_float(rw.y << 16); r0[3] = __uint_as_float(rw.y & 0xffff0000u);
                        r1[0] = __uint_as_float(rw.z << 16); r1[1] = __uint_as_float(rw.z & 0xffff0000u); r1[2] = __uint_as_float(rw.w << 16); r1[3] = __uint_as_float(rw.w & 0xffff0000u); }
                    else { r0 = *(const f32x4*)((const float*)res + (size_t)r * D_MODEL + c); r1 = *(const f32x4*)((const float*)res + (size_t)r * D_MODEL + c + 4); }
                    const f32x4 v0 = r0 + acc[ai][bj][m][0], v1 = r1 + acc[ai][bj][m][1];
                    u32x4 w; w.x = cvtpk(v0[0], v0[1]); w.y = cvtpk(v0[2], v0[3]); w.z = cvtpk(v1[0], v1[1]); w.w = cvtpk(v1[2], v1[3]);
                    *(u32x4*)(out + (size_t)r * D_MODEL + c) = w; } }
    }
};
struct E8Proj {
    bf16_t* out; float* gate; int row0; int col0;
    __device__ __forceinline__ void operator()(const f32x4 (&acc)[2][2][4][2], int wr, int wc, int fr, int fq) const {
#pragma unroll
        for (int ai = 0; ai < 2; ++ai)
#pragma unroll
            for (int m = 0; m < 4; ++m) { const int r = row0 + ai * 128 + wr * 64 + m * 16 + fr;
#pragma unroll
                for (int bj = 0; bj < 2; ++bj) { const int c = col0 + bj * 128 + wc * 32 + 8 * fq; const f32x4 v0 = acc[ai][bj][m][0], v1 = acc[ai][bj][m][1];
                    if (c < B_MAIN) { u32x4 w; w.x = cvtpk(v0[0], v0[1]); w.y = cvtpk(v0[2], v0[3]); w.z = cvtpk(v1[0], v1[1]); w.w = cvtpk(v1[2], v1[3]);
                        *(u32x4*)(out + (size_t)r * B_MAIN + c) = w; }
                    else if (c < B_IN) { f32x4 g0, g1;
#pragma unroll
                        for (int j = 0; j < 4; ++j) { g0[j] = 1.f / (1.f + __expf(-v0[j])); g1[j] = 1.f / (1.f + __expf(-v1[j])); }
                        *(f32x4*)(gate + (size_t)r * 48 + (c - B_MAIN)) = g0; *(f32x4*)(gate + (size_t)r * 48 + (c - B_MAIN) + 4) = g1; } } }
    }
};
template <int MODE>
__device__ __forceinline__ void convert_weight(const float* __restrict__ src, const int K, const int N, bf16_t* __restrict__ dst, int& job, const int stride, char* lds) {
    (void)lds;
    const int tid = tidx(), kb = (tid >> 2) & 7, nb = (tid & 3) + 4 * (tid >> 5); const int nK = K / 64, nN = (N + 255) / 256; const int njobs = nK * nN;
    for (; job < njobs;) {
        const int j1 = job + stride; const bool two = j1 < njobs;
        const int kt0 = job % nK, nt0 = job / nK, kt1 = two ? j1 % nK : kt0, nt1 = two ? j1 / nK : nt0;
        f32x4 v[2][8];
#pragma unroll
        for (int jj = 0; jj < 2; ++jj) { const int kt = jj ? kt1 : kt0, ntl = jj ? nt1 : nt0;
            const int n = ntl * 256 + nb * 4; const float* s = src + (size_t)(kt * 64 + 8 * kb) * N + n;
#pragma unroll
            for (int i = 0; i < 8; ++i) v[jj][i] = n < N ? *(const f32x4*)(s + (size_t)i * N) : (f32x4){0.f, 0.f, 0.f, 0.f}; }
#pragma unroll
        for (int jj = 0; jj < 2; ++jj) { if (jj == 1 && !two) break;
            const int kt = jj ? kt1 : kt0, ntl = jj ? nt1 : nt0; const int n = ntl * 256 + nb * 4;
#pragma unroll
            for (int j = 0; j < 4; ++j) { const int ng = n + j;
                const int drow = MODE == 0 ? ng : ((ng >> 7) * 256 + (ng & 127) + (MODE == 2 ? 128 : 0));
                u32x4 w; w.x = cvtpk(v[jj][0][j], v[jj][1][j]); w.y = cvtpk(v[jj][2][j], v[jj][3][j]); w.z = cvtpk(v[jj][4][j], v[jj][5][j]); w.w = cvtpk(v[jj][6][j], v[jj][7][j]);
                *(u32x4*)(dst + (size_t)drow * K + kt * 64 + 8 * kb) = w; } }
        job += two ? 2 * stride : stride;
    }
    job -= njobs;
}
struct E8SiluMul {
    bf16_t* out; int row0; int c0;
    __device__ __forceinline__ void operator()(const f32x4 (&acc)[2][2][4][2], int wr, int wc, int fr, int fq) const {
#pragma unroll
        for (int ai = 0; ai < 2; ++ai)
#pragma unroll
            for (int m = 0; m < 4; ++m) { const int r = row0 + ai * 128 + wr * 64 + m * 16 + fr;
#pragma unroll
                for (int n = 0; n < 2; ++n) { const int c = c0 + wc * 32 + n * 16 + fq * 4; float h[4];
#pragma unroll
                    for (int j = 0; j < 4; ++j) { const float g = acc[ai][0][m][n][j]; h[j] = g / (1.f + __expf(-g)) * acc[ai][1][m][n][j]; }
                    u32x2 w; w.x = cvtpk(h[0], h[1]); w.y = cvtpk(h[2], h[3]);
                    *(u32x2*)(out + (size_t)r * D_EXPERT + c) = w; } }
    }
};
struct E8ScaleRow {
    bf16_t* out; const float* roww; int rw0; int cnt; int row0; int col0;
    __device__ __forceinline__ void operator()(const f32x4 (&acc)[2][2][4][2], int wr, int wc, int fr, int fq) const {
#pragma unroll
        for (int ai = 0; ai < 2; ++ai)
#pragma unroll
            for (int m = 0; m < 4; ++m) { const int rl = ai * 128 + wr * 64 + m * 16 + fr; const float s = (rw0 + rl < cnt) ? roww[rw0 + rl] : 0.f; const int r = row0 + rl;
#pragma unroll
                for (int bj = 0; bj < 2; ++bj)
#pragma unroll
                    for (int n = 0; n < 2; ++n) { const int c = col0 + bj * 128 + wc * 32 + n * 16 + fq * 4; const f32x4 v = acc[ai][bj][m][n];
                        u32x2 w; w.x = cvtpk(v[0] * s, v[1] * s); w.y = cvtpk(v[2] * s, v[3] * s);
                        *(u32x2*)(out + (size_t)r * D_MODEL + c) = w; } }
    }
};

template <int WHICH>
__device__ __forceinline__ void moe_convert(CParams& p, const int le0, const int le1, char* lds, int job = -1, int stride = 0) {
    if (job < 0) { job = blockIdx.x; stride = gridDim.x; }
#pragma unroll 1
    for (int le = le0; le < le1; ++le) {
        if (WHICH & 1) {
            convert_weight<1>(p.moe_w_gate + (size_t)le * D_MODEL * D_EXPERT, D_MODEL, D_EXPERT, p.wgu_t + (size_t)le * 2048 * 2048, job, stride, lds);
            convert_weight<2>(p.moe_w_up + (size_t)le * D_MODEL * D_EXPERT, D_MODEL, D_EXPERT, p.wgu_t + (size_t)le * 2048 * 2048, job, stride, lds); }
        if (WHICH & 2)
            convert_weight<0>(p.moe_w_down + (size_t)le * D_EXPERT * D_MODEL, D_EXPERT, D_MODEL, p.wd_t + (size_t)le * 2048 * 1024, job, stride, lds);
    }
    __syncthreads();
}
#define KSWZ(row, colB) ((row) * 256 + ((colB) ^ (((row) & 7) << 4)))
#define SBAR() __builtin_amdgcn_sched_barrier(0)
#define TILE_B 16384
__device__ __forceinline__ int v_rd_base(int lane) { return ((lane & 3) << 3) | (((lane >> 2) & 3) << 6) | (((lane >> 4) & 1) << 5) | (((lane >> 5) & 1) << 8); }
constexpr int v_rd_off(int d0, int ks, int half) { return d0 * 512 + ks * 4096 + half * 2048; }
__device__ __forceinline__ int crow(int r, int hi) { return (r & 3) + 8 * (r >> 2) + 4 * hi; }

__device__ __forceinline__ unsigned fill_koff(int tid, int ld) { const int row = tid >> 4, cp = tid & 15; return (unsigned)(row * ld + ((cp ^ (row & 7)) << 3)); }
__device__ __forceinline__ unsigned fill_voff(int tid, int ld) { const int L = tid; const int kk = ((L >> 7) << 3) | ((L >> 2) & 7), c = (((L >> 5) & 3) << 5) | ((L & 3) << 3);
    const int k = (kk & ~0xC) | ((kk & 4) << 1) | ((kk & 8) >> 1); return (unsigned)(k * ld + c); }
__device__ __forceinline__ void fill_tile(const bf16_t* src, unsigned off, int ld, char* dst, int tid) {
    __builtin_amdgcn_global_load_lds((const unsigned*)(src + off), (unsigned*)(dst + tid * 16), 16, 0, 0);
    __builtin_amdgcn_global_load_lds((const unsigned*)(src + 32 * ld + off), (unsigned*)(dst + 8192 + tid * 16), 16, 0, 0);
}
__device__ __forceinline__ void qkt(f32x16& p0, f32x16& p1, const char* Kt, int r32, int hi, const bf16x8* qr) {
    p0 = f32x16{}; p1 = f32x16{};
    const char* kb[4];
#pragma unroll
    for (int dd = 0; dd < 4; ++dd) kb[dd] = Kt + KSWZ(r32, (dd * 16 + hi * 8) * 2);
    __builtin_amdgcn_s_setprio(1);
#pragma unroll
    for (int d0 = 0; d0 < 8; ++d0) { const char* a = kb[d0 & 3] + (d0 >> 2) * 128;
        bf16x8 b0 = *reinterpret_cast<const bf16x8*>(a);
        bf16x8 b1 = *reinterpret_cast<const bf16x8*>(a + 32 * 256);
        p0 = __builtin_amdgcn_mfma_f32_32x32x16_bf16(b0, qr[d0], p0, 0, 0, 0);
        p1 = __builtin_amdgcn_mfma_f32_32x32x16_bf16(b1, qr[d0], p1, 0, 0, 0); }
    __builtin_amdgcn_s_setprio(0);
}
__device__ __forceinline__ void qkt_lds(f32x16& p0, f32x16& p1, const char* Kt, int r32, int hi, const char* qb) {
    p0 = f32x16{}; p1 = f32x16{};
    const char* kb[4];
#pragma unroll
    for (int dd = 0; dd < 4; ++dd) kb[dd] = Kt + KSWZ(r32, (dd * 16 + hi * 8) * 2);
#pragma unroll
    for (int d0 = 0; d0 < 8; ++d0) { const char* a = kb[d0 & 3] + (d0 >> 2) * 128;
        bf16x8 b0 = *reinterpret_cast<const bf16x8*>(a);
        bf16x8 b1 = *reinterpret_cast<const bf16x8*>(a + 32 * 256);
        bf16x8 q = *reinterpret_cast<const bf16x8*>(qb + d0 * 1024);
        p0 = __builtin_amdgcn_mfma_f32_32x32x16_bf16(b0, q, p0, 0, 0, 0);
        p1 = __builtin_amdgcn_mfma_f32_32x32x16_bf16(b1, q, p1, 0, 0, 0); }
}
__device__ __forceinline__ void pv_tile(f32x16* o, int vb0, bf16x8 pa0, bf16x8 pa1, bf16x8 pa2, bf16x8 pa3) {
#define TRRD(dst, off) asm volatile("ds_read_b64_tr_b16 %0, %1 offset:%2" : "=&v"(dst) : "v"(vb0), "i"(off) : "memory")
#define PV_D0(d0) do { s16x4 l0, l1, l2, l3, h0, h1, h2, h3; constexpr int b_ = v_rd_off(d0, 0, 0); \
        TRRD(l0, b_); TRRD(h0, b_ + 2048); TRRD(l1, b_ + 4096); TRRD(h1, b_ + 6144); TRRD(l2, b_ + 8192); TRRD(h2, b_ + 10240); TRRD(l3, b_ + 12288); TRRD(h3, b_ + 14336); \
        asm volatile("s_waitcnt lgkmcnt(0)" ::: "memory"); SBAR(); \
        o[d0] = __builtin_amdgcn_mfma_f32_32x32x16_bf16(pa0, (bf16x8){l0[0], l0[1], l0[2], l0[3], h0[0], h0[1], h0[2], h0[3]}, o[d0], 0, 0, 0); \
        o[d0] = __builtin_amdgcn_mfma_f32_32x32x16_bf16(pa1, (bf16x8){l1[0], l1[1], l1[2], l1[3], h1[0], h1[1], h1[2], h1[3]}, o[d0], 0, 0, 0); \
        o[d0] = __builtin_amdgcn_mfma_f32_32x32x16_bf16(pa2, (bf16x8){l2[0], l2[1], l2[2], l2[3], h2[0], h2[1], h2[2], h2[3]}, o[d0], 0, 0, 0); \
        o[d0] = __builtin_amdgcn_mfma_f32_32x32x16_bf16(pa3, (bf16x8){l3[0], l3[1], l3[2], l3[3], h3[0], h3[1], h3[2], h3[3]}, o[d0], 0, 0, 0); } while (0)
    __builtin_amdgcn_s_setprio(1);
    PV_D0(0); PV_D0(1); PV_D0(2); PV_D0(3);
    __builtin_amdgcn_s_setprio(0);
#undef PV_D0
#undef TRRD
}
__device__ __forceinline__ float half_max(float v) { auto rr = __builtin_amdgcn_permlane32_swap(__float_as_uint(v), __float_as_uint(v), false, false); return fmaxf(__uint_as_float(rr[0]), __uint_as_float(rr[1])); }
__device__ __forceinline__ float half_sum(float v) { auto rr = __builtin_amdgcn_permlane32_swap(__float_as_uint(v), __float_as_uint(v), false, false); return __uint_as_float(rr[0]) + __uint_as_float(rr[1]); }
__device__ __forceinline__ void pack_p(const f32x16& p0, const f32x16& p1, bf16x8& pa0, bf16x8& pa1, bf16x8& pa2, bf16x8& pa3) {
#define PK4(P, B_, OUT) do { unsigned a0 = cvtpk(P[B_+0], P[B_+1]), a1 = cvtpk(P[B_+2], P[B_+3]);                          \
        unsigned b0 = cvtpk(P[B_+4], P[B_+5]), b1 = cvtpk(P[B_+6], P[B_+7]);                                             \
        auto r0 = __builtin_amdgcn_permlane32_swap(a0, b0, false, false); auto r1 = __builtin_amdgcn_permlane32_swap(a1, b1, false, false); \
        u32x4 w = {r0[0], r1[0], r0[1], r1[1]}; OUT = *reinterpret_cast<bf16x8*>(&w); } while (0)
    PK4(p0, 0, pa0); PK4(p0, 8, pa1); PK4(p1, 0, pa2); PK4(p1, 8, pa3);
#undef PK4
}
__device__ __forceinline__ float online_sm(f32x16& p0, f32x16& p1, float& m_reg, float& l_reg) {
    float pmax = p0[0];
#pragma unroll
    for (int r = 1; r < 16; ++r) pmax = fmaxf(pmax, p0[r]);
#pragma unroll
    for (int r = 0; r < 16; ++r) pmax = fmaxf(pmax, p1[r]);
    pmax = half_max(pmax);
    float mn, alpha;
    if (__all(pmax - m_reg <= 8.f)) { mn = m_reg; alpha = 1.f; }
    else { mn = fmaxf(m_reg, pmax); alpha = __builtin_amdgcn_exp2f(m_reg - mn); m_reg = mn; }
    float ps = 0.f;
#pragma unroll
    for (int r = 0; r < 16; ++r) { p0[r] = __builtin_amdgcn_exp2f(p0[r] - mn); ps += p0[r]; }
#pragma unroll
    for (int r = 0; r < 16; ++r) { p1[r] = __builtin_amdgcn_exp2f(p1[r] - mn); ps += p1[r]; }
    ps = half_sum(ps);
    l_reg = l_reg * alpha + ps;
    return alpha;
}
#define ROWX(scr, val, out16) do { if (hi == 0) (scr)[r32] = (val); asm volatile("s_waitcnt lgkmcnt(0)" ::: "memory"); \
        _Pragma("unroll") for (int r_ = 0; r_ < 16; ++r_) (out16)[r_] = (scr)[crow(r_, hi)]; asm volatile("s_waitcnt lgkmcnt(0)" ::: "memory"); } while (0)

__device__ __forceinline__ void diff_attn_unit(CParams& p, const int b, const int h, const int qb, char* lds, const float lam, const float one_m_li) {
    const int tid = tidx(), wid = __builtin_amdgcn_readfirstlane(tid >> 6), lane = tid & 63, r32 = lane & 31, hi = lane >> 5;
    const int rg = wid & 3, comp = wid >> 2;
    const int P0 = qb * 128, qlo = P0 + rg * 32, qpos = qlo + r32;
    const bf16_t* base = p.qkv + (size_t)b * SEQ * A_IN;
    const bf16_t* Kc0 = base + 2048 + (h * 2 + 0) * 128;
    const bf16_t* Vb = base + 4096 + h * 256;
    bf16x8 qr[8];
    { const bf16_t* qp = base + (size_t)qpos * A_IN + (h * 2 + comp) * 128 + hi * 8;
#pragma unroll
        for (int d0 = 0; d0 < 8; ++d0) qr[d0] = *(const bf16x8*)(qp + d0 * 16); }
    const int NT = 2 * qb + 2;
    const float slope = exp2f(-(float)(h + 1));
    const float C2 = 1.4426950408889634f * 0.08838834764831845f, sl2 = 1.4426950408889634f * slope;
    float m_reg = -1e30f, l_reg = 0.f; f32x16 o[8];
#pragma unroll
    for (int d = 0; d < 8; ++d) o[d] = f32x16{};
    const unsigned ko = fill_koff(tid, A_IN), vo = fill_voff(tid, A_IN);
#define DA_FILLK(t, bf) do { const size_t ro_ = (size_t)(t) * 64 * A_IN; char* B_ = lds + (bf) * 4 * TILE_B; \
        fill_tile(Kc0 + ro_, ko, A_IN, B_, tid); fill_tile(Kc0 + ro_ + 128, ko, A_IN, B_ + TILE_B, tid); } while (0)
#define DA_FILLV(t, bf) do { const size_t ro_ = (size_t)(t) * 64 * A_IN; char* B_ = lds + (bf) * 4 * TILE_B; \
        fill_tile(Vb + ro_, vo, A_IN, B_ + 2 * TILE_B, tid); fill_tile(Vb + ro_ + 128, vo, A_IN, B_ + 3 * TILE_B, tid); } while (0)
    DA_FILLK(0, 0); DA_FILLV(0, 0);
    __syncthreads();
    if (comp == 1) __syncthreads();
    for (int t = 0; t < NT; ++t) {
        const int bf = t & 1;
        const int kb = t * 64;
        const bool active = kb <= qlo + 31;
        bf16x8 pa0, pa1, pa2, pa3;
        if (t + 1 < NT) DA_FILLK(t + 1, bf ^ 1);
        if (active) {
            float* scr = (float*)(lds + 8 * TILE_B) + wid * 32;
            f32x16 p0, p1;
            qkt(p0, p1, lds + bf * 4 * TILE_B + comp * TILE_B, r32, hi, qr);
            float sl = sl2; asm volatile("" : "+v"(sl));
            const float bb = sl * (float)(kb - P0 + 4 * hi);
#pragma unroll
            for (int r = 0; r < 16; ++r) { const int c = (r & 3) + 8 * (r >> 2);
                p0[r] = fmaf(p0[r], C2, fmaf(sl, (float)c, bb)); p1[r] = fmaf(p1[r], C2, fmaf(sl, (float)(c + 32), bb)); }
            if (kb + 63 > qlo) {
                const int dq = qpos - kb - 4 * hi;
#pragma unroll
                for (int r = 0; r < 16; ++r) { const int c = (r & 3) + 8 * (r >> 2);
                    if (c > dq) p0[r] = -__builtin_inff();
                    if (c + 32 > dq) p1[r] = -__builtin_inff(); }
            }
            const float alpha = online_sm(p0, p1, m_reg, l_reg);
            if (__any(alpha < 1.f)) { float al[16]; ROWX(scr, alpha, al);
#pragma unroll
                for (int d = 0; d < 8; ++d)
#pragma unroll
                    for (int r = 0; r < 16; ++r) o[d][r] *= al[r]; }
            pack_p(p0, p1, pa0, pa1, pa2, pa3);
        }
        __syncthreads();
        if (t + 1 < NT) DA_FILLV(t + 1, bf ^ 1);
        if (active) {
            const int vb_lane = (int)(uintptr_t)lds + v_rd_base(lane) + bf * 4 * TILE_B;
            pv_tile(o, vb_lane + 2 * TILE_B, pa0, pa1, pa2, pa3);
            pv_tile(o + 4, vb_lane + 3 * TILE_B, pa0, pa1, pa2, pa3);
        }
        __syncthreads();
    }
    if (comp == 0) __syncthreads();
#undef DA_FILLK
#undef DA_FILLV
    int tz = tidx(); asm volatile("" : "+v"(tz));
    const int lane2 = tz & 63, r2 = lane2 & 31, h2 = lane2 >> 5, wid2 = tz >> 6, rg2 = wid2 & 3, comp2 = wid2 >> 2;
    { float il[16];
      { float* scr = (float*)(lds + 8 * TILE_B) + wid2 * 32; const int r32 = r2, hi = h2; ROWX(scr, 1.f / l_reg, il); }
#pragma unroll
      for (int d = 0; d < 8; ++d)
#pragma unroll
          for (int r = 0; r < 16; ++r) o[d][r] *= il[r]; }
    float* xch = (float*)lds + rg2 * 8192;
    if (comp2 == 1) {
#pragma unroll
        for (int d = 0; d < 8; ++d)
#pragma unroll
            for (int r = 0; r < 16; ++r) xch[(d * 16 + r) * 64 + lane2] = o[d][r];
    }
    __syncthreads();
    if (comp2 == 0) {
        float ssq[16];
#pragma unroll
        for (int r = 0; r < 16; ++r) ssq[r] = 0.f;
#pragma unroll
        for (int d = 0; d < 8; ++d) {
#pragma unroll
            for (int r = 0; r < 16; ++r) { float* q = xch + (d * 16 + r) * 64 + lane2; const float v = o[d][r] - lam * *q; *q = v; ssq[r] = fmaf(v, v, ssq[r]); }
            SBAR(); }
        float* rsc = (float*)(lds + 8 * TILE_B) + wid2 * 32;
#pragma unroll
        for (int r = 0; r < 16; ++r) {
            ssq[r] += shx<1>(ssq[r]); ssq[r] += shx<2>(ssq[r]); ssq[r] += shx<4>(ssq[r]); ssq[r] += shx<8>(ssq[r]); ssq[r] += shx<16>(ssq[r]);
            if (r2 == 0) rsc[crow(r, h2)] = rsqrtf(ssq[r] * (1.f / 256.f) + EPS) * one_m_li; }
        asm volatile("s_waitcnt lgkmcnt(0)" ::: "memory");
        bf16_t* ob = p.attn_o + ((size_t)b * SEQ + qb * 128 + rg2 * 32) * D_MODEL + h * 256;
#pragma unroll 4
        for (int i = 0; i < 16; ++i) { const int id = i * 64 + lane2, row = id >> 5, cc = id & 31;
            const int hh_ = (row >> 2) & 1, rr_ = (row & 3) + 4 * (row >> 3);
            const float* q = xch + ((cc >> 2) * 16 + rr_) * 64 + hh_ * 32 + (cc & 3) * 8;
            const f32x4 a = *(const f32x4*)q, c4 = *(const f32x4*)(q + 4);
            const f32x4 w0 = *(const f32x4*)(p.a_subln_w + cc * 8), w1 = *(const f32x4*)(p.a_subln_w + cc * 8 + 4);
            const float rs = rsc[row];
            u32x4 o4; o4.x = cvtpk(a[0] * rs * w0[0], a[1] * rs * w0[1]); o4.y = cvtpk(a[2] * rs * w0[2], a[3] * rs * w0[3]);
            o4.z = cvtpk(c4[0] * rs * w1[0], c4[1] * rs * w1[1]); o4.w = cvtpk(c4[2] * rs * w1[2], c4[3] * rs * w1[3]);
            *(u32x4*)(ob + (size_t)row * D_MODEL + cc * 8) = o4; }
    }
    __syncthreads();
}
__device__ __forceinline__ void phase_diff_attn(CParams& p, char* lds) {
    float lam;
    { const int lane = tidx() & 63; const float* L = p.a_lambda;
        float s1 = L[lane] * L[128 + lane] + L[64 + lane] * L[128 + 64 + lane];
        float s2 = L[256 + lane] * L[384 + lane] + L[256 + 64 + lane] * L[384 + 64 + lane];
        s1 = wave_sum(s1); s2 = wave_sum(s2);
        lam = __expf(s1) - __expf(s2) + 0.2f; }
    int it = 0; const int myslot = blockIdx.x % 3;
#pragma unroll 1
    for (int w = wgid_v(lds); w < 512; w += gridDim.x, ++it) {
        if (CONV_MODE == 1 && it == myslot) moe_convert<1>(p, 16, 32, lds);
        const int ww = w & 255, b = ww >> 7, h = (ww >> 4) & 7, qp = ww & 15;
        diff_attn_unit(p, b, h, w < 256 ? 31 - qp : qp, lds, lam, 0.8f);
    }
    if (CONV_MODE == 1 && myslot >= it) moe_convert<1>(p, 16, 32, lds);
}
#define NSA_IMP_OFF (4 * TILE_B)
#define NSA_SEL_OFF (8 * TILE_B)
#define NSA_UM_OFF (8 * TILE_B + 512)
#define NSA_SCR_OFF (8 * TILE_B + 1024)
#define NSA_LANE() int tz_ = tidx(); asm volatile("" : "+v"(tz_)); const int tid = tz_, wid = __builtin_amdgcn_readfirstlane(tz_ >> 6), lane = tz_ & 63, r32 = lane & 31, hi = lane >> 5; \
    const int hh = wid >> 1, th = wid & 1, tl = th * 32 + r32, pos = P0 + tl, Hh = g * 4 + hh; (void)tid; (void)hh; (void)th; (void)tl; (void)pos; (void)Hh; (void)hi; \
    float* scr = (float*)(lds + NSA_SCR_OFF) + wid * 32; (void)scr; const int vb_lane = (int)(uintptr_t)lds + v_rd_base(lane); (void)vb_lane; \
    const float sl2 = 1.4426950408889634f * exp2f(-0.5f * (float)(Hh + 1)); (void)sl2;
#define NSA_C2 (1.4426950408889634f * 0.08838834764831845f)
#define NSA_RESCALE(o, alpha) do { if (__any((alpha) < 1.f)) { float al_[16]; ROWX(scr, (alpha), al_); \
        _Pragma("unroll") for (int d_ = 0; d_ < 4; ++d_) _Pragma("unroll") for (int r_ = 0; r_ < 16; ++r_) (o)[d_][r_] *= al_[r_]; } } while (0)
#define NSA_ACCUM(tot, o, fac, first) do { float f_[16]; ROWX(scr, (fac), f_); \
        _Pragma("unroll") for (int d_ = 0; d_ < 4; ++d_) _Pragma("unroll") for (int q_ = 0; q_ < 8; ++q_) { \
            float a_ = (o)[d_][2 * q_] * f_[2 * q_], b_ = (o)[d_][2 * q_ + 1] * f_[2 * q_ + 1]; \
            if (!(first)) { a_ += __uint_as_float((tot)[d_][q_] << 16); b_ += __uint_as_float((tot)[d_][q_] & 0xffff0000u); } \
            (tot)[d_][q_] = cvtpk(a_, b_); } } while (0)

__device__ __forceinline__ void nsa_unit(CParams& p, const int b, const int g, const int qb, char* lds) {
    const int P0 = qb * 64;
    const bf16_t* proj = p.qkv + (size_t)b * SEQ * B_MAIN;
    bf16x8 qr[8];
    unsigned tot[4][8];
    {   NSA_LANE();
        const bf16_t* qp = proj + (size_t)pos * B_MAIN + Hh * 128 + hi * 8;
#pragma unroll
        for (int d0 = 0; d0 < 8; ++d0) qr[d0] = *(const bf16x8*)(qp + d0 * 16);
        float* ir = (float*)(lds + NSA_IMP_OFF) + ((size_t)hh * 64 + tl) * 64 + hi * 32;
#pragma unroll
        for (int i = 0; i < 8; ++i) *(f32x4*)(ir + 4 * i) = (f32x4){0.f, 0.f, 0.f, 0.f};
    }
    {   NSA_LANE();
        const bf16_t* kcmp = p.kvcmp + ((size_t)(b * 256) * 4 + g) * 128;
        const bf16_t* vcmp = kcmp + (size_t)2048 * 128;
        const unsigned ko = fill_koff(tid, 512), vo = fill_voff(tid, 512);
        const int NTc = (4 * qb + 2) / 64 + 1;
        const int cmaxl = pos >= 31 ? ((pos - 31) >> 4) : -1;
        float m_c = -1e30f, l_c = 0.f;
#define CMP_SCORES(t) do { float sl_ = sl2 * 16.f; asm volatile("" : "+v"(sl_)); const float bb = sl_ * (float)((t) * 64 + 4 * hi); const int dq = cmaxl - (t) * 64 - 4 * hi; \
        _Pragma("unroll") for (int r = 0; r < 16; ++r) { const int c = (r & 3) + 8 * (r >> 2); \
            p0[r] = c > dq ? -__builtin_inff() : fmaf(p0[r], NSA_C2, fmaf(sl_, (float)c, bb)); \
            p1[r] = c + 32 > dq ? -__builtin_inff() : fmaf(p1[r], NSA_C2, fmaf(sl_, (float)(c + 32), bb)); } } while (0)
        fill_tile(kcmp, ko, 512, lds, tid);
        __syncthreads();
        for (int t = 0; t < NTc; ++t) {
            const int bf = t & 1;
            if (t + 1 < NTc) fill_tile(kcmp + (size_t)(t + 1) * 64 * 512, ko, 512, lds + (bf ^ 1) * 2 * TILE_B, tid);
            f32x16 p0, p1;
            qkt(p0, p1, lds + bf * 2 * TILE_B, r32, hi, qr);
            CMP_SCORES(t);
            (void)online_sm(p0, p1, m_c, l_c);
            __syncthreads();
        }
        const float inv_l = l_c > 0.f ? 1.f / l_c : 0.f;
        f32x16 o[4];
#pragma unroll
        for (int d = 0; d < 4; ++d) o[d] = f32x16{};
        float carry = 0.f;
        fill_tile(kcmp, ko, 512, lds, tid); fill_tile(vcmp, vo, 512, lds + TILE_B, tid);
        __syncthreads();
        for (int t = 0; t < NTc; ++t) {
            const int bf = t & 1;
            if (t + 1 < NTc) { fill_tile(kcmp + (size_t)(t + 1) * 64 * 512, ko, 512, lds + (bf ^ 1) * 2 * TILE_B, tid);
                               fill_tile(vcmp + (size_t)(t + 1) * 64 * 512, vo, 512, lds + (bf ^ 1) * 2 * TILE_B + TILE_B, tid); }
            f32x16 p0, p1;
            qkt(p0, p1, lds + bf * 2 * TILE_B, r32, hi, qr);
            CMP_SCORES(t);
#pragma unroll
            for (int r = 0; r < 16; ++r) { p0[r] = __builtin_amdgcn_exp2f(p0[r] - m_c) * inv_l; p1[r] = __builtin_amdgcn_exp2f(p1[r] - m_c) * inv_l; }
            { float mv[8], sp[8], ps[8];
#pragma unroll
                for (int q = 0; q < 4; ++q) { sp[q] = 0.5f * p0[4 * q + 3]; mv[q] = p0[4 * q] + p0[4 * q + 1] + p0[4 * q + 2] + sp[q];
                                              sp[4 + q] = 0.5f * p1[4 * q + 3]; mv[4 + q] = p1[4 * q] + p1[4 * q + 1] + p1[4 * q + 2] + sp[4 + q]; }
#pragma unroll
                for (int q = 0; q < 8; ++q) ps[q] = shx<32>(sp[q]);
                float* ir = (float*)(lds + NSA_IMP_OFF) + ((size_t)hh * 64 + tl) * 64 + 16 * t + hi;
#pragma unroll
                for (int q = 0; q < 8; ++q) { const float lo = q > 0 ? ps[q > 0 ? q - 1 : 0] : carry; ir[2 * q] = mv[q] + (hi ? ps[q] : lo); }
                carry = ps[7]; }
            bf16x8 pa0, pa1, pa2, pa3; pack_p(p0, p1, pa0, pa1, pa2, pa3);
            pv_tile(o, vb_lane + bf * 2 * TILE_B + TILE_B, pa0, pa1, pa2, pa3);
            __syncthreads();
        }
#undef CMP_SCORES
        const float g0 = p.gate[((size_t)b * SEQ + pos) * 48 + Hh * 3 + 0];
        NSA_ACCUM(tot, o, g0, true);
    }
    {
        const int lane = tidx() & 63, wid = __builtin_amdgcn_readfirstlane(tidx() >> 6);
        const float* imp = (const float*)(lds + NSA_IMP_OFF);
        unsigned long long* selm = (unsigned long long*)(lds + NSA_SEL_OFF);
#pragma unroll 1
        for (int i0 = 0; i0 < 8; i0 += 8) { const int j = lane;
            unsigned key[8], thr[8];
#pragma unroll
            for (int q = 0; q < 8; ++q) { const int tk = wid * 8 + i0 + q;
                const float* ir = imp + (size_t)tk * 64 + j;
                const float v = ((ir[0] + ir[64 * 64]) + ir[2 * 64 * 64]) + ir[3 * 64 * 64];
                const bool forced = (j == 0) || (j == qb) || (j == qb - 1);
                const float sc = forced ? 1e4f : (j <= qb ? v : -1e4f);
                unsigned k_ = __float_as_uint(sc); key[q] = (k_ & 0x80000000u) ? ~k_ : (k_ | 0x80000000u); thr[q] = 0u; }
#pragma unroll 1
            for (int bit = 31; bit >= 0; --bit) {
#pragma unroll
                for (int q = 0; q < 8; ++q) { const unsigned cand = thr[q] | (1u << bit);
                    if (__popcll(__ballot(key[q] >= cand)) >= 16) thr[q] = cand; } }
#pragma unroll
            for (int q = 0; q < 8; ++q) { const int tk = wid * 8 + i0 + q;
                const unsigned long long gt = __ballot(key[q] > thr[q]), eq = __ballot(key[q] == thr[q]);
                const int need = 16 - __popcll(gt);
                const bool sel = (key[q] > thr[q]) || (key[q] == thr[q] && __popcll(eq & ((1ull << j) - 1ull)) < need);
                const unsigned long long sm = __ballot(sel && j <= qb);
                if (lane == 0) selm[tk] = sm; } }
        __syncthreads();
        if (wid == 0) { unsigned long long u = selm[lane];
#define UM_STEP(S) do { const unsigned lo = (unsigned)shx_i<S>((int)(unsigned)u), hi2 = (unsigned)shx_i<S>((int)(unsigned)(u >> 32)); u |= ((unsigned long long)hi2 << 32) | lo; } while (0)
            UM_STEP(32); UM_STEP(16); UM_STEP(8); UM_STEP(4); UM_STEP(2); UM_STEP(1);
#undef UM_STEP
            if (lane == 0) *(unsigned long long*)(lds + NSA_UM_OFF) = u; }
        { char* qd = lds + NSA_IMP_OFF + wid * 8192 + lane * 16;
#pragma unroll
            for (int d0 = 0; d0 < 8; ++d0) *(bf16x8*)(qd + d0 * 1024) = qr[d0]; }
        __syncthreads();
    }
    {   NSA_LANE();
        const unsigned long long mysel = ((const unsigned long long*)(lds + NSA_SEL_OFF))[tl];
        unsigned long long um = *(const unsigned long long*)(lds + NSA_UM_OFF);
        um = ((unsigned long long)__builtin_amdgcn_readfirstlane((unsigned)(um >> 32)) << 32) | (unsigned)__builtin_amdgcn_readfirstlane((unsigned)um);
        const bf16_t* Ks = proj + 3072 + g * 128; const bf16_t* Vs = proj + 3584 + g * 128;
        const unsigned ko = fill_koff(tid, B_MAIN), vo = fill_voff(tid, B_MAIN);
        float m_s = -1e30f, l_s = 0.f; f32x16 o[4];
#pragma unroll
        for (int d = 0; d < 4; ++d) o[d] = f32x16{};
        int j = __builtin_ctzll(um); um &= um - 1; int idx = 0;
        fill_tile(Ks + (size_t)j * 64 * B_MAIN, ko, B_MAIN, lds, tid); fill_tile(Vs + (size_t)j * 64 * B_MAIN, vo, B_MAIN, lds + TILE_B, tid);
        __syncthreads();
        for (;;) {
            const int bf = idx & 1; int jn = -1;
            if (um) { jn = __builtin_ctzll(um); um &= um - 1;
                fill_tile(Ks + (size_t)jn * 64 * B_MAIN, ko, B_MAIN, lds + (bf ^ 1) * 2 * TILE_B, tid); fill_tile(Vs + (size_t)jn * 64 * B_MAIN, vo, B_MAIN, lds + (bf ^ 1) * 2 * TILE_B + TILE_B, tid); }
            const bool ms = (mysel >> j) & 1ull;
            if (__any(ms)) {
                f32x16 p0, p1;
                qkt_lds(p0, p1, lds + bf * 2 * TILE_B, r32, hi, lds + NSA_IMP_OFF + wid * 8192 + lane * 16);
                float sl_ = sl2; asm volatile("" : "+v"(sl_));
                const float bb = sl_ * (float)(j * 64 - P0 + 4 * hi); const int dq = !ms ? -1000 : (j == qb) ? (tl - 4 * hi) : 1000;
#pragma unroll
                for (int r = 0; r < 16; ++r) { const int c = (r & 3) + 8 * (r >> 2);
                    p0[r] = (c > dq) ? -__builtin_inff() : fmaf(p0[r], NSA_C2, fmaf(sl_, (float)c, bb));
                    p1[r] = (c + 32 > dq) ? -__builtin_inff() : fmaf(p1[r], NSA_C2, fmaf(sl_, (float)(c + 32), bb)); }
                const float alpha = online_sm(p0, p1, m_s, l_s);
                NSA_RESCALE(o, alpha);
                bf16x8 pa0, pa1, pa2, pa3; pack_p(p0, p1, pa0, pa1, pa2, pa3);
                pv_tile(o, vb_lane + bf * 2 * TILE_B + TILE_B, pa0, pa1, pa2, pa3);
            }
            __syncthreads();
            if (jn < 0) break;
            j = jn; ++idx;
        }
        const float g1 = p.gate[((size_t)b * SEQ + pos) * 48 + Hh * 3 + 1];
        NSA_ACCUM(tot, o, g1 / l_s, false);
    }
    {   NSA_LANE();
        const bf16_t* Kw = proj + 4096 + g * 128; const bf16_t* Vw = proj + 4608 + g * 128;
        const unsigned ko = fill_koff(tid, B_MAIN), vo = fill_voff(tid, B_MAIN);
        float m_w = -1e30f, l_w = 0.f; f32x16 o[4];
#pragma unroll
        for (int d = 0; d < 4; ++d) o[d] = f32x16{};
        const int j0 = qb >= 8 ? qb - 8 : 0, NTw = qb - j0 + 1;
        fill_tile(Kw + (size_t)j0 * 64 * B_MAIN, ko, B_MAIN, lds, tid); fill_tile(Vw + (size_t)j0 * 64 * B_MAIN, vo, B_MAIN, lds + TILE_B, tid);
        __syncthreads();
        for (int t = 0; t < NTw; ++t) {
            const int bf = t & 1, j = j0 + t;
            if (t + 1 < NTw) { fill_tile(Kw + (size_t)(j + 1) * 64 * B_MAIN, ko, B_MAIN, lds + (bf ^ 1) * 2 * TILE_B, tid); fill_tile(Vw + (size_t)(j + 1) * 64 * B_MAIN, vo, B_MAIN, lds + (bf ^ 1) * 2 * TILE_B + TILE_B, tid); }
            f32x16 p0, p1;
            qkt_lds(p0, p1, lds + bf * 2 * TILE_B, r32, hi, lds + NSA_IMP_OFF + wid * 8192 + lane * 16);
            float sl_ = sl2; asm volatile("" : "+v"(sl_));
            const float bb = sl_ * (float)(j * 64 - P0 + 4 * hi);
#pragma unroll
            for (int r = 0; r < 16; ++r) { const int c = (r & 3) + 8 * (r >> 2);
                p0[r] = fmaf(p0[r], NSA_C2, fmaf(sl_, (float)c, bb)); p1[r] = fmaf(p1[r], NSA_C2, fmaf(sl_, (float)(c + 32), bb)); }
            if (j == qb || j == qb - 8) { const int dq = pos - j * 64 - 4 * hi;
#pragma unroll
                for (int r = 0; r < 16; ++r) { const int c = (r & 3) + 8 * (r >> 2);
                    if ((unsigned)(dq - c) >= 512u) p0[r] = -__builtin_inff();
                    if ((unsigned)(dq - c - 32) >= 512u) p1[r] = -__builtin_inff(); } }
            const float alpha = online_sm(p0, p1, m_w, l_w);
            NSA_RESCALE(o, alpha);
            bf16x8 pa0, pa1, pa2, pa3; pack_p(p0, p1, pa0, pa1, pa2, pa3);
            pv_tile(o, vb_lane + bf * 2 * TILE_B + TILE_B, pa0, pa1, pa2, pa3);
            __syncthreads();
        }
        const float g2 = p.gate[((size_t)b * SEQ + pos) * 48 + Hh * 3 + 2];
        NSA_ACCUM(tot, o, g2 / l_w, false);
    }
    {   NSA_LANE();
        bf16_t* st = (bf16_t*)(lds + wid * 8192);
#pragma unroll
        for (int d = 0; d < 4; ++d) {
#pragma unroll
            for (int r = 0; r < 16; ++r) st[crow(r, hi) * 128 + d * 32 + r32] = (bf16_t)((r & 1) ? (tot[d][r >> 1] >> 16) : (tot[d][r >> 1] & 0xffffu));
            SBAR(); }
        asm volatile("s_waitcnt lgkmcnt(0)" ::: "memory");
        bf16_t* ob = p.attn_o + ((size_t)b * SEQ + P0 + th * 32) * D_MODEL + Hh * 128;
#pragma unroll
        for (int i = 0; i < 8; ++i) { const int id = i * 64 + lane, row = id >> 4, cc = id & 15;
            *(u32x4*)(ob + (size_t)row * D_MODEL + cc * 8) = *(const u32x4*)(st + row * 128 + cc * 8); }
    }
    __syncthreads();
}
__device__ __forceinline__ void phase_nsa(CParams& p, char* lds) {
    int it = 0; const int myslot = blockIdx.x % 3;
#pragma unroll 1
    for (int w = wgid_v(lds); w < 512; w += gridDim.x, ++it) {
        if (CONV_MODE == 1 && it == myslot) moe_convert<1>(p, 54, 64, lds);
        const int ww = w & 255, b = ww >> 7, g = (ww >> 5) & 3, qp = ww & 31;
        nsa_unit(p, b, g, w < 256 ? 63 - qp : qp, lds);
    }
    if (CONV_MODE == 1 && myslot >= it) moe_convert<1>(p, 54, 64, lds);
}
__device__ __forceinline__ void load_row(const float* src, int lane, f32x4 (&v)[8]) {
#pragma unroll
    for (int i = 0; i < 8; ++i) v[i] = *(const f32x4*)(src + (i * 64 + lane) * 4);
}
__device__ __forceinline__ void load_row_bf16(const bf16_t* src, int lane, f32x4 (&v)[8]) {
#pragma unroll
    for (int i = 0; i < 8; ++i) { const u32x2 w = *(const u32x2*)(src + (i * 64 + lane) * 4);
        v[i][0] = __uint_as_float(w.x << 16); v[i][1] = __uint_as_float(w.x & 0xffff0000u);
        v[i][2] = __uint_as_float(w.y << 16); v[i][3] = __uint_as_float(w.y & 0xffff0000u); }
}
__device__ __forceinline__ void add_bf16_row(const bf16_t* src, int lane, f32x4 (&v)[8]) {
#pragma unroll
    for (int i = 0; i < 8; ++i) { const u32x2 w = *(const u32x2*)(src + (i * 64 + lane) * 4);
        v[i][0] += __uint_as_float(w.x << 16); v[i][1] += __uint_as_float(w.x & 0xffff0000u);
        v[i][2] += __uint_as_float(w.y << 16); v[i][3] += __uint_as_float(w.y & 0xffff0000u); }
}
__device__ __forceinline__ float row_rstd(const f32x4 (&v)[8]) {
    float ss = 0.f;
#pragma unroll
    for (int i = 0; i < 8; ++i) ss += v[i][0] * v[i][0] + v[i][1] * v[i][1] + v[i][2] * v[i][2] + v[i][3] * v[i][3];
    ss = wave_sum(ss); return rsqrtf(ss * (1.f / D_MODEL) + EPS);
}
__device__ __forceinline__ void norm_store_bf16(f32x4 (&v)[8], float rs, const float* w, bf16_t* dst, int lane) {
#pragma unroll
    for (int i = 0; i < 8; ++i) { const f32x4 wv = *(const f32x4*)(w + (i * 64 + lane) * 4);
        v[i][0] *= rs * wv[0]; v[i][1] *= rs * wv[1]; v[i][2] *= rs * wv[2]; v[i][3] *= rs * wv[3];
        u32x2 o; o.x = cvtpk(v[i][0], v[i][1]); o.y = cvtpk(v[i][2], v[i][3]);
        *(u32x2*)(dst + (i * 64 + lane) * 4) = o; }
}
struct MoeTab { int cnt[32]; int rbase[32]; int ustart[33]; int next; };
__device__ __forceinline__ void moe_tables(const unsigned* cnt, MoeTab* tb) {
    if (tidx() == 0) { int acc = 0;
        for (int e = 0; e < 32; ++e) { const int c = (int)cnt[e]; tb->cnt[e] = c; tb->rbase[e] = acc * 256; tb->ustart[e] = acc * 16; acc += (c + 255) >> 8; }
        tb->ustart[32] = acc * 16; }
    __syncthreads();
}

__device__ __forceinline__ void phase_first(CParams& p, char* lds) {
    const int tid = tidx(), wid = tid >> 6, lane = tid & 63;
    if (blockIdx.x == 0 && tid < 128) p.cnt[tid] = 0u;
    for (int i = blockIdx.x * NTHREADS + tid; i < 2 * 64 * D_MODEL; i += gridDim.x * NTHREADS) { const int l = i >> 17, e = (i >> 11) & 63, k = i & 2047;
        const float w = e < 4 ? p.moe_w_group[((size_t)l * D_MODEL + k) * 4 + e] : e < 36 ? p.moe_w_expert[((size_t)l * D_MODEL + k) * 32 + (e - 4)] : 0.f;
        const bf16_t whi = f2bf(w); p.rw_hi[i] = whi; p.rw_lo[i] = f2bf(w - bf2f(whi)); }
    for (int row = blockIdx.x * 8 + wid; row < T_TOK; row += gridDim.x * 8) {
        f32x4 v[8]; load_row(p.x + (size_t)row * D_MODEL, lane, v);
        const float rs = row_rstd(v);
        norm_store_bf16(v, rs, p.attn_norm_w, p.xn + (size_t)row * D_MODEL, lane);
    }
    __syncthreads();
    int job = blockIdx.x; const int stride = gridDim.x;
    convert_weight<0>(p.a_w_in, D_MODEL, A_IN, p.wt_a_in, job, stride, lds);
    convert_weight<0>(p.a_w_out, D_MODEL, D_MODEL, p.wt_a_out, job, stride, lds);
    convert_weight<0>(p.b_w_in, D_MODEL, B_IN, p.wt_b_in, job, stride, lds);
    convert_weight<0>(p.b_w_out, D_MODEL, D_MODEL, p.wt_b_out, job, stride, lds);
    __syncthreads();
#if CONV_MODE == 0
    moe_convert<3>(p, 0, 64, lds);
#endif
}

struct RouteDec { int ea, eb; float wa, wb; };
__device__ __forceinline__ void route_decide(CParams& p, const int layer, const float (&acc)[36], RouteDec* out) {
    const float* bg = p.moe_b_group + layer * 4; const float* be = p.moe_b_expert + layer * 32;
    float lg[4];
#pragma unroll
    for (int j = 0; j < 4; ++j) lg[j] = acc[j] + bg[j];
    int gt = 0; float gm = lg[0];
#pragma unroll
    for (int j = 1; j < 4; ++j) if (lg[j] > gm) { gm = lg[j]; gt = j; }
    float gs = 0.f;
#pragma unroll
    for (int j = 0; j < 4; ++j) gs += __expf(lg[j] - gm);
    const float wgp = 1.f / gs;
    int ea = 0, eb = -1; float m0 = -3.0e38f, m1 = -3.0e38f;
#pragma unroll
    for (int k = 0; k < 32; ++k) { const float v = ((k >> 3) == gt) ? acc[4 + k] + be[k] : -3.0e38f; if (v > m0) { m0 = v; ea = k; } }
#pragma unroll
    for (int k = 0; k < 32; ++k) { const float v = ((k >> 3) == gt && k != ea) ? acc[4 + k] + be[k] : -3.0e38f; if (v > m1) { m1 = v; eb = k; } }
    const float e1 = __expf(m1 - m0);
    out->ea = ea; out->eb = eb; out->wa = wgp / (1.f + e1); out->wb = wgp * e1 / (1.f + e1);
}
#define DPP_ADD(v, CTRL) v += __int_as_float(__builtin_amdgcn_update_dpp(0, __float_as_int(v), CTRL, 0xf, 0xf, false))
__device__ __forceinline__ void reduce36(float (&a)[36]) {
    float u[9];
#pragma unroll
    for (int i = 0; i < 9; ++i) {
        float z[2];
#pragma unroll
        for (int h = 0; h < 2; ++h) {
            const u32x2 s = __builtin_amdgcn_permlane32_swap(__float_as_uint(a[4 * i + 2 * h]), __float_as_uint(a[4 * i + 2 * h + 1]), false, false);
            z[h] = __uint_as_float(s[0]) + __uint_as_float(s[1]); }
        const u32x2 t = __builtin_amdgcn_permlane16_swap(__float_as_uint(z[0]), __float_as_uint(z[1]), false, false);
        float x = __uint_as_float(t[0]) + __uint_as_float(t[1]);
        DPP_ADD(x, 0x128); DPP_ADD(x, 0x124); DPP_ADD(x, 0x122); DPP_ADD(x, 0x121);
        u[i] = x; }
#pragma unroll
    for (int i = 0; i < 9; ++i) {
        a[4 * i + 0] = __int_as_float(__builtin_amdgcn_readlane(__float_as_int(u[i]), 0));  a[4 * i + 2] = __int_as_float(__builtin_amdgcn_readlane(__float_as_int(u[i]), 16));
        a[4 * i + 1] = __int_as_float(__builtin_amdgcn_readlane(__float_as_int(u[i]), 32)); a[4 * i + 3] = __int_as_float(__builtin_amdgcn_readlane(__float_as_int(u[i]), 48)); }
}
#define NR_MAXROWS 512
#define NRW 4
__device__ __forceinline__ void phase_norm_route(CParams& p, const bf16_t* h, const int layer, char* lds) {
    const int tid = tidx(), wid = tid >> 6, lane = tid & 63;
    const float* nw = p.ffn_norm_w + layer * D_MODEL;
    float* fin = (float*)lds;
    float* rsl = (float*)(lds + 57344);
    float* part = (float*)(lds + 65536);
    RouteDec* dec = (RouteDec*)(lds + 40960);
    int* dtok = (int*)(lds + 40960 + NR_MAXROWS * 16);
    int* hist = dtok + NR_MAXROWS;
    int* posa = hist + 64; int* posb = posa + NR_MAXROWS;
    if (tid < 64) hist[tid] = 0;
    int nrows = 0;
    for (int rb = blockIdx.x; rb < T_TOK / (8 * NRW); rb += gridDim.x, nrows += 8 * NRW) {
        const int row0 = rb * (8 * NRW) + wid * NRW;
        float rs[NRW];
#pragma unroll
        for (int r = 0; r < NRW; ++r) { f32x4 v[8]; load_row_bf16(h + (size_t)(row0 + r) * D_MODEL, lane, v);
            rs[r] = row_rstd(v);
            norm_store_bf16(v, rs[r], nw, p.xn + (size_t)(row0 + r) * D_MODEL, lane); }
        if (lane == 0) {
#pragma unroll
            for (int r = 0; r < NRW; ++r) rsl[wid * NRW + r] = rs[r]; }
        __syncthreads();
        { const int j = lane & 31, hi = lane >> 5; const float rsj = rsl[j];
          f32x16 d0 = {}, d1 = {};
          const bf16_t* hrow = h + (size_t)(rb * (8 * NRW) + j) * D_MODEL + wid * 256 + 8 * hi;
          const float* nwp = nw + wid * 256 + 8 * hi;
          const bf16_t* wh = p.rw_hi + ((size_t)(layer * 64 + j) * D_MODEL) + wid * 256 + 8 * hi; const bf16_t* wl = p.rw_lo + ((size_t)(layer * 64 + j) * D_MODEL) + wid * 256 + 8 * hi;
#pragma unroll 4
          for (int ks = 0; ks < 16; ++ks) {
              const u32x4 hv = *(const u32x4*)(hrow + ks * 16); const f32x4 na = *(const f32x4*)(nwp + ks * 16), nb = *(const f32x4*)(nwp + ks * 16 + 4);
              float x[8];
              x[0] = __uint_as_float(hv.x << 16) * (rsj * na[0]); x[1] = __uint_as_float(hv.x & 0xffff0000u) * (rsj * na[1]);
              x[2] = __uint_as_float(hv.y << 16) * (rsj * na[2]); x[3] = __uint_as_float(hv.y & 0xffff0000u) * (rsj * na[3]);
              x[4] = __uint_as_float(hv.z << 16) * (rsj * nb[0]); x[5] = __uint_as_float(hv.z & 0xffff0000u) * (rsj * nb[1]);
              x[6] = __uint_as_float(hv.w << 16) * (rsj * nb[2]); x[7] = __uint_as_float(hv.w & 0xffff0000u) * (rsj * nb[3]);
              u32x4 xh, xl;
              xh.x = cvtpk(x[0], x[1]); xh.y = cvtpk(x[2], x[3]); xh.z = cvtpk(x[4], x[5]); xh.w = cvtpk(x[6], x[7]);
              xl.x = cvtpk(x[0] - __uint_as_float(xh.x << 16), x[1] - __uint_as_float(xh.x & 0xffff0000u)); xl.y = cvtpk(x[2] - __uint_as_float(xh.y << 16), x[3] - __uint_as_float(xh.y & 0xffff0000u));
              xl.z = cvtpk(x[4] - __uint_as_float(xh.z << 16), x[5] - __uint_as_float(xh.z & 0xffff0000u)); xl.w = cvtpk(x[6] - __uint_as_float(xh.w << 16), x[7] - __uint_as_float(xh.w & 0xffff0000u));
              const bf16x8 xhf = __builtin_bit_cast(bf16x8, xh), xlf = __builtin_bit_cast(bf16x8, xl);
              const bf16x8 wh0 = *(const bf16x8*)(wh + ks * 16), wl0 = *(const bf16x8*)(wl + ks * 16);
              const bf16x8 wh1 = *(const bf16x8*)(wh + (size_t)32 * D_MODEL + ks * 16), wl1 = *(const bf16x8*)(wl + (size_t)32 * D_MODEL + ks * 16);
              d0 = __builtin_amdgcn_mfma_f32_32x32x16_bf16(wh0, xhf, d0, 0, 0, 0); d0 = __builtin_amdgcn_mfma_f32_32x32x16_bf16(wl0, xhf, d0, 0, 0, 0); d0 = __builtin_amdgcn_mfma_f32_32x32x16_bf16(wh0, xlf, d0, 0, 0, 0);
              d1 = __builtin_amdgcn_mfma_f32_32x32x16_bf16(wh1, xhf, d1, 0, 0, 0); d1 = __builtin_amdgcn_mfma_f32_32x32x16_bf16(wl1, xhf, d1, 0, 0, 0); d1 = __builtin_amdgcn_mfma_f32_32x32x16_bf16(wh1, xlf, d1, 0, 0, 0); }
          float* pw = part + ((size_t)(wid * 32 + j)) * 40;
#pragma unroll
          for (int r = 0; r < 16; ++r) pw[(r & 3) + 8 * (r >> 2) + 4 * hi] = d0[r];
          if (hi == 0) {
#pragma unroll
              for (int r = 0; r < 4; ++r) pw[32 + r] = d1[r]; } }
        __syncthreads();
        for (int idx = tid; idx < 32 * 36; idx += NTHREADS) { const int row = idx / 36, e = idx - row * 36; float s = 0.f;
#pragma unroll
            for (int w = 0; w < 8; ++w) s += part[(size_t)(w * 32 + row) * 40 + e];
            fin[idx] = s; }
        __syncthreads();
        if (tid < 32 && nrows + tid < NR_MAXROWS) { float acc[36];
#pragma unroll
            for (int e = 0; e < 36; ++e) acc[e] = fin[tid * 36 + e];
            route_decide(p, layer, acc, &dec[nrows + tid]); dtok[nrows + tid] = rb * (8 * NRW) + tid; }
        __syncthreads();
    }
    __syncthreads();
    if (nrows > NR_MAXROWS) nrows = NR_MAXROWS;
    if (tid < nrows) { posa[tid] = atomicAdd(&hist[dec[tid].ea], 1); posb[tid] = atomicAdd(&hist[dec[tid].eb], 1); }
    __syncthreads();
    if (tid < 32) { const int c = hist[tid]; hist[32 + tid] = c ? (int)atomicAdd(p.cnt + layer * 32 + tid, (unsigned)c) : 0; }
    __syncthreads();
    if (tid < nrows) { const RouteDec d = dec[tid]; const int tok = dtok[tid];
        const int ra = hist[32 + d.ea] + posa[tid], rb2 = hist[32 + d.eb] + posb[tid];
        p.list_tok[d.ea * LIST_CAP + ra] = tok; p.list_w[d.ea * LIST_CAP + ra] = d.wa;
        p.list_tok[d.eb * LIST_CAP + rb2] = tok; p.list_w[d.eb * LIST_CAP + rb2] = d.wb;
        p.slot_ref[tok * 2 + 0] = (d.ea << 16) | ra; p.slot_ref[tok * 2 + 1] = (d.eb << 16) | rb2; }
    __syncthreads();
}
template <int MODE>
__device__ __forceinline__ void phase_combine(CParams& p, const bf16_t* hold, bf16_t* hnew, const float* w, const int layer, char* lds) {
    MoeTab* tb = (MoeTab*)lds; (void)layer;
    const int wid = tidx() >> 6, lane = tidx() & 63;
    for (int row = blockIdx.x * 8 + wid; row < T_TOK; row += gridDim.x * 8) {
        f32x4 v[8]; load_row_bf16(hold + (size_t)row * D_MODEL, lane, v);
        const int s0 = p.slot_ref[row * 2], s1 = p.slot_ref[row * 2 + 1];
        const int r0 = tb->rbase[s0 >> 16] + (s0 & 0xffff), r1 = tb->rbase[s1 >> 16] + (s1 & 0xffff);
        add_bf16_row(p.ybuf + (size_t)r0 * D_MODEL, lane, v);
        add_bf16_row(p.ybuf + (size_t)r1 * D_MODEL, lane, v);
        if (MODE == 0) {
#pragma unroll
            for (int i = 0; i < 8; ++i) { u32x2 o; o.x = cvtpk(v[i][0], v[i][1]); o.y = cvtpk(v[i][2], v[i][3]); *(u32x2*)(hnew + (size_t)row * D_MODEL + (i * 64 + lane) * 4) = o; }
            const float rs = row_rstd(v);
            norm_store_bf16(v, rs, w, p.xn + (size_t)row * D_MODEL, lane);
        } else {
            const float rs = row_rstd(v);
#pragma unroll
            for (int i = 0; i < 8; ++i) { const f32x4 wv = *(const f32x4*)(w + (i * 64 + lane) * 4);
                f32x4 o; o[0] = v[i][0] * rs * wv[0]; o[1] = v[i][1] * rs * wv[1]; o[2] = v[i][2] * rs * wv[2]; o[3] = v[i][3] * rs * wv[3];
                *(f32x4*)(p.out + (size_t)row * D_MODEL + (i * 64 + lane) * 4) = o; }
        }
    }
    __syncthreads();
}

#define GEMM_LDS_OFF 1024
#ifdef PROBE_QKV_GT
__device__ __forceinline__ void phase_qkv(CParams& p, char* lds) {
    for (int u = blockIdx.x; u < 32 * 48; u += gridDim.x) { const int mt = u & 31, nt = u >> 5;
        gemm_tile(ARows{p.xn, D_MODEL, mt * 256, T_TOK}, BBf16T{p.wt_a_in, D_MODEL, nt * 128}, EpBf16{p.qkv, A_IN, mt * 256, nt * 128, T_TOK, A_IN}, D_MODEL, lds + GEMM_LDS_OFF, 0xFu); }
}
#else
__device__ __forceinline__ void phase_qkv(CParams& p, char* lds) {
    int it = 0; const int myslot = blockIdx.x & 3;
    for (int u = wgid_v(lds); u < 32 * 24; u += gridDim.x, ++it) { int pm, pn; g8_order_c(u, 32, 24, pm, pn);
        if (CONV_MODE == 1 && it == myslot) moe_convert<1>(p, 0, 16, lds);
        unsigned ao[2][2], bo[2]; g8_offsets2(ao[0], pm * 256, D_MODEL); ao[1][0] = ao[1][1] = 0u; g8_offsets2_perm(bo, pn * 256, D_MODEL);
        gemm8_unit<false>(p.xn, ao, D_MODEL, p.wt_a_in, bo, D_MODEL, lds + GEMM_LDS_OFF, E8Bf16{p.qkv, A_IN, pm * 256, pn * 256, A_IN}, true); }
    if (CONV_MODE == 1 && myslot >= it) moe_convert<1>(p, 0, 16, lds);
}
#endif
template <bool RB>
__device__ __forceinline__ void phase_oproj(CParams& p, const bf16_t* wt, const void* res, bf16_t* hout, char* lds) {
    for (int u = wgid_v(lds); u < 32 * 8; u += gridDim.x) { int pm, pn; g8_order_c(u, 32, 8, pm, pn);
        unsigned ao[2][2], bo[2]; g8_offsets2(ao[0], pm * 256, D_MODEL); ao[1][0] = ao[1][1] = 0u; g8_offsets2_perm(bo, pn * 256, D_MODEL);
        gemm8_unit<false>(p.attn_o, ao, D_MODEL, wt, bo, D_MODEL, lds + GEMM_LDS_OFF, E8ResBf16<RB>{hout, res, pm * 256, pn * 256}, true); }
}
__device__ __forceinline__ void phase_proj(CParams& p, char* lds) {
    int it = 0; const int myslot = blockIdx.x & 3;
    for (int u = wgid_v(lds); u < 32 * 21; u += gridDim.x, ++it) { int pm, pn; g8_order_c(u, 32, 21, pm, pn);
        if (CONV_MODE == 1 && it == myslot) moe_convert<1>(p, 32, 43, lds);
        unsigned ao[2][2], bo[2]; g8_offsets2(ao[0], pm * 256, D_MODEL); ao[1][0] = ao[1][1] = 0u; g8_offsets2_perm(bo, pn * 256, D_MODEL);
        gemm8_unit<false>(p.xn, ao, D_MODEL, p.wt_b_in, bo, D_MODEL, lds + GEMM_LDS_OFF, E8Proj{p.qkv, p.gate, pm * 256, pn * 256}, true); }
    if (CONV_MODE == 1 && myslot >= it) moe_convert<1>(p, 32, 43, lds);
    __syncthreads();
    { const int tid = tidx();
      for (int w = (int)gridDim.x - 1 - wgid_v(lds); w < 64; w += gridDim.x) {
        const int o = tid & 7, ks = tid >> 3, out = w * 8 + o, t = out >> 8, n = out & 255;
        const float* pe = p.b_cmp_pos + (size_t)t * 4096; const float* w1 = p.b_cmp_w1 + (size_t)t * 4096 * 256 + n;
        float s = 0.f;
        for (int k = ks; k < 4096; k += 64) s += pe[k] * w1[(size_t)k * 256];
        float* red = (float*)lds; red[tid] = s; __syncthreads();
        if (tid < 8) { float a = 0.f; for (int i = 0; i < 64; ++i) a += red[i * 8 + tid]; p.cbias[w * 8 + tid] = a; }
        __syncthreads();
      } }
}
__device__ __forceinline__ void phase_cmp1(CParams& p, char* lds) {
    for (int u = blockIdx.x; u < 256; u += gridDim.x) { const int sp = u >> 5, t = (u >> 4) & 1, mt = (u >> 1) & 7, nt = u & 1;
        gemm_tile<false>(ACompress{p.qkv, 2048 + t * 512, mt * 256, sp * 512}, BPlain{p.b_cmp_w1 + ((size_t)t * 4096 + sp * 512) * 256, 256, nt * 128, 256},
                  EpF32{p.cslab + ((size_t)sp * 2 + t) * 2048 * 256, 256, mt * 256, nt * 128}, 512, lds + GEMM_LDS_OFF, 0xFu); }
}
__device__ __forceinline__ void phase_cmp_reduce(CParams& p) {
    for (int i = blockIdx.x * NTHREADS + tidx(); i < 2 * 2048 * 256 / 4; i += gridDim.x * NTHREADS) {
        const int c = (i & 63) * 4, t = i >> 17; f32x4 s = *(const f32x4*)(p.cbias + t * 256 + c);
#pragma unroll
        for (int sp = 0; sp < 8; ++sp) s += *(const f32x4*)(p.cslab + (size_t)sp * 2 * 2048 * 256 + (size_t)i * 4);
        u32x2 w; w.x = cvtpk(gelu_tanh(s[0]), gelu_tanh(s[1])); w.y = cvtpk(gelu_tanh(s[2]), gelu_tanh(s[3]));
        *(u32x2*)(p.chid + (size_t)i * 4) = w; }
}
__device__ __forceinline__ void phase_cmp2(CParams& p, char* lds) {
    for (int u = blockIdx.x; u < 16; u += gridDim.x) { const int t = u >> 3, mt = u & 7;
        gemm_tile<true>(ARows{p.chid + (size_t)t * 2048 * 256, 256, mt * 256, 2048}, BPlain{p.b_cmp_w2 + (size_t)t * 256 * 128, 128, 0, 128},
                  EpBf16{p.kvcmp + (size_t)t * 2048 * 128, 128, mt * 256, 0, 2048, 128}, 256, lds + GEMM_LDS_OFF, 0xFu); }
}
__device__ __forceinline__ int moe_first_unit() { const int w = blockIdx.x; return gridDim.x == 256 ? 32 * (w & 7) + (w >> 3) : w; }
__device__ __forceinline__ bool moe_decode(const MoeTab* tb, int u, int& e, int& mt, int& nt) {
    if (u >= tb->ustart[32]) return false;
    e = 0;
#pragma unroll 1
    for (int i = 1; i < 32; ++i) if (u >= tb->ustart[i]) e = i;
    const int loc = u - tb->ustart[e], tiles = (tb->cnt[e] + 255) >> 8;
    nt = loc / tiles; mt = loc - nt * tiles; return true;
}
__device__ __forceinline__ unsigned moe_rowmask(int cnt, int mt) { const int rem = cnt - mt * 256; return rem >= 193 ? 0xFu : rem >= 129 ? 0x7u : rem >= 65 ? 0x3u : 0x1u; }
__device__ __forceinline__ bool moe_decode8(const MoeTab* tb, int u, int& e, int& mt, int& nt);
#define SCAL(v) __builtin_amdgcn_readfirstlane((int)(v))
__device__ __forceinline__ bool moe_decode8(const MoeTab* tb, int u, int& e, int& mt, int& nt);
__device__ __forceinline__ unsigned moe_rowmask(int cnt, int mt);
struct UpUnits { typedef BGateUp256 BFT; typedef EpSiluMul256 EPT; static constexpr size_t LDB = D_EXPERT;
    CParams& p; const MoeTab* tb; int layer; int u, G, nfull; AGather af; BGateUp256 bf; EpSiluMul256 ep; unsigned rowmask;
    __device__ __forceinline__ bool load() { if (u >= nfull) return false; int e, mt, nt; moe_decode8(tb, u, e, mt, nt); e = SCAL(e); mt = SCAL(mt); nt = SCAL(nt);
        const size_t wo = ((size_t)layer * N_EXPERTS + e) * D_MODEL * D_EXPERT; const int cnt = SCAL(tb->cnt[e]), rb = SCAL(tb->rbase[e]);
        af = AGather{p.xn, D_MODEL, p.list_tok + e * LIST_CAP, mt * 256, cnt}; bf = BGateUp256{p.moe_w_gate + wo, (long long)(p.moe_w_up - p.moe_w_gate), D_EXPERT, nt * 128};
        ep = EpSiluMul256{p.hmid, rb + mt * 256, nt * 128}; rowmask = moe_rowmask(cnt, mt); return true; }
    __device__ __forceinline__ bool first() { return load(); }
    __device__ __forceinline__ bool next() { u += G; return load(); }
};
struct DownUnits { typedef BPlain256 BFT; typedef EpScaleRow256 EPT; static constexpr size_t LDB = D_MODEL;
    CParams& p; const MoeTab* tb; int layer; int u, G, nfull; ARows af; BPlain256 bf; EpScaleRow256 ep; unsigned rowmask;
    __device__ __forceinline__ bool load() { if (u >= nfull) return false; int e, mt, nt; moe_decode8(tb, u, e, mt, nt); e = SCAL(e); mt = SCAL(mt); nt = SCAL(nt);
        const size_t wo = ((size_t)layer * N_EXPERTS + e) * D_EXPERT * D_MODEL; const int cnt = SCAL(tb->cnt[e]), rb = SCAL(tb->rbase[e]), r0 = rb + mt * 256;
        af = ARows{p.hmid, D_EXPERT, r0, rb + cnt}; bf = BPlain256{p.moe_w_down + wo, D_MODEL, nt * 256};
        ep = EpScaleRow256{p.ybuf, p.list_w + e * LIST_CAP, mt * 256, cnt, r0, nt * 256}; rowmask = moe_rowmask(cnt, mt); return true; }
    __device__ __forceinline__ bool first() { return load(); }
    __device__ __forceinline__ bool next() { u += G; return load(); }
};
#define SCAL3(a, b, c) do { a = SCAL(a); b = SCAL(b); c = SCAL(c); } while (0)
template <int PROBE = 0>
__device__ __forceinline__ void phase_moe_up_direct(CParams& p, const int layer, char* lds) {
    MoeTab* tb = (MoeTab*)lds; moe_tables(p.cnt + layer * 32, tb);
    const int T = tb->ustart[32] / 2, G = gridDim.x, nfull = (2 * (T % G) > G) ? T : (T / G) * G;
    bf16_t* const hout = PROBE ? (bf16_t*)p.wgu_t : p.hmid;
    int e, mt, nt;
    if (PROBE == 0) { UpUnits un{p, tb, layer, wgid_v(lds), G, nfull, AGather{}, BGateUp256{}, EpSiluMul256{}, 0u}; gemm_tile256_seq(un, D_MODEL, lds + GEMM_LDS_OFF); }
    else
    for (int u = wgid_v(lds); u < nfull; u += G) { moe_decode8(tb, u, e, mt, nt); SCAL3(e, mt, nt);
        const int eb = PROBE >= 2 ? 0 : e, ntb = PROBE >= 2 ? 0 : nt, ea = PROBE >= 3 ? 0 : e, mta = PROBE >= 3 ? 0 : mt;
        const size_t wo = ((size_t)layer * N_EXPERTS + eb) * D_MODEL * D_EXPERT; const int cnt = SCAL(tb->cnt[e]), rb = SCAL(tb->rbase[e]);
        gemm_tile256(AGather{p.xn, D_MODEL, p.list_tok + ea * LIST_CAP, mta * 256, PROBE >= 3 ? 256 : cnt}, BGateUp256{p.moe_w_gate + wo, (long long)(p.moe_w_up - p.moe_w_gate), D_EXPERT, ntb * 128},
                     EpSiluMul256{hout, rb + mt * 256, nt * 128}, D_MODEL, lds + GEMM_LDS_OFF, moe_rowmask(cnt, mt)); }
    for (int j = wgid_v(lds); j < 2 * (T - nfull); j += G) { moe_decode8(tb, nfull + (j >> 1), e, mt, nt); const int n2 = 2 * nt + (j & 1);
        const int eb = PROBE >= 2 ? 0 : e, n2b = PROBE >= 2 ? 0 : n2, ea = PROBE >= 3 ? 0 : e, mta = PROBE >= 3 ? 0 : mt;
        const size_t wo = ((size_t)layer * N_EXPERTS + eb) * D_MODEL * D_EXPERT; const int cnt = tb->cnt[e];
        gemm_tile(AGather{p.xn, D_MODEL, p.list_tok + ea * LIST_CAP, mta * 256, PROBE >= 3 ? 256 : cnt}, BGateUp{p.moe_w_gate + wo, (long long)(p.moe_w_up - p.moe_w_gate), D_EXPERT, n2b * 64},
                  EpSiluMul{hout, tb->rbase[e] + mt * 256, n2 * 64}, D_MODEL, lds + GEMM_LDS_OFF, moe_rowmask(cnt, mt)); }
    __syncthreads();
}
__device__ __forceinline__ void phase_moe_down_direct(CParams& p, const int layer, char* lds) {
    MoeTab* tb = (MoeTab*)lds; (void)layer;
    const int T = tb->ustart[32] / 2, G = gridDim.x, nfull = (2 * (T % G) > G) ? T : (T / G) * G;
    int e, mt, nt;
    { DownUnits un{p, tb, layer, wgid_v(lds), G, nfull, ARows{}, BPlain256{}, EpScaleRow256{}, 0u}; gemm_tile256_seq(un, D_EXPERT, lds + GEMM_LDS_OFF); }
    for (int j = wgid_v(lds); j < 2 * (T - nfull); j += G) { moe_decode8(tb, nfull + (j >> 1), e, mt, nt); const int n2 = 2 * nt + (j & 1);
        const size_t wo = ((size_t)layer * N_EXPERTS + e) * D_EXPERT * D_MODEL; const int cnt = tb->cnt[e], r0 = tb->rbase[e] + mt * 256;
        gemm_tile(ARows{p.hmid, D_EXPERT, r0, tb->rbase[e] + cnt}, BPlain{p.moe_w_down + wo, D_MODEL, n2 * 128, D_MODEL},
                  EpScaleRow{p.ybuf, p.list_w + e * LIST_CAP, mt * 256, cnt, r0, n2 * 128}, D_EXPERT, lds + GEMM_LDS_OFF, moe_rowmask(cnt, mt)); }
    __syncthreads();
}
__device__ __forceinline__ bool moe_decode8(const MoeTab* tb, int u, int& e, int& mt, int& nt) {
    if (2 * u >= tb->ustart[32]) return false;
    { const int l = tidx() & 63; const int us = tb->ustart[l < 32 ? l : 32];
      const unsigned long long m = __ballot(l < 32 && 2 * u >= us);
      e = 63 - __builtin_clzll(m); }
    const int loc = u - tb->ustart[e] / 2, tiles = (tb->cnt[e] + 255) >> 8;
    nt = loc / tiles; mt = loc - nt * tiles; return true;
}
__device__ __forceinline__ void phase_moe_up(CParams& p, const int layer, char* lds) {
    MoeTab* tb = (MoeTab*)lds; moe_tables(p.cnt + layer * 32, tb);
    int e, mt, nt; int it = 0; const int myslot = blockIdx.x & 1;
    for (int u = blockIdx.x; moe_decode8(tb, u, e, mt, nt); u += gridDim.x, ++it) {
        if (CONV_MODE == 1 && it == myslot) moe_convert<2>(p, layer * 32, layer * 32 + 32, lds + 1024);
        const int cnt = tb->cnt[e]; const int* list = p.list_tok + e * LIST_CAP;
        unsigned ao[2][2], bo[2];
        { const int tid = tidx();
#pragma unroll
          for (int i = 0; i < 2; ++i) { int R, C; stage_rc(tid * 16 + i * 8192, R, C);
#pragma unroll
              for (int h = 0; h < 2; ++h) { const int g = mt * 256 + h * 128 + R; const int tok = g < cnt ? list[g] : 0; ao[h][i] = (unsigned)(tok * D_MODEL + C); } } }
        g8_offsets2(bo, nt * 256, D_MODEL);
        gemm8_unit<true>(p.xn, ao, D_MODEL, p.wgu_t + (size_t)(layer * N_EXPERTS + e) * 2048 * 2048, bo, D_MODEL, lds + GEMM_LDS_OFF,
                   E8SiluMul{p.hmid, tb->rbase[e] + mt * 256, nt * 128}, cnt - mt * 256 > 128); }
    if (CONV_MODE == 1 && myslot >= it) moe_convert<2>(p, layer * 32, layer * 32 + 32, lds + 1024);
    __syncthreads();
}
__device__ __forceinline__ void phase_moe_down(CParams& p, const int layer, char* lds) {
    MoeTab* tb = (MoeTab*)lds; moe_tables(p.cnt + layer * 32, tb);
    int e, mt, nt;
    for (int u = blockIdx.x; moe_decode8(tb, u, e, mt, nt); u += gridDim.x) {
        const int cnt = tb->cnt[e], r0 = tb->rbase[e] + mt * 256;
        unsigned ao[2][2], bo[2]; g8_offsets2(ao[0], r0, D_EXPERT); ao[1][0] = ao[1][1] = 0u; g8_offsets2(bo, nt * 256, D_EXPERT);
        gemm8_unit<false>(p.hmid, ao, D_EXPERT, p.wd_t + (size_t)(layer * N_EXPERTS + e) * 2048 * 1024, bo, D_EXPERT, lds + GEMM_LDS_OFF,
                   E8ScaleRow{p.ybuf, p.list_w + e * LIST_CAP, mt * 256, cnt, r0, nt * 256}, cnt - mt * 256 > 128); }
    __syncthreads();
}

#define NPHASE 18
template <int PH> __device__ __forceinline__ void run_phase(CParams& p, char* lds) {
    if (PH == 0) phase_first(p, lds);
    if (PH == 1) phase_qkv(p, lds);
    if (PH == 2) phase_diff_attn(p, lds);
    if (PH == 3) phase_oproj<false>(p, p.wt_a_out, p.x, p.h1, lds);
    if (PH == 4) phase_norm_route(p, p.h1, 0, lds);
    if (PH == 5) { if (MOE_G8) phase_moe_up(p, 0, lds); else phase_moe_up_direct(p, 0, lds); }
    if (PH == 6) { if (MOE_G8) phase_moe_down(p, 0, lds); else phase_moe_down_direct(p, 0, lds); }
    if (PH == 7) phase_combine<0>(p, p.h1, p.h2, p.attn_norm_w + D_MODEL, 0, lds);
    if (PH == 8) phase_proj(p, lds);
    if (PH == 9) phase_cmp1(p, lds);
    if (PH == 10) phase_cmp_reduce(p);
    if (PH == 11) phase_cmp2(p, lds);
    if (PH == 12) phase_nsa(p, lds);
    if (PH == 13) phase_oproj<true>(p, p.wt_b_out, p.h2, p.h1, lds);
    if (PH == 14) phase_norm_route(p, p.h1, 1, lds);
    if (PH == 15) { if (MOE_G8) phase_moe_up(p, 1, lds); else phase_moe_up_direct(p, 1, lds); }
    if (PH == 16) { if (MOE_G8) phase_moe_down(p, 1, lds); else phase_moe_down_direct(p, 1, lds); }
    if (PH == 17) phase_combine<1>(p, p.h1, nullptr, p.final_norm_w, 1, lds);
}
#if defined(ONLY_PH)
#define PHASE(PH) do { if (PH == ONLY_PH) { CParams* q_ = kp; asm volatile("" : "+s"(q_)); run_phase<PH>(*q_, lds); } } while (0)
#elif N_LAUNCH_MODE == 1
#ifndef DUP_MASK
#define DUP_MASK 0
#endif
#define PHASE(PH) do { { CParams* q_ = kp; asm volatile("" : "+s"(q_)); run_phase<PH>(*q_, lds); } \
        if ((DUP_MASK >> PH) & 1) { xcd_barrier(bar); CParams* q_ = kp; asm volatile("" : "+s"(q_)); run_phase<PH>(*q_, lds); } \
        if (PH + 1 < NPHASE) xcd_barrier(bar); } while (0)
#else
#define PHASE(PH) do { if (kp->phase_lo == PH) { CParams* q_ = kp; asm volatile("" : "+s"(q_)); run_phase<PH>(*q_, lds); } } while (0)
#endif
__global__ void __launch_bounds__(NTHREADS, 2) fwd_kernel(Params p_unused) {
    extern __shared__ __attribute__((aligned(16))) char lds[];
    CParams* kp = (CParams*)__builtin_amdgcn_kernarg_segment_ptr();
    if (threadIdx.x == 0) *(uint4*)(lds + LDS_BYTES - 16) = make_uint4(0u, 0u, 0u, 0u);
    __syncthreads();
    XcdBarrier bar = xcd_barrier_post(kp->bar, (volatile LAS unsigned*)(lds + LDS_BYTES - 16));
    (void)bar;
    PHASE(0);
#if N_LAUNCH_MODE == 1 && !defined(ONLY_PH)
    { volatile LAS unsigned* st_ = (volatile LAS unsigned*)(lds + LDS_BYTES - 16);
      if (threadIdx.x == 0) { unsigned base_ = 0u;
          _Pragma("unroll") for (unsigned j = 0; j < 16; ++j) { const unsigned c_ = xb_ld(&bar.bar[XB_XCNT(j)]); base_ += j < bar.x ? c_ : 0u; }
          st_[2] = base_ + bar.rank; }
      __syncthreads(); }
#endif
    PHASE(1); PHASE(2); PHASE(3); PHASE(4); PHASE(5);
#if defined(PROBE_UP) && N_LAUNCH_MODE == 1 && !defined(ONLY_PH)
    { CParams* q_ = kp; asm volatile("" : "+s"(q_)); phase_moe_up_direct<PROBE_UP>(*q_, 0, lds); xcd_barrier(bar); }
#endif
    PHASE(6); PHASE(7); PHASE(8);
    PHASE(9); PHASE(10); PHASE(11); PHASE(12); PHASE(13); PHASE(14); PHASE(15); PHASE(16); PHASE(17);
}

static inline size_t al256(size_t v) { return (v + 255) & ~(size_t)255; }
extern "C" void kernel_launch(void* const* d_in, const int* in_sizes, int n_in, void* d_out, int out_size, void* d_ws, size_t ws_size, hipStream_t stream) {
    (void)in_sizes; (void)n_in; (void)out_size; (void)ws_size;
    Params p; memset(&p, 0, sizeof(p));
    p.x = (const float*)d_in[0]; p.attn_norm_w = (const float*)d_in[1]; p.ffn_norm_w = (const float*)d_in[2]; p.final_norm_w = (const float*)d_in[3];
    p.a_w_in = (const float*)d_in[4]; p.a_lambda = (const float*)d_in[5]; p.a_subln_w = (const float*)d_in[6]; p.a_w_out = (const float*)d_in[7];
    p.b_w_in = (const float*)d_in[8]; p.b_cmp_pos = (const float*)d_in[9]; p.b_cmp_w1 = (const float*)d_in[10]; p.b_cmp_w2 = (const float*)d_in[11]; p.b_w_out = (const float*)d_in[12];
    p.moe_w_group = (const float*)d_in[13]; p.moe_b_group = (const float*)d_in[14]; p.moe_w_expert = (const float*)d_in[15]; p.moe_b_expert = (const float*)d_in[16];
    p.moe_w_gate = (const float*)d_in[17]; p.moe_w_up = (const float*)d_in[18]; p.moe_w_down = (const float*)d_in[19];
    p.out = (float*)d_out;
    char* w = (char*)d_ws; size_t off = 0;
#define CARVE(ptr, type, bytes) do { ptr = (type)(w + off); off = al256(off + (size_t)(bytes)); } while (0)
    CARVE(p.bar, unsigned*, XCD_BAR_WORDS * 4);
    CARVE(p.cnt, unsigned*, 128 * 4);
    CARVE(p.rw_hi, bf16_t*, (size_t)2 * 64 * D_MODEL * 2);
    CARVE(p.rw_lo, bf16_t*, (size_t)2 * 64 * D_MODEL * 2);
    CARVE(p.diag, unsigned*, 256 * 4);
    CARVE(p.xn, bf16_t*, (size_t)T_TOK * D_MODEL * 2);
    CARVE(p.qkv, bf16_t*, (size_t)T_TOK * A_IN * 2);
    CARVE(p.gate, float*, (size_t)T_TOK * 48 * 4);
    CARVE(p.attn_o, bf16_t*, (size_t)T_TOK * D_MODEL * 2);
    CARVE(p.h1, bf16_t*, (size_t)T_TOK * D_MODEL * 2);
    CARVE(p.h2, bf16_t*, (size_t)T_TOK * D_MODEL * 2);
    CARVE(p.hmid, bf16_t*, (size_t)MAX_ROWS * D_EXPERT * 2);
    CARVE(p.ybuf, bf16_t*, (size_t)MAX_ROWS * D_MODEL * 2);
    CARVE(p.list_tok, int*, (size_t)32 * LIST_CAP * 4);
    CARVE(p.list_w, float*, (size_t)32 * LIST_CAP * 4);
    CARVE(p.slot_ref, int*, (size_t)T_TOK * 2 * 4);
    CARVE(p.cbias, float*, 512 * 4);
    CARVE(p.cslab, float*, (size_t)8 * 2 * 2048 * 256 * 4);
    CARVE(p.chid, bf16_t*, (size_t)2 * 2048 * 256 * 2);
    CARVE(p.kvcmp, bf16_t*, (size_t)2 * 2048 * 128 * 2);
    CARVE(p.wt_a_in, bf16_t*, (size_t)A_IN * D_MODEL * 2);
    CARVE(p.wt_a_out, bf16_t*, (size_t)D_MODEL * D_MODEL * 2);
    CARVE(p.wt_b_in, bf16_t*, (size_t)5376 * D_MODEL * 2);
    CARVE(p.wt_b_out, bf16_t*, (size_t)D_MODEL * D_MODEL * 2);
    CARVE(p.wgu_t, bf16_t*, (size_t)64 * 2048 * 2048 * 2);
    CARVE(p.wd_t, bf16_t*, (size_t)64 * 2048 * 1024 * 2);
    static int grid = 0;
    if (!grid) {
        (void)hipFuncSetAttribute((const void*)fwd_kernel, hipFuncAttributeMaxDynamicSharedMemorySize, LDS_BYTES);
        int dev = 0, cus = 0, per_cu = 0;
        (void)hipGetDevice(&dev);
        if (hipDeviceGetAttribute(&cus, hipDeviceAttributeMultiprocessorCount, dev) != hipSuccess || cus <= 0) cus = 256;
        if (hipOccupancyMaxActiveBlocksPerMultiprocessor(&per_cu, (const void*)fwd_kernel, NTHREADS, LDS_BYTES) != hipSuccess || per_cu < 1) per_cu = 1;
        grid = cus * 1;
        if (grid > 256) grid = 256;
    }
    (void)hipMemsetAsync(p.bar, 0, XCD_BAR_WORDS * 4, stream);
#if N_LAUNCH_MODE == 1
    p.phase_lo = 0; p.phase_hi = NPHASE;
    hipLaunchKernelGGL(fwd_kernel, dim3(grid), dim3(NTHREADS), LDS_BYTES, stream, p);
#else
    for (int ph = 0; ph < NPHASE; ++ph) { p.phase_lo = ph; p.phase_hi = ph + 1; hipLaunchKernelGGL(fwd_kernel, dim3(grid), dim3(NTHREADS), LDS_BYTES, stream, p); }
#endif
}
```

```cpp
#include <hip/hip_runtime.h>
#include <stdint.h>
#include <stdio.h>
#include <string.h>

#ifndef CONV_MODE
#define CONV_MODE 2
#endif
#ifndef MOE_G8
#define MOE_G8 0
#endif
#ifndef PP_MODE
#define PP_MODE 1
#endif
#ifndef N_LAUNCH_MODE
#define N_LAUNCH_MODE 1
#endif

#define D_MODEL 2048
#define BATCH 2
#define SEQ 4096
#define T_TOK (BATCH * SEQ)
#define A_HEADS 8
#define A_IN 6144
#define B_HEADS 16
#define B_GROUPS 4
#define B_IN 5168
#define B_MAIN 5120
#define NC 255
#define N_EXPERTS 32
#define D_EXPERT 1024
#define LIST_CAP 8192
#define MAX_ROWS (16384 + 32 * 256)
#define EPS 1e-6f

typedef unsigned short bf16_t;
typedef short bf16x8 __attribute__((ext_vector_type(8)));
typedef short s16x4 __attribute__((ext_vector_type(4)));
typedef float f32x4 __attribute__((ext_vector_type(4)));
typedef float f32x16 __attribute__((ext_vector_type(16)));
typedef unsigned u32x4 __attribute__((ext_vector_type(4)));
typedef unsigned u32x2 __attribute__((ext_vector_type(2)));

#define NTHREADS 512
#define LDS_BYTES (160 * 1024 - 256)

__device__ __forceinline__ unsigned cvtpk(float lo, float hi) {
    unsigned r; asm volatile("v_cvt_pk_bf16_f32 %0, %1, %2" : "=v"(r) : "v"(lo), "v"(hi)); return r;
}
__device__ __forceinline__ float bf2f(bf16_t v) { return __uint_as_float(((unsigned)v) << 16); }
__device__ __forceinline__ bf16_t f2bf(float f) { return (bf16_t)(cvtpk(f, 0.f) & 0xffffu); }
__device__ __forceinline__ int tidx() { int t = threadIdx.x; asm volatile("" : "+v"(t)); return t; }
template <int O> __device__ __forceinline__ int shx_i(int v) {
    if constexpr (O < 32) return __builtin_amdgcn_ds_swizzle(v, (O << 10) | 0x1f);
    else { const int l = tidx(); return __builtin_amdgcn_ds_bpermute(((l & 63) ^ 32) << 2, v); }
}
template <int O> __device__ __forceinline__ float shx(float v) { return __int_as_float(shx_i<O>(__float_as_int(v))); }
__device__ __forceinline__ float wave_sum(float v) {
    v += shx<32>(v); v += shx<16>(v); v += shx<8>(v); v += shx<4>(v); v += shx<2>(v); v += shx<1>(v);
    return v;
}

#define XB_TMO      128
#define XB_XCNT(j)  (256  + 64 * (j))
#define XB_XSUB(j)  (1280 + 64 * (j))
#define XB_XGEN(j)  (2304 + 64 * (j))
#define XB_TOP      3328
#define XB_TOPGEN   3392
#define XCD_BAR_WORDS 3456
#define XB_SPIN_CAP (1u << 22)
#define LAS __attribute__((address_space(3)))

__device__ __forceinline__ unsigned xb_ld(unsigned* p)              { return __hip_atomic_load(p, __ATOMIC_RELAXED, __HIP_MEMORY_SCOPE_AGENT); }
__device__ __forceinline__ unsigned xb_add(unsigned* p, unsigned v) { return __hip_atomic_fetch_add(p, v, __ATOMIC_RELAXED, __HIP_MEMORY_SCOPE_AGENT); }
__device__ __forceinline__ unsigned xb_xcc_id() { return (unsigned)__builtin_amdgcn_s_getreg((3 << 11) | 20) & 0xFu; }
#define XB_SPIN(cond, bar) do { unsigned _sp = 0; while (cond) { __builtin_amdgcn_s_sleep(1); \
    if ((++_sp & 255u) == 0u) { if (xb_ld(&(bar)[XB_TMO])) break; if (_sp > XB_SPIN_CAP) { atomicAdd(&(bar)[XB_TMO], 1u); break; } } } } while (0)

struct XcdBarrier { unsigned* bar; unsigned x; volatile LAS unsigned* st; unsigned rank; };

__device__ __forceinline__ XcdBarrier xcd_barrier_post(unsigned* bar, volatile LAS unsigned* st) {
    XcdBarrier b; b.bar = bar; b.x = xb_xcc_id(); b.st = st; b.rank = 0u;
    if (threadIdx.x == 0) b.rank = xb_add(&bar[XB_XCNT(b.x)], 1u);
    return b;
}
__device__ __forceinline__ void xcd_barrier_complete(unsigned* bar, unsigned x, unsigned& nloc, unsigned& nx) {
    const unsigned G = gridDim.x * gridDim.y * gridDim.z;
    unsigned sum, cnt, mine, sp = 0u;
    for (;;) {
        sum = 0u; cnt = 0u; mine = 0u;
#pragma unroll
        for (unsigned j = 0; j < 16; ++j) { const unsigned c = xb_ld(&bar[XB_XCNT(j)]); sum += c; cnt += (c > 0u) ? 1u : 0u; mine = (j == x) ? c : mine; }
        if (sum == G) break;
        __builtin_amdgcn_s_sleep(1);
        if ((++sp & 255u) == 0u) { if (xb_ld(&bar[XB_TMO])) break; if (sp > XB_SPIN_CAP) { atomicAdd(&bar[XB_TMO], 1u); break; } }
    }
    nloc = mine > 0u ? mine : 1u; nx = cnt > 0u ? cnt : 1u;
}
__device__ __forceinline__ void xcd_barrier(const XcdBarrier& b) {
    asm volatile("s_waitcnt vmcnt(0)" ::: "memory");
    __syncthreads();
    if (threadIdx.x == 0) {
        unsigned* bar = b.bar;
        __builtin_amdgcn_s_waitcnt(0);
        unsigned nloc = b.st[0], nx = b.st[1];
        if (nloc == 0u) { xcd_barrier_complete(bar, b.x, nloc, nx); b.st[0] = nloc; b.st[1] = nx; }
        const unsigned old = xb_add(&bar[XB_XSUB(b.x)], 1u);
        const unsigned gen = old / nloc;
        if (old + 1u == (gen + 1u) * nloc) {
            __builtin_amdgcn_fence(__ATOMIC_RELEASE, "agent");
            asm volatile("s_waitcnt vmcnt(0)" ::: "memory");
            const unsigned og = xb_add(&bar[XB_TOP], 1u);
            const unsigned tg = og / nx;
            if (og + 1u == (tg + 1u) * nx) xb_add(&bar[XB_TOPGEN], 1u);
            else XB_SPIN(xb_ld(&bar[XB_TOPGEN]) == tg, bar);
            __builtin_amdgcn_fence(__ATOMIC_ACQUIRE, "agent");
            xb_add(&bar[XB_XGEN(b.x)], 1u);
            asm volatile("s_waitcnt vmcnt(0)" ::: "memory");
        } else {
            XB_SPIN(xb_ld(&bar[XB_XGEN(b.x)]) == gen, bar);
            __builtin_amdgcn_fence(__ATOMIC_ACQUIRE, "agent");
            asm volatile("s_waitcnt vmcnt(0)" ::: "memory");
        }
    }
    __syncthreads();
}

__device__ __forceinline__ int wgid_v(char* lds);
struct Params {
    const float* x; const float* attn_norm_w; const float* ffn_norm_w; const float* final_norm_w;
    const float* a_w_in; const float* a_lambda; const float* a_subln_w; const float* a_w_out;
    const float* b_w_in; const float* b_cmp_pos; const float* b_cmp_w1; const float* b_cmp_w2; const float* b_w_out;
    const float* moe_w_group; const float* moe_b_group; const float* moe_w_expert; const float* moe_b_expert;
    const float* moe_w_gate; const float* moe_w_up; const float* moe_w_down;
    float* out;
    unsigned* bar;
    unsigned* cnt;
    bf16_t* xn;
    bf16_t* qkv;
    float* gate;
    bf16_t* attn_o;
    bf16_t* h1;
    bf16_t* h2;
    bf16_t* rw_hi;
    bf16_t* rw_lo;
    bf16_t* hmid;
    bf16_t* ybuf;
    int* list_tok;
    float* list_w;
    int* slot_ref;
    float* cbias;
    float* cslab;
    bf16_t* chid;
    bf16_t* kvcmp;
    bf16_t* wt_a_in; bf16_t* wt_a_out; bf16_t* wt_b_in; bf16_t* wt_b_out;
    bf16_t* wgu_t; bf16_t* wd_t;
    unsigned* diag;
    int phase_lo, phase_hi;
};
typedef const __attribute__((address_space(4))) Params CParams;

__device__ __forceinline__ int lds_byte(int r, int c) { const int st = (r >> 4) * 2 + (c >> 5), rr = r & 15, cc = c & 31, ob = rr * 64 + cc * 2; return st * 1024 + (ob ^ (((ob >> 9) & 1) << 5)); }

#define G_BM 256
#define G_BN 128
#define G_BK 64
#define G_ABYTES (G_BM * G_BK * 2)
#define G_BBYTES (G_BN * G_BK * 2)
#define G_BUF (G_ABYTES + G_BBYTES)

template <bool LIGHT = false, class AF, class BF, class EP>
__device__ __forceinline__ void gemm_tile(const AF& af, const BF& bf, const EP& ep, const int K, char* lds, const unsigned rowmask  ) {
    const int tid = tidx(), wid = tid >> 6, lane = tid & 63, wr = wid >> 1, wc = wid & 1, fr = lane & 15, fq = lane >> 4;
    f32x4 acc[4][4];
#pragma unroll
    for (int m = 0; m < 4; ++m)
#pragma unroll
        for (int n = 0; n < 4; ++n) acc[m][n] = (f32x4){0.f, 0.f, 0.f, 0.f};
    const int a_r0 = tid >> 3, a_kc = (tid & 7) * 8;
    const bf16_t* ap[4]; unsigned avm = 0u;
#pragma unroll
    for (int i = 0; i < 4; ++i) { ap[i] = af.a_row(a_r0 + 64 * i); if (ap[i]) avm |= 1u << i; else ap[i] = af.safe(); }
    const int b_nb = (lane & 7) + 8 * (wid >> 1), b_kb = (lane >> 3) + 8 * (wid & 1);
    const float* bp = bf.colptr(4 * b_nb); const bool bvm = bp != nullptr; if (!bvm) bp = bf.safe();
    const bf16_t* bt16 = bf.bt16();
    const size_t ldb = bf.ldb;
    u32x4 ar0[4], ar1[4], ar2[4]; f32x4 br0[4], br1[4], br2[4];
    const int nk = K / G_BK;
    const bool act = (rowmask >> wr) & 1u;
    const int sa_base = lds_byte(a_r0, a_kc), sb_base = lds_byte(4 * b_nb, 4 * b_kb);
    const int fa_base = lds_byte(wr * 64 + fr, fq * 8), fb_base = lds_byte(wc * 64 + fr, fq * 8);

#define G_LOAD(kt, AR, BR) do { const int k0_ = (kt) * G_BK; const int ko_ = af.koff(k0_) + a_kc; \
        _Pragma("unroll") for (int i = 0; i < 4; ++i) AR[i] = *(const u32x4*)(ap[i] + ko_); \
        if (BF::IS_BF16) { _Pragma("unroll") for (int i = 0; i < 2; ++i) BR[i] = *(const f32x4*)(bt16 + (size_t)(a_r0 + 64 * i) * ldb + k0_ + a_kc); } \
        else { _Pragma("unroll") for (int i = 0; i < 4; ++i) BR[i] = *(const f32x4*)(bp + (size_t)(k0_ + 4 * b_kb + i) * ldb); } } while (0)
#define G_STORE(kt, AR, BR) do { char* A_ = lds + ((kt) & 1) * G_BUF; char* B_ = A_ + G_ABYTES; \
        _Pragma("unroll") for (int i = 0; i < 4; ++i) *(u32x4*)(A_ + sa_base + i * 8192) = ((avm >> i) & 1u) ? AR[i] : (u32x4){0u, 0u, 0u, 0u}; \
        _Pragma("unroll") for (int j = 0; j < 4; ++j) { u32x2 w_; w_.x = cvtpk(BR[0][j], BR[1][j]); w_.y = cvtpk(BR[2][j], BR[3][j]); if (!bvm) { w_.x = 0u; w_.y = 0u; } \
            *(u32x2*)(B_ + sb_base + j * 64) = w_; } } while (0)
#define G_COMPUTE(kt) do { if (act) { const char* A_ = lds + ((kt) & 1) * G_BUF; const char* B_ = A_ + G_ABYTES; \
        _Pragma("unroll") for (int ks = 0; ks < 2; ++ks) { bf16x8 a[4], b[4]; \
            _Pragma("unroll") for (int m = 0; m < 4; ++m) a[m] = *(const bf16x8*)(A_ + fa_base + m * 2048 + ks * 1024); \
            _Pragma("unroll") for (int n = 0; n < 4; ++n) b[n] = *(const bf16x8*)(B_ + fb_base + n * 2048 + ks * 1024); \
            _Pragma("unroll") for (int m = 0; m < 4; ++m) _Pragma("unroll") for (int n = 0; n < 4; ++n) \
                acc[m][n] = __builtin_amdgcn_mfma_f32_16x16x32_bf16(b[n], a[m], acc[m][n], 0, 0, 0); } } } while (0)
#define G_STEP(kt, ARc, BRc, ARn, BRn) do { G_LOAD((kt) + 3, ARc, BRc); G_COMPUTE(kt); G_STORE((kt) + 1, ARn, BRn); __syncthreads(); } while (0)
#define G_TAIL(kt, ARn, BRn) do { if ((kt) < nk) { G_COMPUTE(kt); if ((kt) + 1 < nk) G_STORE((kt) + 1, ARn, BRn); __syncthreads(); } } while (0)

    if (LIGHT) {
        G_LOAD(0, ar0, br0); G_STORE(0, ar0, br0); __syncthreads();
        for (int k1 = 0; k1 < nk; ++k1) { if (k1 + 1 < nk) G_LOAD(k1 + 1, ar0, br0); G_COMPUTE(k1); if (k1 + 1 < nk) G_STORE(k1 + 1, ar0, br0); __syncthreads(); }
        if (act) ep(acc, wr, wc, fr, fq);
        __syncthreads();
        return;
    }
#if PP_MODE == 0
    G_LOAD(0, ar0, br0); G_LOAD(1, ar1, br1); G_LOAD(2, ar2, br2);
    G_STORE(0, ar0, br0);
    __syncthreads();
    { int kt = 0;
      for (; kt + 5 < nk; kt += 3) { G_STEP(kt, ar0, br0, ar1, br1); G_STEP(kt + 1, ar1, br1, ar2, br2); G_STEP(kt + 2, ar2, br2, ar0, br0); }
      if (kt + 3 < nk) G_LOAD(kt + 3, ar0, br0);
      G_COMPUTE(kt); if (kt + 1 < nk) G_STORE(kt + 1, ar1, br1); __syncthreads();
      if (kt + 4 < nk) G_LOAD(kt + 4, ar1, br1);
      G_TAIL(kt + 1, ar2, br2); G_TAIL(kt + 2, ar0, br0); G_TAIL(kt + 3, ar1, br1); G_TAIL(kt + 4, ar2, br2); }
#else
#define PP_STAGE(t) (lds + ((t) % 3) * G_BUF)
#define PP_STORE(t, AR, BR) do { char* A_ = PP_STAGE(t); char* B_ = A_ + G_ABYTES; \
        _Pragma("unroll") for (int i = 0; i < 4; ++i) *(u32x4*)(A_ + sa_base + i * 8192) = ((avm >> i) & 1u) ? AR[i] : (u32x4){0u, 0u, 0u, 0u}; \
        if (BF::IS_BF16) { _Pragma("unroll") for (int i = 0; i < 2; ++i) *(f32x4*)(B_ + sa_base + i * 8192) = BR[i]; } \
        else { _Pragma("unroll") for (int j = 0; j < 4; ++j) { u32x2 w_; w_.x = cvtpk(BR[0][j], BR[1][j]); w_.y = cvtpk(BR[2][j], BR[3][j]); if (!bvm) { w_.x = 0u; w_.y = 0u; } \
            *(u32x2*)(B_ + sb_base + j * 64) = w_; } } } while (0)
#define PP_READ(t, ks) do { if (act) { const char* A_ = PP_STAGE(t); const char* B_ = A_ + G_ABYTES; \
        _Pragma("unroll") for (int m = 0; m < 4; ++m) fa[m] = *(const bf16x8*)(A_ + fa_base + m * 2048 + (ks) * 1024); \
        _Pragma("unroll") for (int n = 0; n < 4; ++n) fb[n] = *(const bf16x8*)(B_ + fb_base + n * 2048 + (ks) * 1024); } } while (0)
#define PP_MMA() do { if (act) { __builtin_amdgcn_s_setprio(1); \
        _Pragma("unroll") for (int m = 0; m < 4; ++m) _Pragma("unroll") for (int n = 0; n < 4; ++n) \
            acc[m][n] = __builtin_amdgcn_mfma_f32_16x16x32_bf16(fb[n], fa[m], acc[m][n], 0, 0, 0); \
        __builtin_amdgcn_s_setprio(0); } } while (0)
#define PP_BAR() __builtin_amdgcn_s_barrier()
#define PP_WL() asm volatile("s_waitcnt lgkmcnt(0)" ::: "memory")
#define PP_STEP(kt, ARs, BRs, DOLOAD, DOSTORE) do { \
        PP_READ(kt, 0); PP_BAR(); PP_WL(); PP_MMA(); PP_BAR(); \
        PP_READ(kt, 1); if (DOSTORE) PP_STORE((kt) + 2, ARs, BRs); if (DOLOAD) G_LOAD((kt) + 5, ARs, BRs); PP_BAR(); PP_WL(); PP_MMA(); PP_BAR(); } while (0)
    bf16x8 fa[4], fb[4];
    const bool grp1 = wid >= 4;
    G_LOAD(0, ar0, br0); G_LOAD(1, ar1, br1); G_LOAD(2, ar2, br2);
    PP_STORE(0, ar0, br0); G_LOAD(3, ar0, br0);
    PP_STORE(1, ar1, br1); G_LOAD(4, ar1, br1);
    asm volatile("s_waitcnt lgkmcnt(0)" ::: "memory");
    __syncthreads();
    if (grp1) PP_BAR();
    int kt = 0;
    for (; kt + 7 < nk; kt += 3) {
        PP_STEP(kt, ar2, br2, true, true);
        PP_STEP(kt + 1, ar0, br0, true, true);
        PP_STEP(kt + 2, ar1, br1, true, true);
    }
#define PP_TAIL(kk, ARs, BRs) do { if ((kk) < nk) { const bool ld_ = (kk) + 5 < nk, st_ = (kk) + 2 < nk; \
        PP_READ(kk, 0); PP_BAR(); PP_WL(); PP_MMA(); PP_BAR(); \
        PP_READ(kk, 1); if (st_) PP_STORE((kk) + 2, ARs, BRs); if (ld_) G_LOAD((kk) + 5, ARs, BRs); PP_BAR(); PP_WL(); PP_MMA(); PP_BAR(); } } while (0)
    PP_TAIL(kt, ar2, br2); PP_TAIL(kt + 1, ar0, br0); PP_TAIL(kt + 2, ar1, br1);
    PP_TAIL(kt + 3, ar2, br2); PP_TAIL(kt + 4, ar0, br0); PP_TAIL(kt + 5, ar1, br1); PP_TAIL(kt + 6, ar2, br2);
    if (!grp1) PP_BAR();
#endif
#undef PP_STAGE
#undef PP_STORE
#undef PP_READ
#undef PP_MMA
#undef PP_BAR
#undef PP_WL
#undef PP_STEP
#undef PP_TAIL
#undef G_LOAD
#undef G_STORE
#undef G_COMPUTE
#undef G_STEP
#undef G_TAIL
    if (act) ep(acc, wr, wc, fr, fq);
    __syncthreads();
}

#define G2_BUF (G_ABYTES + 2 * G_BBYTES)
__device__ __forceinline__ void stage_rc(int b, int& R, int& C);
__device__ __forceinline__ void glds16_asm(const void* gsrc, unsigned lds_dst) {
    unsigned keep;
    asm volatile("s_mov_b32 %0, m0\n\ts_mov_b32 m0, %2\n\ts_nop 0\n\tglobal_load_lds_dwordx4 %1, off\n\ts_mov_b32 m0, %0" : "=&s"(keep) : "v"(gsrc), "s"(lds_dst) : "memory");
}
__device__ __forceinline__ void glds16_asm_s(const void* sbase, unsigned voff, unsigned lds_dst) {
    unsigned keep;
    asm volatile("s_mov_b32 %0, m0\n\ts_mov_b32 m0, %3\n\ts_nop 0\n\tglobal_load_lds_dwordx4 %1, %2\n\ts_mov_b32 m0, %0" : "=&s"(keep) : "v"(voff), "s"(sbase), "s"(lds_dst) : "memory");
}
template <class AF, class BF, class EP>
__device__ __forceinline__ void gemm_tile256(const AF& af, const BF& bf, const EP& ep, const int K, char* lds, const unsigned rowmask) {
    const int tid = tidx(), wid = __builtin_amdgcn_readfirstlane(tid >> 6), lane = tid & 63, wr = wid >> 1, wc = wid & 1, fr = lane & 15, fq = lane >> 4;
    f32x4 acc[4][8];
#pragma unroll
    for (int m = 0; m < 4; ++m)
#pragma unroll
        for (int n = 0; n < 8; ++n) acc[m][n] = (f32x4){0.f, 0.f, 0.f, 0.f};
    const bf16_t* abase = af.safe(); unsigned aoff[4];
#pragma unroll
    for (int i = 0; i < 4; ++i) { int R, C; stage_rc(tid * 16 + (i & 1) * 8192, R, C);
        aoff[i] = 2u * (af.a_off((i >> 1) * 128 + R) + (unsigned)C); }
    const unsigned lds_a = (unsigned)(uintptr_t)lds + (unsigned)wid * 1024u;
    const int b_nl = (lane & 3) + 4 * ((lane >> 5) & 1), b_kl = ((lane >> 2) & 3) + 4 * ((lane >> 4) & 1);
    const size_t ldb = bf.ldb;
    const unsigned boff = (unsigned)((4 * (b_kl + 8 * (wid & 1))) * (int)ldb + 4 * (b_nl + 8 * (wid >> 1))) * 4u;
    const __amdgpu_buffer_rsrc_t rs0 = __builtin_amdgcn_make_buffer_rsrc((void*)bf.base(0), 0, 0x7fffffff, 0x00020000);
    const __amdgpu_buffer_rsrc_t rs1 = __builtin_amdgcn_make_buffer_rsrc((void*)bf.base(1), 0, 0x7fffffff, 0x00020000);
    const unsigned lpk = (unsigned)lds_byte(lane & 15, (lane >> 4) * 8) | ((unsigned)lds_byte((lane & 15) ^ ((lane >> 2) & 1), (lane >> 4) * 8) << 10)
                       | ((unsigned)(lds_byte(4 * b_nl, 4 * b_kl) + (lane & 1) * 64) << 20);
    const int s_fa = (wid >> 1) * 8192, s_fb = (wid & 1) * 16384, s_sb = lds_byte(BF::wrow(wid >> 1), 32 * (wid & 1));
    f32x4 br[8];
    const int nk = K / G_BK;
    const bool act = __builtin_amdgcn_readfirstlane((int)((rowmask >> wr) & 1u)) != 0;
#define G2_SB() ((int)(lpk >> 20) + s_sb)
#define G2_SB1(sb0_) ((sb0_) ^ 64)
#define G2_FA() ((int)(lpk & 1023u) + s_fa)
#define G2_FB() ((int)((lpk >> 10) & 1023u) + s_fb)
#define G2_ADMA(kt) do { const int ko_ = af.koff((kt) * G_BK); const unsigned d_ = lds_a + (unsigned)(((kt) & 1) * G2_BUF); \
        _Pragma("unroll") for (int i = 0; i < 4; ++i) glds16_asm_s(abase + ko_, aoff[i], d_ + (unsigned)(i * 8192)); } while (0)
#define G2_BLOADH(kt, hh) do { const int so_ = (kt) * G_BK * (int)ldb * 4; \
        _Pragma("unroll") for (int i = 0; i < 4; ++i) br[4 * (hh) + i] = __builtin_bit_cast(f32x4, __builtin_amdgcn_raw_buffer_load_b128((hh) ? rs1 : rs0, (int)boff, so_ + i * (int)ldb * 4, 0)); } while (0)
#define G2_PIECE(Bw_, sb_, sb1_, pc) do { u32x2 w_; \
        w_.x = cvtpk(br[4 * ((pc) >> 2) + 0][(pc) & 3], br[4 * ((pc) >> 2) + 1][(pc) & 3]); w_.y = cvtpk(br[4 * ((pc) >> 2) + 2][(pc) & 3], br[4 * ((pc) >> 2) + 3][(pc) & 3]); \
        *(u32x2*)(Bw_ + (((pc) & 1) ? sb1_ : sb_) + ((pc) >> 2) * (BF::HROW * 128) + (((pc) >> 1) & 1) * 128) = w_; } while (0)
#define G2_BSTORE(kt) do { char* Bw_ = lds + ((kt) & 1) * G2_BUF + G_ABYTES; const int sb_ = G2_SB(), sb1_ = G2_SB1(sb_); \
        _Pragma("unroll") for (int pc = 0; pc < 8; ++pc) G2_PIECE(Bw_, sb_, sb1_, pc); } while (0)
#define G2_COMPUTE(kt, ST, RL, ACT, DMA) do { char* Bw_ = lds + (((kt) + 1) & 1) * G2_BUF + G_ABYTES; const int sb_ = (ST) ? G2_SB() : 0, sb1_ = (ST) ? G2_SB1(sb_) : 0; \
        const char* A_ = lds + ((kt) & 1) * G2_BUF; const char* B_ = A_ + G_ABYTES; const int fa_base = (ACT) ? G2_FA() : 0, fb_base = (ACT) ? G2_FB() : 0; \
        bf16x8 a[4], bc; \
        if (ACT) { _Pragma("unroll") for (int m = 0; m < 4; ++m) a[m] = *(const bf16x8*)(A_ + fa_base + m * 2048); \
                   bc = *(const bf16x8*)(B_ + fb_base); } \
        if (DMA) G2_ADMA((kt) + 1);                                  \
        __builtin_amdgcn_sched_barrier(0); \
        _Pragma("unroll") for (int ks = 0; ks < 2; ++ks) { \
            _Pragma("unroll") for (int n = 0; n < 8; ++n) { \
                if (ACT) { const bf16x8 bn = bc; \
                    if (n < 7) bc = *(const bf16x8*)(B_ + fb_base + (n + 1) * 2048 + ks * 1024); \
                    else if (ks == 0) bc = *(const bf16x8*)(B_ + fb_base + 1024); \
                    __builtin_amdgcn_s_setprio(1); \
                    _Pragma("unroll") for (int m = 0; m < 4; ++m) { acc[m][n] = __builtin_amdgcn_mfma_f32_16x16x32_bf16(bn, a[m], acc[m][n], 0, 0, 0); \
                        if (ks == 0 && n == 7) { __builtin_amdgcn_sched_barrier(0); a[m] = *(const bf16x8*)(A_ + fa_base + m * 2048 + 1024); } }     \
                    __builtin_amdgcn_s_setprio(0); } \
                if ((ST) && (n & 1)) G2_PIECE(Bw_, sb_, sb1_, ks * 4 + (n >> 1)); \
                if ((RL) && n == 7) G2_BLOADH((kt) + 2, ks); \
                __builtin_amdgcn_sched_barrier(0); } } } while (0)
    G2_ADMA(0); G2_BLOADH(0, 0); G2_BLOADH(0, 1);
    G2_BSTORE(0);
    __builtin_amdgcn_sched_barrier(0);
    if (nk > 1) { G2_BLOADH(1, 0); G2_BLOADH(1, 1); asm volatile("s_waitcnt vmcnt(8)" ::: "memory"); }
    else asm volatile("s_waitcnt vmcnt(0)" ::: "memory");
    __syncthreads();
#define G2_LOOP(ACT) do { int kt = 0; \
    for (; kt + 2 < nk; ++kt) { G2_COMPUTE(kt, 1, 1, ACT, 1); asm volatile("s_waitcnt vmcnt(8)" ::: "memory"); __syncthreads(); } \
    if (kt + 1 < nk) { G2_COMPUTE(kt, 1, 0, ACT, 1); asm volatile("s_waitcnt vmcnt(0)" ::: "memory"); __syncthreads(); ++kt; } \
    G2_COMPUTE(kt, 0, 0, ACT, 0); \
    __syncthreads(); } while (0)
    if (act) G2_LOOP(1); else G2_LOOP(0);
#undef G2_LOOP
#undef G2_BLOADH
#undef G2_PIECE
#undef G2_SB
#undef G2_SB1
#undef G2_FA
#undef G2_FB
#undef G2_ADMA
#undef G2_BSTORE
#undef G2_COMPUTE
    { const int l2_ = tidx() & 63; if (act) ep(acc, wr, wc, l2_ & 15, l2_ >> 4); }
    __syncthreads();
}
template <class UN>
__device__ __forceinline__ void gemm_tile256_seq(UN& un, const int K, char* lds) {
    typedef typename UN::BFT BF;
    const int tid = tidx(), wid = __builtin_amdgcn_readfirstlane(tid >> 6), lane = tid & 63, wr = wid >> 1, wc = wid & 1, fr = lane & 15, fq = lane >> 4;
    f32x4 acc[4][8];
    const bf16_t* abase = nullptr; unsigned aoff[4] = {0u, 0u, 0u, 0u};
    const unsigned lds_a = (unsigned)(uintptr_t)lds + (unsigned)wid * 1024u;
    const int b_nl = (lane & 3) + 4 * ((lane >> 5) & 1), b_kl = ((lane >> 2) & 3) + 4 * ((lane >> 4) & 1);
    const size_t ldb = UN::LDB;
    const int s_bo = ((32 * (wid & 1)) * (int)ldb + 32 * (wid >> 1)) * 4;
    __amdgpu_buffer_rsrc_t rs0 = __builtin_amdgcn_make_buffer_rsrc((void*)nullptr, 0, 0x7fffffff, 0x00020000), rs1 = rs0;
#define T2_SETUP() do { abase = un.af.safe(); \
        _Pragma("unroll") for (int i = 0; i < 4; ++i) { int R, C; stage_rc(tidx() * 16 + (i & 1) * 8192, R, C); aoff[i] = 2u * (un.af.a_off((i >> 1) * 128 + R) + (unsigned)C); } \
        rs0 = __builtin_amdgcn_make_buffer_rsrc((void*)un.bf.base(0), 0, 0x7fffffff, 0x00020000); rs1 = __builtin_amdgcn_make_buffer_rsrc((void*)un.bf.base(1), 0, 0x7fffffff, 0x00020000); } while (0)
    const unsigned lpk = (unsigned)lds_byte(lane & 15, (lane >> 4) * 8) | ((unsigned)lds_byte((lane & 15) ^ ((lane >> 2) & 1), (lane >> 4) * 8) << 10)
                       | ((unsigned)(lds_byte(4 * b_nl, 4 * b_kl) + (lane & 1) * 64) << 20);
    const int s_fa = (wid >> 1) * 8192, s_fb = (wid & 1) * 16384, s_sb = lds_byte(BF::wrow(wid >> 1), 32 * (wid & 1));
    f32x4 br[8];
    const int nk = K / G_BK;
#define G2_SB() ((int)(lpk >> 20) + s_sb)
#define G2_SB1(sb0_) ((sb0_) ^ 64)
#define G2_FA() ((int)(lpk & 1023u) + s_fa)
#define G2_FB() ((int)((lpk >> 10) & 1023u) + s_fb)
#define G2_ADMA(kt) do { const int ko_ = (kt) * G_BK; const unsigned d_ = lds_a + (unsigned)(((kt) & 1) * G2_BUF); \
        _Pragma("unroll") for (int i = 0; i < 4; ++i) glds16_asm_s(abase + ko_, aoff[i], d_ + (unsigned)(i * 8192)); } while (0)
#define G2_BLOADH(kt, hh) do { const int so_ = (kt) * G_BK * (int)ldb * 4 + s_bo; const int l_ = tidx() & 63; \
        const int bo_ = (((l_ >> 2) & 3) + 4 * ((l_ >> 4) & 1)) * (16 * (int)ldb) + ((l_ & 3) + 4 * ((l_ >> 5) & 1)) * 16;        \
        _Pragma("unroll") for (int i = 0; i < 4; ++i) br[4 * (hh) + i] = __builtin_bit_cast(f32x4, __builtin_amdgcn_raw_buffer_load_b128((hh) ? rs1 : rs0, bo_, so_ + i * (int)ldb * 4, 0)); } while (0)
#define G2_PIECE(Bw_, sb_, sb1_, pc) do { u32x2 w_; \
        w_.x = cvtpk(br[4 * ((pc) >> 2) + 0][(pc) & 3], br[4 * ((pc) >> 2) + 1][(pc) & 3]); w_.y = cvtpk(br[4 * ((pc) >> 2) + 2][(pc) & 3], br[4 * ((pc) >> 2) + 3][(pc) & 3]); \
        *(u32x2*)(Bw_ + (((pc) & 1) ? sb1_ : sb_) + ((pc) >> 2) * (BF::HROW * 128) + (((pc) >> 1) & 1) * 128) = w_; } while (0)
#define G2_BSTORE(kt) do { char* Bw_ = lds + ((kt) & 1) * G2_BUF + G_ABYTES; const int sb_ = G2_SB(), sb1_ = G2_SB1(sb_); \
        _Pragma("unroll") for (int pc = 0; pc < 8; ++pc) G2_PIECE(Bw_, sb_, sb1_, pc); } while (0)
#define G2_COMPUTE(kt, ST, RL, ACT, DMA) do { char* Bw_ = lds + (((kt) + 1) & 1) * G2_BUF + G_ABYTES; const int sb_ = (ST) ? G2_SB() : 0, sb1_ = (ST) ? G2_SB1(sb_) : 0; \
        const char* A_ = lds + ((kt) & 1) * G2_BUF; const char* B_ = A_ + G_ABYTES; const int fa_base = (ACT) ? G2_FA() : 0, fb_base = (ACT) ? G2_FB() : 0; \
        bf16x8 a[4], bc; \
        if (ACT) { _Pragma("unroll") for (int m = 0; m < 4; ++m) a[m] = *(const bf16x8*)(A_ + fa_base + m * 2048); \
                   bc = *(const bf16x8*)(B_ + fb_base); } \
        if (DMA) G2_ADMA((kt) + 1);                                  \
        __builtin_amdgcn_sched_barrier(0); \
        _Pragma("unroll") for (int ks = 0; ks < 2; ++ks) { \
            _Pragma("unroll") for (int n = 0; n < 8; ++n) { \
                if (ACT) { const bf16x8 bn = bc; \
                    if (n < 7) bc = *(const bf16x8*)(B_ + fb_base + (n + 1) * 2048 + ks * 1024); \
                    else if (ks == 0) bc = *(const bf16x8*)(B_ + fb_base + 1024); \
                    __builtin_amdgcn_s_setprio(1); \
                    _Pragma("unroll") for (int m = 0; m < 4; ++m) { acc[m][n] = __builtin_amdgcn_mfma_f32_16x16x32_bf16(bn, a[m], acc[m][n], 0, 0, 0); \
                        if (ks == 0 && n == 7) { __builtin_amdgcn_sched_barrier(0); a[m] = *(const bf16x8*)(A_ + fa_base + m * 2048 + 1024); } }     \
                    __builtin_amdgcn_s_setprio(0); } \
                if ((ST) && (n & 1)) G2_PIECE(Bw_, sb_, sb1_, ks * 4 + (n >> 1)); \
                if ((RL) && n == 7) G2_BLOADH((kt) + 2, ks); \
                __builtin_amdgcn_sched_barrier(0); } } } while (0)
#define G2_LOOP(ACT) do { int kt = 0; \
    for (; kt + 2 < nk; ++kt) { G2_COMPUTE(kt, 1, 1, ACT, 1); asm volatile("s_waitcnt vmcnt(8)" ::: "memory"); __syncthreads(); } \
    if (kt + 1 < nk) { G2_COMPUTE(kt, 1, 0, ACT, 1); asm volatile("s_waitcnt vmcnt(0)" ::: "memory"); __syncthreads(); ++kt; } \
    G2_COMPUTE(kt, 0, 0, ACT, 0); \
    __syncthreads(); } while (0)
    bool have = un.first();
    if (have) { T2_SETUP(); G2_ADMA(0); G2_BLOADH(0, 0); G2_BLOADH(0, 1); }
#pragma unroll 1
    while (have) {
        const typename UN::EPT ep = un.ep;
        const bool act = __builtin_amdgcn_readfirstlane((int)((un.rowmask >> wr) & 1u)) != 0;
#pragma unroll
        for (int m = 0; m < 4; ++m)
#pragma unroll
            for (int n = 0; n < 8; ++n) acc[m][n] = (f32x4){0.f, 0.f, 0.f, 0.f};
        G2_BSTORE(0);
        __builtin_amdgcn_sched_barrier(0);
        if (nk > 1) { G2_BLOADH(1, 0); G2_BLOADH(1, 1); asm volatile("s_waitcnt vmcnt(8)" ::: "memory"); }
        else asm volatile("s_waitcnt vmcnt(0)" ::: "memory");
        __syncthreads();
        if (act) G2_LOOP(1); else G2_LOOP(0);
        have = un.next();
        if (have) { T2_SETUP(); G2_ADMA(0); G2_BLOADH(0, 0); G2_BLOADH(0, 1); }
        __builtin_amdgcn_sched_barrier(0);
        { const int l2_ = tidx() & 63; if (act) ep(acc, wr, wc, l2_ & 15, l2_ >> 4); }
    }
    __syncthreads();
#undef G2_LOOP
#undef T2_SETUP
#undef G2_BLOADH
#undef G2_PIECE
#undef G2_SB
#undef G2_SB1
#undef G2_FA
#undef G2_FB
#undef G2_ADMA
#undef G2_BSTORE
#undef G2_COMPUTE
}
struct ARows {
    const bf16_t* base; int lda; int row0; int mlim;
    __device__ __forceinline__ const bf16_t* a_row(int r) const { const int g = row0 + r; return g < mlim ? base + (size_t)g * lda : nullptr; }
    __device__ __forceinline__ unsigned a_off(int r) const { const int g = row0 + r; return g < mlim ? (unsigned)g * (unsigned)lda : 0u; }
    __device__ __forceinline__ const bf16_t* safe() const { return base; }
    __device__ __forceinline__ int koff(int k0) const { return k0; }
};
struct AGather {
    const bf16_t* base; int lda; const int* list; int r0; int cnt;
    __device__ __forceinline__ const bf16_t* a_row(int r) const { const int g = r0 + r; return g < cnt ? base + (size_t)list[g] * lda : nullptr; }
    __device__ __forceinline__ unsigned a_off(int r) const { const int g = r0 + r; return g < cnt ? (unsigned)list[g] * (unsigned)lda : 0u; }
    __device__ __forceinline__ const bf16_t* safe() const { return base; }
    __device__ __forceinline__ int koff(int k0) const { return k0; }
};
struct ACompress {
    const bf16_t* src; int col0; int row0; int kbase;
    __device__ __forceinline__ const bf16_t* a_row(int r) const {
        const int g = row0 + r; const int b = g >> 10, c = (g >> 2) & 255, gg = g & 3;
        if (c >= NC) return nullptr;
        return src + ((size_t)(b * SEQ + 16 * c)) * B_MAIN + col0 + gg * 128;
    }
    __device__ __forceinline__ const bf16_t* safe() const { return src; }
    __device__ __forceinline__ int koff(int k0) const { const int k = kbase + k0; return (k >> 7) * B_MAIN + (k & 127); }
};
struct BPlain {           static constexpr bool IS_BF16 = false;
    const float* base; size_t ldb; int n0; int nlim;
    __device__ __forceinline__ const float* colptr(int nl) const { const int c = n0 + nl; return c < nlim ? base + c : nullptr; }
    __device__ __forceinline__ const float* safe() const { return base; }
    __device__ __forceinline__ const bf16_t* bt16() const { return nullptr; }
};
struct BGateUp {          static constexpr bool IS_BF16 = false;
    const float* wg; long long du; size_t ldb; int c0;
    __device__ __forceinline__ const float* colptr(int nl) const {
        const int wc = nl >> 6, q = (nl >> 4) & 3, w = nl & 15; const int col = c0 + wc * 32 + (q & 1) * 16 + w;
        return wg + (long long)(q >> 1) * du + col;
    }
    __device__ __forceinline__ const float* safe() const { return wg; }
    __device__ __forceinline__ const bf16_t* bt16() const { return nullptr; }
};

struct BGateUp256 {
    static constexpr int HROW = 64;
    const float* wg; long long du; size_t ldb; int c0;
    __device__ __forceinline__ const float* base(int hh) const { return wg + (hh ? du : 0ll) + c0; }
    static __device__ __forceinline__ int wrow(int wq) { return (wq >> 1) * 128 + (wq & 1) * 32; }
};
struct BPlain256 {
    static constexpr int HROW = 128;
    const float* wbase; size_t ldb; int n0;
    __device__ __forceinline__ const float* base(int hh) const { return wbase + n0 + 128 * hh; }
    static __device__ __forceinline__ int wrow(int wq) { return wq * 32; }
};
struct EpSiluMul256 {
    bf16_t* out; int row0; int c0;
    __device__ __forceinline__ void operator()(const f32x4 (&acc)[4][8], int wr, int wc, int fr, int fq) const {
#pragma unroll
        for (int m = 0; m < 4; ++m) { const int r = row0 + wr * 64 + m * 16 + fr;
#pragma unroll
            for (int n = 0; n < 4; ++n) { const int c = c0 + wc * 64 + n * 16 + fq * 4; float hh[4];
#pragma unroll
                for (int j = 0; j < 4; ++j) { const float g = acc[m][n][j]; hh[j] = g / (1.f + __expf(-g)) * acc[m][n + 4][j]; }
                u32x2 w; w.x = cvtpk(hh[0], hh[1]); w.y = cvtpk(hh[2], hh[3]);
                *(u32x2*)(out + (size_t)r * D_EXPERT + c) = w; } }
    }
};
struct EpScaleRow256 {
    bf16_t* out; const float* roww; int rw0; int cnt; int row0; int col0;
    __device__ __forceinline__ void operator()(const f32x4 (&acc)[4][8], int wr, int wc, int fr, int fq) const {
#pragma unroll
        for (int m = 0; m < 4; ++m) { const int rl = wr * 64 + m * 16 + fr; const float s = (rw0 + rl < cnt) ? roww[rw0 + rl] : 0.f; const int r = row0 + rl;
#pragma unroll
            for (int n = 0; n < 8; ++n) { const int c = col0 + wc * 128 + n * 16 + fq * 4;
                u32x2 w; w.x = cvtpk(acc[m][n][0] * s, acc[m][n][1] * s); w.y = cvtpk(acc[m][n][2] * s, acc[m][n][3] * s);
                *(u32x2*)(out + (size_t)r * D_MODEL + c) = w; } }
    }
};
struct BBf16T {           static constexpr bool IS_BF16 = true;
    const bf16_t* base; size_t ldb; int n0;
    __device__ __forceinline__ const float* colptr(int) const { return nullptr; }
    __device__ __forceinline__ const float* safe() const { return nullptr; }
    __device__ __forceinline__ const bf16_t* bt16() const { return base + (size_t)n0 * ldb; }
};
struct EpBf16 {
    bf16_t* out; int ldc; int row0; int col0; int mlim; int nlim;
    __device__ __forceinline__ void operator()(const f32x4 (&acc)[4][4], int wr, int wc, int fr, int fq) const {
#pragma unroll
        for (int m = 0; m < 4; ++m) { const int r = row0 + wr * 64 + m * 16 + fr; if (r >= mlim) continue;
#pragma unroll
            for (int n = 0; n < 4; ++n) { const int c = col0 + wc * 64 + n * 16 + fq * 4; if (c >= nlim) continue;
                u32x2 w; w.x = cvtpk(acc[m][n][0], acc[m][n][1]); w.y = cvtpk(acc[m][n][2], acc[m][n][3]);
                *(u32x2*)(out + (size_t)r * ldc + c) = w; } }
    }
};
struct EpResF32 {
    float* out; const float* res; int ldc; int row0; int col0;
    __device__ __forceinline__ void operator()(const f32x4 (&acc)[4][4], int wr, int wc, int fr, int fq) const {
#pragma unroll
        for (int m = 0; m < 4; ++m) { const int r = row0 + wr * 64 + m * 16 + fr;
#pragma unroll
            for (int n = 0; n < 4; ++n) { const int c = col0 + wc * 64 + n * 16 + fq * 4;
                const f32x4 rv = *(const f32x4*)(res + (size_t)r * ldc + c);
                *(f32x4*)(out + (size_t)r * ldc + c) = rv + acc[m][n]; } }
    }
};
struct EpF32 {
    float* out; int ldc; int row0; int col0;
    __device__ __forceinline__ void operator()(const f32x4 (&acc)[4][4], int wr, int wc, int fr, int fq) const {
#pragma unroll
        for (int m = 0; m < 4; ++m) { const int r = row0 + wr * 64 + m * 16 + fr;
#pragma unroll
            for (int n = 0; n < 4; ++n) { const int c = col0 + wc * 64 + n * 16 + fq * 4; *(f32x4*)(out + (size_t)r * ldc + c) = acc[m][n]; } }
    }
};
struct EpProj {
    bf16_t* out; float* gate; int row0; int col0;
    __device__ __forceinline__ void operator()(const f32x4 (&acc)[4][4], int wr, int wc, int fr, int fq) const {
#pragma unroll
        for (int m = 0; m < 4; ++m) { const int r = row0 + wr * 64 + m * 16 + fr;
#pragma unroll
            for (int n = 0; n < 4; ++n) { const int c = col0 + wc * 64 + n * 16 + fq * 4;
                if (c < B_MAIN) { u32x2 w; w.x = cvtpk(acc[m][n][0], acc[m][n][1]); w.y = cvtpk(acc[m][n][2], acc[m][n][3]);
                    *(u32x2*)(out + (size_t)r * B_MAIN + c) = w; }
                else if (c < B_IN) { f32x4 g;
#pragma unroll
                    for (int j = 0; j < 4; ++j) g[j] = 1.f / (1.f + __expf(-acc[m][n][j]));
                    *(f32x4*)(gate + (size_t)r * 48 + (c - B_MAIN)) = g; } } }
    }
};
struct EpSiluMul {
    bf16_t* out; int row0; int c0;
    __device__ __forceinline__ void operator()(const f32x4 (&acc)[4][4], int wr, int wc, int fr, int fq) const {
#pragma unroll
        for (int m = 0; m < 4; ++m) { const int r = row0 + wr * 64 + m * 16 + fr;
#pragma unroll
            for (int n = 0; n < 2; ++n) { const int c = c0 + wc * 32 + n * 16 + fq * 4; float h[4];
#pragma unroll
                for (int j = 0; j < 4; ++j) { const float g = acc[m][n][j]; h[j] = g / (1.f + __expf(-g)) * acc[m][n + 2][j]; }
                u32x2 w; w.x = cvtpk(h[0], h[1]); w.y = cvtpk(h[2], h[3]);
                *(u32x2*)(out + (size_t)r * D_EXPERT + c) = w; } }
    }
};
struct EpScaleRow {
    bf16_t* out; const float* roww; int rw0; int cnt; int row0; int col0;
    __device__ __forceinline__ void operator()(const f32x4 (&acc)[4][4], int wr, int wc, int fr, int fq) const {
#pragma unroll
        for (int m = 0; m < 4; ++m) { const int rl = wr * 64 + m * 16 + fr; const float s = (rw0 + rl < cnt) ? roww[rw0 + rl] : 0.f; const int r = row0 + rl;
#pragma unroll
            for (int n = 0; n < 4; ++n) { const int c = col0 + wc * 64 + n * 16 + fq * 4;
                u32x2 w; w.x = cvtpk(acc[m][n][0] * s, acc[m][n][1] * s); w.y = cvtpk(acc[m][n][2] * s, acc[m][n][3] * s);
                *(u32x2*)(out + (size_t)r * D_MODEL + c) = w; } }
    }
};
__device__ __forceinline__ float gelu_tanh(float x) {
    const float u = 0.7978845608028654f * (x + 0.044715f * x * x * x);
    const float e = __expf(2.f * u); const float t = 1.f - 2.f / (e + 1.f);
    return 0.5f * x * (1.f + t);
}
struct EpGeluBias {
    bf16_t* out; const float* bias; int row0; int col0;
    __device__ __forceinline__ void operator()(const f32x4 (&acc)[4][4], int wr, int wc, int fr, int fq) const {
#pragma unroll
        for (int m = 0; m < 4; ++m) { const int r = row0 + wr * 64 + m * 16 + fr;
#pragma unroll
            for (int n = 0; n < 4; ++n) { const int c = col0 + wc * 64 + n * 16 + fq * 4; const f32x4 bv = *(const f32x4*)(bias + c); float h[4];
#pragma unroll
                for (int j = 0; j < 4; ++j) h[j] = gelu_tanh(acc[m][n][j] + bv[j]);
                u32x2 w; w.x = cvtpk(h[0], h[1]); w.y = cvtpk(h[2], h[3]);
                *(u32x2*)(out + (size_t)r * 256 + c) = w; } }
    }
};

__device__ __forceinline__ void stage_rc(int b, int& R, int& C) { const int st = b / 1024, sb = b % 1024, swz = sb ^ (((sb >> 9) & 1) << 5); R = (st >> 1) * 16 + swz / 64; C = (st & 1) * 32 + (swz % 64) / 2; }
#define G8_HT 16384
template <bool GATHER, class EP>
__device__ __forceinline__ void gemm8_unit(const bf16_t* __restrict__ A, const unsigned (&ao)[2][2], const int lda, const bf16_t* __restrict__ Bt, const unsigned (&bo2)[2], const int K, char* lds, const EP& ep, const bool hi_act) {
    const int tid = tidx(), wid = tid >> 6, lane = tid & 63, wr = wid >> 2, wc = wid & 3, fr = lane & 15, fq = lane >> 4;
#define SA(b, h) (((b) * 2 + (h)) * G8_HT)
#define SB(b, h) ((4 + (b) * 2 + (h)) * G8_HT)
#define STG(P, BASE, OFF, kt) do { const bf16_t* g_ = (BASE) + (kt) * 64; \
        __builtin_amdgcn_global_load_lds((const unsigned*)(g_ + (OFF)[0]), (unsigned*)(lds + (P) + tid * 16), 16, 0, 0); \
        __builtin_amdgcn_global_load_lds((const unsigned*)(g_ + (OFF)[1]), (unsigned*)(lds + (P) + 8192 + tid * 16), 16, 0, 0); } while (0)
#define LDA(dst, b, h) _Pragma("unroll") for (int m = 0; m < 4; ++m) _Pragma("unroll") for (int k = 0; k < 2; ++k) \
        dst[m][k] = *reinterpret_cast<const bf16x8*>(lds + SA(b, h) + fa_base + m * 2048 + k * 1024)
#define LDB(dst, b, h) _Pragma("unroll") for (int n = 0; n < 2; ++n) _Pragma("unroll") for (int k = 0; k < 2; ++k) \
        dst[n][k] = *reinterpret_cast<const bf16x8*>(lds + SB(b, h) + fb_base + n * 2048 + k * 1024)
#define MMA(ai, bj, At_, Bt_) do { __builtin_amdgcn_s_setprio(1); \
        _Pragma("unroll") for (int m = 0; m < 4; ++m) _Pragma("unroll") for (int n = 0; n < 2; ++n) _Pragma("unroll") for (int k = 0; k < 2; ++k) \
            acc[ai][bj][m][n] = __builtin_amdgcn_mfma_f32_16x16x32_bf16(Bt_[n][k], At_[m][k], acc[ai][bj][m][n], 0, 0, 0); \
        __builtin_amdgcn_s_setprio(0); } while (0)
#define MMAH(bj, At_, Bt_) do { if (hi_act) MMA(1, bj, At_, Bt_); } while (0)
#define WAIT_V(n) asm volatile("s_waitcnt vmcnt(" #n ")" ::: "memory")
#define WAIT_L(n) asm volatile("s_waitcnt lgkmcnt(" #n ")" ::: "memory")
#define BAR __builtin_amdgcn_s_barrier()
#define SCHED __builtin_amdgcn_sched_barrier(0)
    const int fa_base = lds_byte(wr * 64 + fr, fq * 8), fb_base = lds_byte(wc * 32 + fr, fq * 8);
    f32x4 acc[2][2][4][2];
#pragma unroll
    for (int a = 0; a < 2; ++a)
#pragma unroll
        for (int b = 0; b < 2; ++b)
#pragma unroll
            for (int m = 0; m < 4; ++m)
#pragma unroll
                for (int n = 0; n < 2; ++n) acc[a][b][m][n] = (f32x4){0.f, 0.f, 0.f, 0.f};
    bf16x8 At[4][2], B0[2][2], B1[2][2];
    const int nt = K / 64;
    const bf16_t* Bt1 = Bt + (size_t)128 * K;
    const bf16_t* A1 = GATHER ? A : A + (size_t)128 * lda;
#define AO1 ao[GATHER ? 1 : 0]
    STG(SB(0, 0), Bt, bo2, 0); STG(SA(0, 0), A, ao[0], 0);
    STG(SB(0, 1), Bt1, bo2, 0); STG(SA(0, 1), A1, AO1, 0);
    if (wr == 1) BAR;
    WAIT_V(4); BAR;
    STG(SB(1, 0), Bt, bo2, 1); STG(SA(1, 0), A, ao[0], 1); STG(SB(1, 1), Bt1, bo2, 1);
    WAIT_V(6); BAR;
    for (int t = 0; t < nt - 2; t += 2) {
        LDB(B0, 0, 0); SCHED; LDA(At, 0, 0); STG(SA(1, 1), A1, AO1, t + 1);
        WAIT_L(8); BAR; WAIT_L(0); MMA(0, 0, At, B0); BAR; SCHED;
        LDB(B1, 0, 1); STG(SB(0, 0), Bt, bo2, t + 2);
        BAR; WAIT_L(0); MMA(0, 1, At, B1); BAR;
        LDA(At, 0, 1); STG(SA(0, 0), A, ao[0], t + 2);
        BAR; WAIT_L(0); MMAH(0, At, B0); BAR; SCHED;
        STG(SB(0, 1), Bt1, bo2, t + 2);
        WAIT_V(6); BAR; MMAH(1, At, B1); BAR;
        LDB(B0, 1, 0); SCHED; LDA(At, 1, 0); STG(SA(0, 1), A1, AO1, t + 2);
        WAIT_L(8); BAR; WAIT_L(0); MMA(0, 0, At, B0); BAR; SCHED;
        LDB(B1, 1, 1); STG(SB(1, 0), Bt, bo2, t + 3);
        BAR; WAIT_L(0); MMA(0, 1, At, B1); BAR;
        LDA(At, 1, 1); STG(SA(1, 0), A, ao[0], t + 3);
        BAR; WAIT_L(0); MMAH(0, At, B0); BAR; SCHED;
        STG(SB(1, 1), Bt1, bo2, t + 3);
        WAIT_V(6); BAR; MMAH(1, At, B1); BAR;
    }
    { LDB(B0, 0, 0); WAIT_V(0); LDA(At, 0, 0); STG(SA(1, 1), A1, AO1, nt - 1);
      BAR; WAIT_L(0); MMA(0, 0, At, B0); BAR;
      LDB(B1, 0, 1); BAR; WAIT_L(0); MMA(0, 1, At, B1); BAR;
      LDA(At, 0, 1); WAIT_V(4); BAR; WAIT_L(0); MMAH(0, At, B0); MMAH(1, At, B1); BAR; }
    { LDB(B0, 1, 0); LDA(At, 1, 0); WAIT_V(2); BAR; WAIT_L(0); MMA(0, 0, At, B0); BAR;
      LDB(B1, 1, 1); WAIT_V(0); BAR; WAIT_L(0); MMA(0, 1, At, B1); BAR;
      LDA(At, 1, 1); BAR; WAIT_L(0); MMAH(0, At, B0); MMAH(1, At, B1); BAR; }
    if (wr == 0) BAR;
    ep(acc, wr, wc, fr, fq);
    __syncthreads();
#undef SA
#undef AO1
#undef SB
#undef STG
#undef LDA
#undef LDB
#undef MMA
#undef MMAH
#undef WAIT_V
#undef WAIT_L
#undef BAR
#undef SCHED
}
__device__ __forceinline__ void g8_offsets2(unsigned (&o)[2], int row0, int ld) {
    const int tid = tidx();
#pragma unroll
    for (int i = 0; i < 2; ++i) { int R, C; stage_rc(tid * 16 + i * 8192, R, C); o[i] = (unsigned)((row0 + R) * ld + C); }
}
__device__ __forceinline__ void g8_offsets2_perm(unsigned (&o)[2], int row0, int ld) {
    const int tid = tidx();
#pragma unroll
    for (int i = 0; i < 2; ++i) { int R, C; stage_rc(tid * 16 + i * 8192, R, C); const int rho = R & 31, nn = rho >> 4, ii = rho & 15;
        const int Rp = (R & ~31) + 8 * (ii >> 2) + 4 * nn + (ii & 3); o[i] = (unsigned)((row0 + Rp) * ld + C); }
}
__device__ __forceinline__ void g8_offsets(unsigned (&o)[2][2], int row0, int ld) {
    const int tid = tidx();
#pragma unroll
    for (int i = 0; i < 2; ++i) { int R, C; stage_rc(tid * 16 + i * 8192, R, C);
#pragma unroll
        for (int h = 0; h < 2; ++h) o[h][i] = (unsigned)((row0 + h * 128 + R) * ld + C); }
}
__device__ __forceinline__ int wgid_v(char* lds) {
#if N_LAUNCH_MODE == 1
    return __builtin_amdgcn_readfirstlane((int)((volatile LAS unsigned*)(lds + LDS_BYTES - 16))[2]);
#else
    (void)lds; return (int)blockIdx.x;
#endif
}
__device__ __forceinline__ void g8_order_c(int L, int nM, int nN, int& pm, int& pn) {
    const int nig = 8 * nN, gid = L / nig, fm = gid * 8, gsz = (nM - fm) < 8 ? (nM - fm) : 8;
    pm = fm + ((L % nig) % gsz); pn = (L % nig) / gsz;
}
__device__ __forceinline__ void g8_order(int L, int nM, int nN, int& pm, int& pn) {
    const int nwg = nM * nN; int wgid = L; { const int q = nwg / 8, r = nwg % 8, xcd = wgid % 8, off = wgid / 8; wgid = (xcd < r ? xcd * (q + 1) : r * (q + 1) + (xcd - r) * q) + off; }
    const int nig = 8 * nN, gid = wgid / nig, fm = gid * 8, gsz = (nM - fm) < 8 ? (nM - fm) : 8;
    pm = fm + ((wgid % nig) % gsz); pn = (wgid % nig) / gsz;
}
struct E8Bf16 {
    bf16_t* out; int ldc; int row0; int col0; int nlim;
    __device__ __forceinline__ void operator()(const f32x4 (&acc)[2][2][4][2], int wr, int wc, int fr, int fq) const {
#pragma unroll
        for (int ai = 0; ai < 2; ++ai)
#pragma unroll
            for (int m = 0; m < 4; ++m) { const int r = row0 + ai * 128 + wr * 64 + m * 16 + fr;
#pragma unroll
                for (int bj = 0; bj < 2; ++bj) { const int c = col0 + bj * 128 + wc * 32 + 8 * fq; if (c >= nlim) continue;
                    const f32x4 v0 = acc[ai][bj][m][0], v1 = acc[ai][bj][m][1];
                    u32x4 w; w.x = cvtpk(v0[0], v0[1]); w.y = cvtpk(v0[2], v0[3]); w.z = cvtpk(v1[0], v1[1]); w.w = cvtpk(v1[2], v1[3]);
                    *(u32x4*)(out + (size_t)r * ldc + c) = w; } }
    }
};
template <bool RB>
struct E8ResBf16 {
    bf16_t* out; const void* res; int row0; int col0;
    __device__ __forceinline__ void operator()(const f32x4 (&acc)[2][2][4][2], int wr, int wc, int fr, int fq) const {
#pragma unroll
        for (int ai = 0; ai < 2; ++ai)
#pragma unroll
            for (int m = 0; m < 4; ++m) { const int r = row0 + ai * 128 + wr * 64 + m * 16 + fr;
#pragma unroll
                for (int bj = 0; bj < 2; ++bj) { const int c = col0 + bj * 128 + wc * 32 + 8 * fq;
                    f32x4 r0, r1;
                    if (RB) { const u32x4 rw = *(const u32x4*)((const bf16_t*)res + (size_t)r * D_MODEL + c);
                        r0[0] = __uint_as_float(rw.x << 16); r0[1] = __uint_as_float(rw.x & 0xffff0000u); r0[2] = __uint_as_float(rw.y << 16); r0[3] = __uint_as_float(rw.y & 0xffff0000u);
                        r1[0] = __uint_as_float(rw.z << 16); r1[1] = __uint_as_float(rw.z & 0xffff0000u); r1[2] = __uint_as_float(rw.w << 16); r1[3] = __uint_as_float(rw.w & 0xffff0000u); }
                    else { r0 = *(const f32x4*)((const float*)res + (size_t)r * D_MODEL + c); r1 = *(const f32x4*)((const float*)res + (size_t)r * D_MODEL + c + 4); }
                    const f32x4 v0 = r0 + acc[ai][bj][m][0], v1 = r1 + acc[ai][bj][m][1];
                    u32x4 w; w.x = cvtpk(v0[0], v0[1]); w.y = cvtpk(v0[2], v0[3]); w.z = cvtpk(v1[0], v1[1]); w.w = cvtpk(v1[2], v1[3]);
                    *(u32x4*)(out + (size_t)r * D_MODEL + c) = w; } }
    }
};
struct E8Proj {
    bf16_t* out; float* gate; int row0; int col0;
    __device__ __forceinline__ void operator()(const f32x4 (&acc)[2][2][4][2], int wr, int wc, int fr, int fq) const {
#pragma unroll
        for (int ai = 0; ai < 2; ++ai)
#pragma unroll
            for (int m = 0; m < 4; ++m) { const int r = row0 + ai * 128 + wr * 64 + m * 16 + fr;
#pragma unroll
                for (int bj = 0; bj < 2; ++bj) { const int c = col0 + bj * 128 + wc * 32 + 8 * fq; const f32x4 v0 = acc[ai][bj][m][0], v1 = acc[ai][bj][m][1];
                    if (c < B_MAIN) { u32x4 w; w.x = cvtpk(v0[0], v0[1]); w.y = cvtpk(v0[2], v0[3]); w.z = cvtpk(v1[0], v1[1]); w.w = cvtpk(v1[2], v1[3]);
                        *(u32x4*)(out + (size_t)r * B_MAIN + c) = w; }
                    else if (c < B_IN) { f32x4 g0, g1;
#pragma unroll
                        for (int j = 0; j < 4; ++j) { g0[j] = 1.f / (1.f + __expf(-v0[j])); g1[j] = 1.f / (1.f + __expf(-v1[j])); }
                        *(f32x4*)(gate + (size_t)r * 48 + (c - B_MAIN)) = g0; *(f32x4*)(gate + (size_t)r * 48 + (c - B_MAIN) + 4) = g1; } } }
    }
};
template <int MODE>
__device__ __forceinline__ void convert_weight(const float* __restrict__ src, const int K, const int N, bf16_t* __restrict__ dst, int& job, const int stride, char* lds) {
    (void)lds;
    const int tid = tidx(), kb = (tid >> 2) & 7, nb = (tid & 3) + 4 * (tid >> 5); const int nK = K / 64, nN = (N + 255) / 256; const int njobs = nK * nN;
    for (; job < njobs;) {
        const int j1 = job + stride; const bool two = j1 < njobs;
        const int kt0 = job % nK, nt0 = job / nK, kt1 = two ? j1 % nK : kt0, nt1 = two ? j1 / nK : nt0;
        f32x4 v[2][8];
#pragma unroll
        for (int jj = 0; jj < 2; ++jj) { const int kt = jj ? kt1 : kt0, ntl = jj ? nt1 : nt0;
            const int n = ntl * 256 + nb * 4; const float* s = src + (size_t)(kt * 64 + 8 * kb) * N + n;
#pragma unroll
            for (int i = 0; i < 8; ++i) v[jj][i] = n < N ? *(const f32x4*)(s + (size_t)i * N) : (f32x4){0.f, 0.f, 0.f, 0.f}; }
#pragma unroll
        for (int jj = 0; jj < 2; ++jj) { if (jj == 1 && !two) break;
            const int kt = jj ? kt1 : kt0, ntl = jj ? nt1 : nt0; const int n = ntl * 256 + nb * 4;
#pragma unroll
            for (int j = 0; j < 4; ++j) { const int ng = n + j;
                const int drow = MODE == 0 ? ng : ((ng >> 7) * 256 + (ng & 127) + (MODE == 2 ? 128 : 0));
                u32x4 w; w.x = cvtpk(v[jj][0][j], v[jj][1][j]); w.y = cvtpk(v[jj][2][j], v[jj][3][j]); w.z = cvtpk(v[jj][4][j], v[jj][5][j]); w.w = cvtpk(v[jj][6][j], v[jj][7][j]);
                *(u32x4*)(dst + (size_t)drow * K + kt * 64 + 8 * kb) = w; } }
        job += two ? 2 * stride : stride;
    }
    job -= njobs;
}
struct E8SiluMul {
    bf16_t* out; int row0; int c0;
    __device__ __forceinline__ void operator()(const f32x4 (&acc)[2][2][4][2], int wr, int wc, int fr, int fq) const {
#pragma unroll
        for (int ai = 0; ai < 2; ++ai)
#pragma unroll
            for (int m = 0; m < 4; ++m) { const int r = row0 + ai * 128 + wr * 64 + m * 16 + fr;
#pragma unroll
                for (int n = 0; n < 2; ++n) { const int c = c0 + wc * 32 + n * 16 + fq * 4; float h[4];
#pragma unroll
                    for (int j = 0; j < 4; ++j) { const float g = acc[ai][0][m][n][j]; h[j] = g / (1.f + __expf(-g)) * acc[ai][1][m][n][j]; }
                    u32x2 w; w.x = cvtpk(h[0], h[1]); w.y = cvtpk(h[2], h[3]);
                    *(u32x2*)(out + (size_t)r * D_EXPERT + c) = w; } }
    }
};
struct E8ScaleRow {
    bf16_t* out; const float* roww; int rw0; int cnt; int row0; int col0;
    __device__ __forceinline__ void operator()(const f32x4 (&acc)[2][2][4][2], int wr, int wc, int fr, int fq) const {
#pragma unroll
        for (int ai = 0; ai < 2; ++ai)
#pragma unroll
            for (int m = 0; m < 4; ++m) { const int rl = ai * 128 + wr * 64 + m * 16 + fr; const float s = (rw0 + rl < cnt) ? roww[rw0 + rl] : 0.f; const int r = row0 + rl;
#pragma unroll
                for (int bj = 0; bj < 2; ++bj)
#pragma unroll
                    for (int n = 0; n < 2; ++n) { const int c = col0 + bj * 128 + wc * 32 + n * 16 + fq * 4; const f32x4 v = acc[ai][bj][m][n];
                        u32x2 w; w.x = cvtpk(v[0] * s, v[1] * s); w.y = cvtpk(v[2] * s, v[3] * s);
                        *(u32x2*)(out + (size_t)r * D_MODEL + c) = w; } }
    }
};

template <int WHICH>
__device__ __forceinline__ void moe_convert(CParams& p, const int le0, const int le1, char* lds, int job = -1, int stride = 0) {
    if (job < 0) { job = blockIdx.x; stride = gridDim.x; }
#pragma unroll 1
    for (int le = le0; le < le1; ++le) {
        if (WHICH & 1) {
            convert_weight<1>(p.moe_w_gate + (size_t)le * D_MODEL * D_EXPERT, D_MODEL, D_EXPERT, p.wgu_t + (size_t)le * 2048 * 2048, job, stride, lds);
            convert_weight<2>(p.moe_w_up + (size_t)le * D_MODEL * D_EXPERT, D_MODEL, D_EXPERT, p.wgu_t + (size_t)le * 2048 * 2048, job, stride, lds); }
        if (WHICH & 2)
            convert_weight<0>(p.moe_w_down + (size_t)le * D_EXPERT * D_MODEL, D_EXPERT, D_MODEL, p.wd_t + (size_t)le * 2048 * 1024, job, stride, lds);
    }
    __syncthreads();
}
#define KSWZ(row, colB) ((row) * 256 + ((colB) ^ (((row) & 7) << 4)))
#define SBAR() __builtin_amdgcn_sched_barrier(0)
#define TILE_B 16384
__device__ __forceinline__ int v_rd_base(int lane) { return ((lane & 3) << 3) | (((lane >> 2) & 3) << 6) | (((lane >> 4) & 1) << 5) | (((lane >> 5) & 1) << 8); }
constexpr int v_rd_off(int d0, int ks, int half) { return d0 * 512 + ks * 4096 + half * 2048; }
__device__ __forceinline__ int crow(int r, int hi) { return (r & 3) + 8 * (r >> 2) + 4 * hi; }

__device__ __forceinline__ unsigned fill_koff(int tid, int ld) { const int row = tid >> 4, cp = tid & 15; return (unsigned)(row * ld + ((cp ^ (row & 7)) << 3)); }
__device__ __forceinline__ unsigned fill_voff(int tid, int ld) { const int L = tid; const int kk = ((L >> 7) << 3) | ((L >> 2) & 7), c = (((L >> 5) & 3) << 5) | ((L & 3) << 3);
    const int k = (kk & ~0xC) | ((kk & 4) << 1) | ((kk & 8) >> 1); return (unsigned)(k * ld + c); }
__device__ __forceinline__ void fill_tile(const bf16_t* src, unsigned off, int ld, char* dst, int tid) {
    __builtin_amdgcn_global_load_lds((const unsigned*)(src + off), (unsigned*)(dst + tid * 16), 16, 0, 0);
    __builtin_amdgcn_global_load_lds((const unsigned*)(src + 32 * ld + off), (unsigned*)(dst + 8192 + tid * 16), 16, 0, 0);
}
__device__ __forceinline__ void qkt(f32x16& p0, f32x16& p1, const char* Kt, int r32, int hi, const bf16x8* qr) {
    p0 = f32x16{}; p1 = f32x16{};
    const char* kb[4];
#pragma unroll
    for (int dd = 0; dd < 4; ++dd) kb[dd] = Kt + KSWZ(r32, (dd * 16 + hi * 8) * 2);
    __builtin_amdgcn_s_setprio(1);
#pragma unroll
    for (int d0 = 0; d0 < 8; ++d0) { const char* a = kb[d0 & 3] + (d0 >> 2) * 128;
        bf16x8 b0 = *reinterpret_cast<const bf16x8*>(a);
        bf16x8 b1 = *reinterpret_cast<const bf16x8*>(a + 32 * 256);
        p0 = __builtin_amdgcn_mfma_f32_32x32x16_bf16(b0, qr[d0], p0, 0, 0, 0);
        p1 = __builtin_amdgcn_mfma_f32_32x32x16_bf16(b1, qr[d0], p1, 0, 0, 0); }
    __builtin_amdgcn_s_setprio(0);
}
__device__ __forceinline__ void qkt_lds(f32x16& p0, f32x16& p1, const char* Kt, int r32, int hi, const char* qb) {
    p0 = f32x16{}; p1 = f32x16{};
    const char* kb[4];
#pragma unroll
    for (int dd = 0; dd < 4; ++dd) kb[dd] = Kt + KSWZ(r32, (dd * 16 + hi * 8) * 2);
#pragma unroll
    for (int d0 = 0; d0 < 8; ++d0) { const char* a = kb[d0 & 3] + (d0 >> 2) * 128;
        bf16x8 b0 = *reinterpret_cast<const bf16x8*>(a);
        bf16x8 b1 = *reinterpret_cast<const bf16x8*>(a + 32 * 256);
        bf16x8 q = *reinterpret_cast<const bf16x8*>(qb + d0 * 1024);
        p0 = __builtin_amdgcn_mfma_f32_32x32x16_bf16(b0, q, p0, 0, 0, 0);
        p1 = __builtin_amdgcn_mfma_f32_32x32x16_bf16(b1, q, p1, 0, 0, 0); }
}
__device__ __forceinline__ void pv_tile(f32x16* o, int vb0, bf16x8 pa0, bf16x8 pa1, bf16x8 pa2, bf16x8 pa3) {
#define TRRD(dst, off) asm volatile("ds_read_b64_tr_b16 %0, %1 offset:%2" : "=&v"(dst) : "v"(vb0), "i"(off) : "memory")
#define PV_D0(d0) do { s16x4 l0, l1, l2, l3, h0, h1, h2, h3; constexpr int b_ = v_rd_off(d0, 0, 0); \
        TRRD(l0, b_); TRRD(h0, b_ + 2048); TRRD(l1, b_ + 4096); TRRD(h1, b_ + 6144); TRRD(l2, b_ + 8192); TRRD(h2, b_ + 10240); TRRD(l3, b_ + 12288); TRRD(h3, b_ + 14336); \
        asm volatile("s_waitcnt lgkmcnt(0)" ::: "memory"); SBAR(); \
        o[d0] = __builtin_amdgcn_mfma_f32_32x32x16_bf16(pa0, (bf16x8){l0[0], l0[1], l0[2], l0[3], h0[0], h0[1], h0[2], h0[3]}, o[d0], 0, 0, 0); \
        o[d0] = __builtin_amdgcn_mfma_f32_32x32x16_bf16(pa1, (bf16x8){l1[0], l1[1], l1[2], l1[3], h1[0], h1[1], h1[2], h1[3]}, o[d0], 0, 0, 0); \
        o[d0] = __builtin_amdgcn_mfma_f32_32x32x16_bf16(pa2, (bf16x8){l2[0], l2[1], l2[2], l2[3], h2[0], h2[1], h2[2], h2[3]}, o[d0], 0, 0, 0); \
        o[d0] = __builtin_amdgcn_mfma_f32_32x32x16_bf16(pa3, (bf16x8){l3[0], l3[1], l3[2], l3[3], h3[0], h3[1], h3[2], h3[3]}, o[d0], 0, 0, 0); } while (0)
    __builtin_amdgcn_s_setprio(1);
    PV_D0(0); PV_D0(1); PV_D0(2); PV_D0(3);
    __builtin_amdgcn_s_setprio(0);
#undef PV_D0
#undef TRRD
}
__device__ __forceinline__ float half_max(float v) { auto rr = __builtin_amdgcn_permlane32_swap(__float_as_uint(v), __float_as_uint(v), false, false); return fmaxf(__uint_as_float(rr[0]), __uint_as_float(rr[1])); }
__device__ __forceinline__ float half_sum(float v) { auto rr = __builtin_amdgcn_permlane32_swap(__float_as_uint(v), __float_as_uint(v), false, false); return __uint_as_float(rr[0]) + __uint_as_float(rr[1]); }
__device__ __forceinline__ void pack_p(const f32x16& p0, const f32x16& p1, bf16x8& pa0, bf16x8& pa1, bf16x8& pa2, bf16x8& pa3) {
#define PK4(P, B_, OUT) do { unsigned a0 = cvtpk(P[B_+0], P[B_+1]), a1 = cvtpk(P[B_+2], P[B_+3]);                          \
        unsigned b0 = cvtpk(P[B_+4], P[B_+5]), b1 = cvtpk(P[B_+6], P[B_+7]);                                             \
        auto r0 = __builtin_amdgcn_permlane32_swap(a0, b0, false, false); auto r1 = __builtin_amdgcn_permlane32_swap(a1, b1, false, false); \
        u32x4 w = {r0[0], r1[0], r0[1], r1[1]}; OUT = *reinterpret_cast<bf16x8*>(&w); } while (0)
    PK4(p0, 0, pa0); PK4(p0, 8, pa1); PK4(p1, 0, pa2); PK4(p1, 8, pa3);
#undef PK4
}
__device__ __forceinline__ float online_sm(f32x16& p0, f32x16& p1, float& m_reg, float& l_reg) {
    float pmax = p0[0];
#pragma unroll
    for (int r = 1; r < 16; ++r) pmax = fmaxf(pmax, p0[r]);
#pragma unroll
    for (int r = 0; r < 16; ++r) pmax = fmaxf(pmax, p1[r]);
    pmax = half_max(pmax);
    float mn, alpha;
    if (__all(pmax - m_reg <= 8.f)) { mn = m_reg; alpha = 1.f; }
    else { mn = fmaxf(m_reg, pmax); alpha = __builtin_amdgcn_exp2f(m_reg - mn); m_reg = mn; }
    float ps = 0.f;
#pragma unroll
    for (int r = 0; r < 16; ++r) { p0[r] = __builtin_amdgcn_exp2f(p0[r] - mn); ps += p0[r]; }
#pragma unroll
    for (int r = 0; r < 16; ++r) { p1[r] = __builtin_amdgcn_exp2f(p1[r] - mn); ps += p1[r]; }
    ps = half_sum(ps);
    l_reg = l_reg * alpha + ps;
    return alpha;
}
#define ROWX(scr, val, out16) do { if (hi == 0) (scr)[r32] = (val); asm volatile("s_waitcnt lgkmcnt(0)" ::: "memory"); \
        _Pragma("unroll") for (int r_ = 0; r_ < 16; ++r_) (out16)[r_] = (scr)[crow(r_, hi)]; asm volatile("s_waitcnt lgkmcnt(0)" ::: "memory"); } while (0)

__device__ __forceinline__ void diff_attn_unit(CParams& p, const int b, const int h, const int qb, char* lds, const float lam, const float one_m_li) {
    const int tid = tidx(), wid = __builtin_amdgcn_readfirstlane(tid >> 6), lane = tid & 63, r32 = lane & 31, hi = lane >> 5;
    const int rg = wid & 3, comp = wid >> 2;
    const int P0 = qb * 128, qlo = P0 + rg * 32, qpos = qlo + r32;
    const bf16_t* base = p.qkv + (size_t)b * SEQ * A_IN;
    const bf16_t* Kc0 = base + 2048 + (h * 2 + 0) * 128;
    const bf16_t* Vb = base + 4096 + h * 256;
    bf16x8 qr[8];
    { const bf16_t* qp = base + (size_t)qpos * A_IN + (h * 2 + comp) * 128 + hi * 8;
#pragma unroll
        for (int d0 = 0; d0 < 8; ++d0) qr[d0] = *(const bf16x8*)(qp + d0 * 16); }
    const int NT = 2 * qb + 2;
    const float slope = exp2f(-(float)(h + 1));
    const float C2 = 1.4426950408889634f * 0.08838834764831845f, sl2 = 1.4426950408889634f * slope;
    float m_reg = -1e30f, l_reg = 0.f; f32x16 o[8];
#pragma unroll
    for (int d = 0; d < 8; ++d) o[d] = f32x16{};
    const unsigned ko = fill_koff(tid, A_IN), vo = fill_voff(tid, A_IN);
#define DA_FILLK(t, bf) do { const size_t ro_ = (size_t)(t) * 64 * A_IN; char* B_ = lds + (bf) * 4 * TILE_B; \
        fill_tile(Kc0 + ro_, ko, A_IN, B_, tid); fill_tile(Kc0 + ro_ + 128, ko, A_IN, B_ + TILE_B, tid); } while (0)
#define DA_FILLV(t, bf) do { const size_t ro_ = (size_t)(t) * 64 * A_IN; char* B_ = lds + (bf) * 4 * TILE_B; \
        fill_tile(Vb + ro_, vo, A_IN, B_ + 2 * TILE_B, tid); fill_tile(Vb + ro_ + 128, vo, A_IN, B_ + 3 * TILE_B, tid); } while (0)
    DA_FILLK(0, 0); DA_FILLV(0, 0);
    __syncthreads();
    if (comp == 1) __syncthreads();
    for (int t = 0; t < NT; ++t) {
        const int bf = t & 1;
        const int kb = t * 64;
        const bool active = kb <= qlo + 31;
        bf16x8 pa0, pa1, pa2, pa3;
        if (t + 1 < NT) DA_FILLK(t + 1, bf ^ 1);
        if (active) {
            float* scr = (float*)(lds + 8 * TILE_B) + wid * 32;
            f32x16 p0, p1;
            qkt(p0, p1, lds + bf * 4 * TILE_B + comp * TILE_B, r32, hi, qr);
            float sl = sl2; asm volatile("" : "+v"(sl));
            const float bb = sl * (float)(kb - P0 + 4 * hi);
#pragma unroll
            for (int r = 0; r < 16; ++r) { const int c = (r & 3) + 8 * (r >> 2);
                p0[r] = fmaf(p0[r], C2, fmaf(sl, (float)c, bb)); p1[r] = fmaf(p1[r], C2, fmaf(sl, (float)(c + 32), bb)); }
            if (kb + 63 > qlo) {
                const int dq = qpos - kb - 4 * hi;
#pragma unroll
                for (int r = 0; r < 16; ++r) { const int c = (r & 3) + 8 * (r >> 2);
                    if (c > dq) p0[r] = -__builtin_inff();
                    if (c + 32 > dq) p1[r] = -__builtin_inff(); }
            }
            const float alpha = online_sm(p0, p1, m_reg, l_reg);
            if (__any(alpha < 1.f)) { float al[16]; ROWX(scr, alpha, al);
#pragma unroll
                for (int d = 0; d < 8; ++d)
#pragma unroll
                    for (int r = 0; r < 16; ++r) o[d][r] *= al[r]; }
            pack_p(p0, p1, pa0, pa1, pa2, pa3);
        }
        __syncthreads();
        if (t + 1 < NT) DA_FILLV(t + 1, bf ^ 1);
        if (active) {
            const int vb_lane = (int)(uintptr_t)lds + v_rd_base(lane) + bf * 4 * TILE_B;
            pv_tile(o, vb_lane + 2 * TILE_B, pa0, pa1, pa2, pa3);
            pv_tile(o + 4, vb_lane + 3 * TILE_B, pa0, pa1, pa2, pa3);
        }
        __syncthreads();
    }
    if (comp == 0) __syncthreads();
#undef DA_FILLK
#undef DA_FILLV
    int tz = tidx(); asm volatile("" : "+v"(tz));
    const int lane2 = tz & 63, r2 = lane2 & 31, h2 = lane2 >> 5, wid2 = tz >> 6, rg2 = wid2 & 3, comp2 = wid2 >> 2;
    { float il[16];
      { float* scr = (float*)(lds + 8 * TILE_B) + wid2 * 32; const int r32 = r2, hi = h2; ROWX(scr, 1.f / l_reg, il); }
#pragma unroll
      for (int d = 0; d < 8; ++d)
#pragma unroll
          for (int r = 0; r < 16; ++r) o[d][r] *= il[r]; }
    float* xch = (float*)lds + rg2 * 8192;
    if (comp2 == 1) {
#pragma unroll
        for (int d = 0; d < 8; ++d)
#pragma unroll
            for (int r = 0; r < 16; ++r) xch[(d * 16 + r) * 64 + lane2] = o[d][r];
    }
    __syncthreads();
    if (comp2 == 0) {
        float ssq[16];
#pragma unroll
        for (int r = 0; r < 16; ++r) ssq[r] = 0.f;
#pragma unroll
        for (int d = 0; d < 8; ++d) {
#pragma unroll
            for (int r = 0; r < 16; ++r) { float* q = xch + (d * 16 + r) * 64 + lane2; const float v = o[d][r] - lam * *q; *q = v; ssq[r] = fmaf(v, v, ssq[r]); }
            SBAR(); }
        float* rsc = (float*)(lds + 8 * TILE_B) + wid2 * 32;
#pragma unroll
        for (int r = 0; r < 16; ++r) {
            ssq[r] += shx<1>(ssq[r]); ssq[r] += shx<2>(ssq[r]); ssq[r] += shx<4>(ssq[r]); ssq[r] += shx<8>(ssq[r]); ssq[r] += shx<16>(ssq[r]);
            if (r2 == 0) rsc[crow(r, h2)] = rsqrtf(ssq[r] * (1.f / 256.f) + EPS) * one_m_li; }
        asm volatile("s_waitcnt lgkmcnt(0)" ::: "memory");
        bf16_t* ob = p.attn_o + ((size_t)b * SEQ + qb * 128 + rg2 * 32) * D_MODEL + h * 256;
#pragma unroll 4
        for (int i = 0; i < 16; ++i) { const int id = i * 64 + lane2, row = id >> 5, cc = id & 31;
            const int hh_ = (row >> 2) & 1, rr_ = (row & 3) + 4 * (row >> 3);
            const float* q = xch + ((cc >> 2) * 16 + rr_) * 64 + hh_ * 32 + (cc & 3) * 8;
            const f32x4 a = *(const f32x4*)q, c4 = *(const f32x4*)(q + 4);
            const f32x4 w0 = *(const f32x4*)(p.a_subln_w + cc * 8), w1 = *(const f32x4*)(p.a_subln_w + cc * 8 + 4);
            const float rs = rsc[row];
            u32x4 o4; o4.x = cvtpk(a[0] * rs * w0[0], a[1] * rs * w0[1]); o4.y = cvtpk(a[2] * rs * w0[2], a[3] * rs * w0[3]);
            o4.z = cvtpk(c4[0] * rs * w1[0], c4[1] * rs * w1[1]); o4.w = cvtpk(c4[2] * rs * w1[2], c4[3] * rs * w1[3]);
            *(u32x4*)(ob + (size_t)row * D_MODEL + cc * 8) = o4; }
    }
    __syncthreads();
}
__device__ __forceinline__ void phase_diff_attn(CParams& p, char* lds) {
    float lam;
    { const int lane = tidx() & 63; const float* L = p.a_lambda;
        float s1 = L[lane] * L[128 + lane] + L[64 + lane] * L[128 + 64 + lane];
        float s2 = L[256 + lane] * L[384 + lane] + L[256 + 64 + lane] * L[384 + 64 + lane];
        s1 = wave_sum(s1); s2 = wave_sum(s2);
        lam = __expf(s1) - __expf(s2) + 0.2f; }
    int it = 0; const int myslot = blockIdx.x % 3;
#pragma unroll 1
    for (int w = wgid_v(lds); w < 512; w += gridDim.x, ++it) {
        if (CONV_MODE == 1 && it == myslot) moe_convert<1>(p, 16, 32, lds);
        const int ww = w & 255, b = ww >> 7, h = (ww >> 4) & 7, qp = ww & 15;
        diff_attn_unit(p, b, h, w < 256 ? 31 - qp : qp, lds, lam, 0.8f);
    }
    if (CONV_MODE == 1 && myslot >= it) moe_convert<1>(p, 16, 32, lds);
}
#define NSA_IMP_OFF (4 * TILE_B)
#define NSA_SEL_OFF (8 * TILE_B)
#define NSA_UM_OFF (8 * TILE_B + 512)
#define NSA_SCR_OFF (8 * TILE_B + 1024)
#define NSA_LANE() int tz_ = tidx(); asm volatile("" : "+v"(tz_)); const int tid = tz_, wid = __builtin_amdgcn_readfirstlane(tz_ >> 6), lane = tz_ & 63, r32 = lane & 31, hi = lane >> 5; \
    const int hh = wid >> 1, th = wid & 1, tl = th * 32 + r32, pos = P0 + tl, Hh = g * 4 + hh; (void)tid; (void)hh; (void)th; (void)tl; (void)pos; (void)Hh; (void)hi; \
    float* scr = (float*)(lds + NSA_SCR_OFF) + wid * 32; (void)scr; const int vb_lane = (int)(uintptr_t)lds + v_rd_base(lane); (void)vb_lane; \
    const float sl2 = 1.4426950408889634f * exp2f(-0.5f * (float)(Hh + 1)); (void)sl2;
#define NSA_C2 (1.4426950408889634f * 0.08838834764831845f)
#define NSA_RESCALE(o, alpha) do { if (__any((alpha) < 1.f)) { float al_[16]; ROWX(scr, (alpha), al_); \
        _Pragma("unroll") for (int d_ = 0; d_ < 4; ++d_) _Pragma("unroll") for (int r_ = 0; r_ < 16; ++r_) (o)[d_][r_] *= al_[r_]; } } while (0)
#define NSA_ACCUM(tot, o, fac, first) do { float f_[16]; ROWX(scr, (fac), f_); \
        _Pragma("unroll") for (int d_ = 0; d_ < 4; ++d_) _Pragma("unroll") for (int q_ = 0; q_ < 8; ++q_) { \
            float a_ = (o)[d_][2 * q_] * f_[2 * q_], b_ = (o)[d_][2 * q_ + 1] * f_[2 * q_ + 1]; \
            if (!(first)) { a_ += __uint_as_float((tot)[d_][q_] << 16); b_ += __uint_as_float((tot)[d_][q_] & 0xffff0000u); } \
            (tot)[d_][q_] = cvtpk(a_, b_); } } while (0)

__device__ __forceinline__ void nsa_unit(CParams& p, const int b, const int g, const int qb, char* lds) {
    const int P0 = qb * 64;
    const bf16_t* proj = p.qkv + (size_t)b * SEQ * B_MAIN;
    bf16x8 qr[8];
    unsigned tot[4][8];
    {   NSA_LANE();
        const bf16_t* qp = proj + (size_t)pos * B_MAIN + Hh * 128 + hi * 8;
#pragma unroll
        for (int d0 = 0; d0 < 8; ++d0) qr[d0] = *(const bf16x8*)(qp + d0 * 16);
        float* ir = (float*)(lds + NSA_IMP_OFF) + ((size_t)hh * 64 + tl) * 64 + hi * 32;
#pragma unroll
        for (int i = 0; i < 8; ++i) *(f32x4*)(ir + 4 * i) = (f32x4){0.f, 0.f, 0.f, 0.f};
    }
    {   NSA_LANE();
        const bf16_t* kcmp = p.kvcmp + ((size_t)(b * 256) * 4 + g) * 128;
        const bf16_t* vcmp = kcmp + (size_t)2048 * 128;
        const unsigned ko = fill_koff(tid, 512), vo = fill_voff(tid, 512);
        const int NTc = (4 * qb + 2) / 64 + 1;
        const int cmaxl = pos >= 31 ? ((pos - 31) >> 4) : -1;
        float m_c = -1e30f, l_c = 0.f;
#define CMP_SCORES(t) do { float sl_ = sl2 * 16.f; asm volatile("" : "+v"(sl_)); const float bb = sl_ * (float)((t) * 64 + 4 * hi); const int dq = cmaxl - (t) * 64 - 4 * hi; \
        _Pragma("unroll") for (int r = 0; r < 16; ++r) { const int c = (r & 3) + 8 * (r >> 2); \
            p0[r] = c > dq ? -__builtin_inff() : fmaf(p0[r], NSA_C2, fmaf(sl_, (float)c, bb)); \
            p1[r] = c + 32 > dq ? -__builtin_inff() : fmaf(p1[r], NSA_C2, fmaf(sl_, (float)(c + 32), bb)); } } while (0)
        fill_tile(kcmp, ko, 512, lds, tid);
        __syncthreads();
        for (int t = 0; t < NTc; ++t) {
            const int bf = t & 1;
            if (t + 1 < NTc) fill_tile(kcmp + (size_t)(t + 1) * 64 * 512, ko, 512, lds + (bf ^ 1) * 2 * TILE_B, tid);
            f32x16 p0, p1;
            qkt(p0, p1, lds + bf * 2 * TILE_B, r32, hi, qr);
            CMP_SCORES(t);
            (void)online_sm(p0, p1, m_c, l_c);
            __syncthreads();
        }
        const float inv_l = l_c > 0.f ? 1.f / l_c : 0.f;
        f32x16 o[4];
#pragma unroll
        for (int d = 0; d < 4; ++d) o[d] = f32x16{};
        float carry = 0.f;
        fill_tile(kcmp, ko, 512, lds, tid); fill_tile(vcmp, vo, 512, lds + TILE_B, tid);
        __syncthreads();
        for (int t = 0; t < NTc; ++t) {
            const int bf = t & 1;
            if (t + 1 < NTc) { fill_tile(kcmp + (size_t)(t + 1) * 64 * 512, ko, 512, lds + (bf ^ 1) * 2 * TILE_B, tid);
                               fill_tile(vcmp + (size_t)(t + 1) * 64 * 512, vo, 512, lds + (bf ^ 1) * 2 * TILE_B + TILE_B, tid); }
            f32x16 p0, p1;
            qkt(p0, p1, lds + bf * 2 * TILE_B, r32, hi, qr);
            CMP_SCORES(t);
#pragma unroll
            for (int r = 0; r < 16; ++r) { p0[r] = __builtin_amdgcn_exp2f(p0[r] - m_c) * inv_l; p1[r] = __builtin_amdgcn_exp2f(p1[r] - m_c) * inv_l; }
            { float mv[8], sp[8], ps[8];
#pragma unroll
                for (int q = 0; q < 4; ++q) { sp[q] = 0.5f * p0[4 * q + 3]; mv[q] = p0[4 * q] + p0[4 * q + 1] + p0[4 * q + 2] + sp[q];
                                              sp[4 + q] = 0.5f * p1[4 * q + 3]; mv[4 + q] = p1[4 * q] + p1[4 * q + 1] + p1[4 * q + 2] + sp[4 + q]; }
#pragma unroll
                for (int q = 0; q < 8; ++q) ps[q] = shx<32>(sp[q]);
                float* ir = (float*)(lds + NSA_IMP_OFF) + ((size_t)hh * 64 + tl) * 64 + 16 * t + hi;
#pragma unroll
                for (int q = 0; q < 8; ++q) { const float lo = q > 0 ? ps[q > 0 ? q - 1 : 0] : carry; ir[2 * q] = mv[q] + (hi ? ps[q] : lo); }
                carry = ps[7]; }
            bf16x8 pa0, pa1, pa2, pa3; pack_p(p0, p1, pa0, pa1, pa2, pa3);
            pv_tile(o, vb_lane + bf * 2 * TILE_B + TILE_B, pa0, pa1, pa2, pa3);
            __syncthreads();
        }
#undef CMP_SCORES
        const float g0 = p.gate[((size_t)b * SEQ + pos) * 48 + Hh * 3 + 0];
        NSA_ACCUM(tot, o, g0, true);
    }
    {
        const int lane = tidx() & 63, wid = __builtin_amdgcn_readfirstlane(tidx() >> 6);
        const float* imp = (const float*)(lds + NSA_IMP_OFF);
        unsigned long long* selm = (unsigned long long*)(lds + NSA_SEL_OFF);
#pragma unroll 1
        for (int i0 = 0; i0 < 8; i0 += 8) { const int j = lane;
            unsigned key[8], thr[8];
#pragma unroll
            for (int q = 0; q < 8; ++q) { const int tk = wid * 8 + i0 + q;
                const float* ir = imp + (size_t)tk * 64 + j;
                const float v = ((ir[0] + ir[64 * 64]) + ir[2 * 64 * 64]) + ir[3 * 64 * 64];
                const bool forced = (j == 0) || (j == qb) || (j == qb - 1);
                const float sc = forced ? 1e4f : (j <= qb ? v : -1e4f);
                unsigned k_ = __float_as_uint(sc); key[q] = (k_ & 0x80000000u) ? ~k_ : (k_ | 0x80000000u); thr[q] = 0u; }
#pragma unroll 1
            for (int bit = 31; bit >= 0; --bit) {
#pragma unroll
                for (int q = 0; q < 8; ++q) { const unsigned cand = thr[q] | (1u << bit);
                    if (__popcll(__ballot(key[q] >= cand)) >= 16) thr[q] = cand; } }
#pragma unroll
            for (int q = 0; q < 8; ++q) { const int tk = wid * 8 + i0 + q;
                const unsigned long long gt = __ballot(key[q] > thr[q]), eq = __ballot(key[q] == thr[q]);
                const int need = 16 - __popcll(gt);
                const bool sel = (key[q] > thr[q]) || (key[q] == thr[q] && __popcll(eq & ((1ull << j) - 1ull)) < need);
                const unsigned long long sm = __ballot(sel && j <= qb);
                if (lane == 0) selm[tk] = sm; } }
        __syncthreads();
        if (wid == 0) { unsigned long long u = selm[lane];
#define UM_STEP(S) do { const unsigned lo = (unsigned)shx_i<S>((int)(unsigned)u), hi2 = (unsigned)shx_i<S>((int)(unsigned)(u >> 32)); u |= ((unsigned long long)hi2 << 32) | lo; } while (0)
            UM_STEP(32); UM_STEP(16); UM_STEP(8); UM_STEP(4); UM_STEP(2); UM_STEP(1);
#undef UM_STEP
            if (lane == 0) *(unsigned long long*)(lds + NSA_UM_OFF) = u; }
        { char* qd = lds + NSA_IMP_OFF + wid * 8192 + lane * 16;
#pragma unroll
            for (int d0 = 0; d0 < 8; ++d0) *(bf16x8*)(qd + d0 * 1024) = qr[d0]; }
        __syncthreads();
    }
    {   NSA_LANE();
        const unsigned long long mysel = ((const unsigned long long*)(lds + NSA_SEL_OFF))[tl];
        unsigned long long um = *(const unsigned long long*)(lds + NSA_UM_OFF);
        um = ((unsigned long long)__builtin_amdgcn_readfirstlane((unsigned)(um >> 32)) << 32) | (unsigned)__builtin_amdgcn_readfirstlane((unsigned)um);
        const bf16_t* Ks = proj + 3072 + g * 128; const bf16_t* Vs = proj + 3584 + g * 128;
        const unsigned ko = fill_koff(tid, B_MAIN), vo = fill_voff(tid, B_MAIN);
        float m_s = -1e30f, l_s = 0.f; f32x16 o[4];
#pragma unroll
        for (int d = 0; d < 4; ++d) o[d] = f32x16{};
        int j = __builtin_ctzll(um); um &= um - 1; int idx = 0;
        fill_tile(Ks + (size_t)j * 64 * B_MAIN, ko, B_MAIN, lds, tid); fill_tile(Vs + (size_t)j * 64 * B_MAIN, vo, B_MAIN, lds + TILE_B, tid);
        __syncthreads();
        for (;;) {
            const int bf = idx & 1; int jn = -1;
            if (um) { jn = __builtin_ctzll(um); um &= um - 1;
                fill_tile(Ks + (size_t)jn * 64 * B_MAIN, ko, B_MAIN, lds + (bf ^ 1) * 2 * TILE_B, tid); fill_tile(Vs + (size_t)jn * 64 * B_MAIN, vo, B_MAIN, lds + (bf ^ 1) * 2 * TILE_B + TILE_B, tid); }
            const bool ms = (mysel >> j) & 1ull;
            if (__any(ms)) {
                f32x16 p0, p1;
                qkt_lds(p0, p1, lds + bf * 2 * TILE_B, r32, hi, lds + NSA_IMP_OFF + wid * 8192 + lane * 16);
                float sl_ = sl2; asm volatile("" : "+v"(sl_));
                const float bb = sl_ * (float)(j * 64 - P0 + 4 * hi); const int dq = !ms ? -1000 : (j == qb) ? (tl - 4 * hi) : 1000;
#pragma unroll
                for (int r = 0; r < 16; ++r) { const int c = (r & 3) + 8 * (r >> 2);
                    p0[r] = (c > dq) ? -__builtin_inff() : fmaf(p0[r], NSA_C2, fmaf(sl_, (float)c, bb));
                    p1[r] = (c + 32 > dq) ? -__builtin_inff() : fmaf(p1[r], NSA_C2, fmaf(sl_, (float)(c + 32), bb)); }
                const float alpha = online_sm(p0, p1, m_s, l_s);
                NSA_RESCALE(o, alpha);
                bf16x8 pa0, pa1, pa2, pa3; pack_p(p0, p1, pa0, pa1, pa2, pa3);
                pv_tile(o, vb_lane + bf * 2 * TILE_B + TILE_B, pa0, pa1, pa2, pa3);
            }
            __syncthreads();
            if (jn < 0) break;
            j = jn; ++idx;
        }
        const float g1 = p.gate[((size_t)b * SEQ + pos) * 48 + Hh * 3 + 1];
        NSA_ACCUM(tot, o, g1 / l_s, false);
    }
    {   NSA_LANE();
        const bf16_t* Kw = proj + 4096 + g * 128; const bf16_t* Vw = proj + 4608 + g * 128;
        const unsigned ko = fill_koff(tid, B_MAIN), vo = fill_voff(tid, B_MAIN);
        float m_w = -1e30f, l_w = 0.f; f32x16 o[4];
#pragma unroll
        for (int d = 0; d < 4; ++d) o[d] = f32x16{};
        const int j0 = qb >= 8 ? qb - 8 : 0, NTw = qb - j0 + 1;
        fill_tile(Kw + (size_t)j0 * 64 * B_MAIN, ko, B_MAIN, lds, tid); fill_tile(Vw + (size_t)j0 * 64 * B_MAIN, vo, B_MAIN, lds + TILE_B, tid);
        __syncthreads();
        for (int t = 0; t < NTw; ++t) {
            const int bf = t & 1, j = j0 + t;
            if (t + 1 < NTw) { fill_tile(Kw + (size_t)(j + 1) * 64 * B_MAIN, ko, B_MAIN, lds + (bf ^ 1) * 2 * TILE_B, tid); fill_tile(Vw + (size_t)(j + 1) * 64 * B_MAIN, vo, B_MAIN, lds + (bf ^ 1) * 2 * TILE_B + TILE_B, tid); }
            f32x16 p0, p1;
            qkt_lds(p0, p1, lds + bf * 2 * TILE_B, r32, hi, lds + NSA_IMP_OFF + wid * 8192 + lane * 16);
            float sl_ = sl2; asm volatile("" : "+v"(sl_));
            const float bb = sl_ * (float)(j * 64 - P0 + 4 * hi);
#pragma unroll
            for (int r = 0; r < 16; ++r) { const int c = (r & 3) + 8 * (r >> 2);
                p0[r] = fmaf(p0[r], NSA_C2, fmaf(sl_, (float)c, bb)); p1[r] = fmaf(p1[r], NSA_C2, fmaf(sl_, (float)(c + 32), bb)); }
            if (j == qb || j == qb - 8) { const int dq = pos - j * 64 - 4 * hi;
#pragma unroll
                for (int r = 0; r < 16; ++r) { const int c = (r & 3) + 8 * (r >> 2);
                    if ((unsigned)(dq - c) >= 512u) p0[r] = -__builtin_inff();
                    if ((unsigned)(dq - c - 32) >= 512u) p1[r] = -__builtin_inff(); } }
            const float alpha = online_sm(p0, p1, m_w, l_w);
            NSA_RESCALE(o, alpha);
            bf16x8 pa0, pa1, pa2, pa3; pack_p(p0, p1, pa0, pa1, pa2, pa3);
            pv_tile(o, vb_lane + bf * 2 * TILE_B + TILE_B, pa0, pa1, pa2, pa3);
            __syncthreads();
        }
        const float g2 = p.gate[((size_t)b * SEQ + pos) * 48 + Hh * 3 + 2];
        NSA_ACCUM(tot, o, g2 / l_w, false);
    }
    {   NSA_LANE();
        bf16_t* st = (bf16_t*)(lds + wid * 8192);
#pragma unroll
        for (int d = 0; d < 4; ++d) {
#pragma unroll
            for (int r = 0; r < 16; ++r) st[crow(r, hi) * 128 + d * 32 + r32] = (bf16_t)((r & 1) ? (tot[d][r >> 1] >> 16) : (tot[d][r >> 1] & 0xffffu));
            SBAR(); }
        asm volatile("s_waitcnt lgkmcnt(0)" ::: "memory");
        bf16_t* ob = p.attn_o + ((size_t)b * SEQ + P0 + th * 32) * D_MODEL + Hh * 128;
#pragma unroll
        for (int i = 0; i < 8; ++i) { const int id = i * 64 + lane, row = id >> 4, cc = id & 15;
            *(u32x4*)(ob + (size_t)row * D_MODEL + cc * 8) = *(const u32x4*)(st + row * 128 + cc * 8); }
    }
    __syncthreads();
}
__device__ __forceinline__ void phase_nsa(CParams& p, char* lds) {
    int it = 0; const int myslot = blockIdx.x % 3;
#pragma unroll 1
    for (int w = wgid_v(lds); w < 512; w += gridDim.x, ++it) {
        if (CONV_MODE == 1 && it == myslot) moe_convert<1>(p, 54, 64, lds);
        const int ww = w & 255, b = ww >> 7, g = (ww >> 5) & 3, qp = ww & 31;
        nsa_unit(p, b, g, w < 256 ? 63 - qp : qp, lds);
    }
    if (CONV_MODE == 1 && myslot >= it) moe_convert<1>(p, 54, 64, lds);
}
__device__ __forceinline__ void load_row(const float* src, int lane, f32x4 (&v)[8]) {
#pragma unroll
    for (int i = 0; i < 8; ++i) v[i] = *(const f32x4*)(src + (i * 64 + lane) * 4);
}
__device__ __forceinline__ void load_row_bf16(const bf16_t* src, int lane, f32x4 (&v)[8]) {
#pragma unroll
    for (int i = 0; i < 8; ++i) { const u32x2 w = *(const u32x2*)(src + (i * 64 + lane) * 4);
        v[i][0] = __uint_as_float(w.x << 16); v[i][1] = __uint_as_float(w.x & 0xffff0000u);
        v[i][2] = __uint_as_float(w.y << 16); v[i][3] = __uint_as_float(w.y & 0xffff0000u); }
}
__device__ __forceinline__ void add_bf16_row(const bf16_t* src, int lane, f32x4 (&v)[8]) {
#pragma unroll
    for (int i = 0; i < 8; ++i) { const u32x2 w = *(const u32x2*)(src + (i * 64 + lane) * 4);
        v[i][0] += __uint_as_float(w.x << 16); v[i][1] += __uint_as_float(w.x & 0xffff0000u);
        v[i][2] += __uint_as_float(w.y << 16); v[i][3] += __uint_as_float(w.y & 0xffff0000u); }
}
__device__ __forceinline__ float row_rstd(const f32x4 (&v)[8]) {
    float ss = 0.f;
#pragma unroll
    for (int i = 0; i < 8; ++i) ss += v[i][0] * v[i][0] + v[i][1] * v[i][1] + v[i][2] * v[i][2] + v[i][3] * v[i][3];
    ss = wave_sum(ss); return rsqrtf(ss * (1.f / D_MODEL) + EPS);
}
__device__ __forceinline__ void norm_store_bf16(f32x4 (&v)[8], float rs, const float* w, bf16_t* dst, int lane) {
#pragma unroll
    for (int i = 0; i < 8; ++i) { const f32x4 wv = *(const f32x4*)(w + (i * 64 + lane) * 4);
        v[i][0] *= rs * wv[0]; v[i][1] *= rs * wv[1]; v[i][2] *= rs * wv[2]; v[i][3] *= rs * wv[3];
        u32x2 o; o.x = cvtpk(v[i][0], v[i][1]); o.y = cvtpk(v[i][2], v[i][3]);
        *(u32x2*)(dst + (i * 64 + lane) * 4) = o; }
}
struct MoeTab { int cnt[32]; int rbase[32]; int ustart[33]; int next; };
__device__ __forceinline__ void moe_tables(const unsigned* cnt, MoeTab* tb) {
    if (tidx() == 0) { int acc = 0;
        for (int e = 0; e < 32; ++e) { const int c = (int)cnt[e]; tb->cnt[e] = c; tb->rbase[e] = acc * 256; tb->ustart[e] = acc * 16; acc += (c + 255) >> 8; }
        tb->ustart[32] = acc * 16; }
    __syncthreads();
}

__device__ __forceinline__ void phase_first(CParams& p, char* lds) {
    const int tid = tidx(), wid = tid >> 6, lane = tid & 63;
    if (blockIdx.x == 0 && tid < 128) p.cnt[tid] = 0u;
    for (int i = blockIdx.x * NTHREADS + tid; i < 2 * 64 * D_MODEL; i += gridDim.x * NTHREADS) { const int l = i >> 17, e = (i >> 11) & 63, k = i & 2047;
        const float w = e < 4 ? p.moe_w_group[((size_t)l * D_MODEL + k) * 4 + e] : e < 36 ? p.moe_w_expert[((size_t)l * D_MODEL + k) * 32 + (e - 4)] : 0.f;
        const bf16_t whi = f2bf(w); p.rw_hi[i] = whi; p.rw_lo[i] = f2bf(w - bf2f(whi)); }
    for (int row = blockIdx.x * 8 + wid; row < T_TOK; row += gridDim.x * 8) {
        f32x4 v[8]; load_row(p.x + (size_t)row * D_MODEL, lane, v);
        const float rs = row_rstd(v);
        norm_store_bf16(v, rs, p.attn_norm_w, p.xn + (size_t)row * D_MODEL, lane);
    }
    __syncthreads();
    int job = blockIdx.x; const int stride = gridDim.x;
    convert_weight<0>(p.a_w_in, D_MODEL, A_IN, p.wt_a_in, job, stride, lds);
    convert_weight<0>(p.a_w_out, D_MODEL, D_MODEL, p.wt_a_out, job, stride, lds);
    convert_weight<0>(p.b_w_in, D_MODEL, B_IN, p.wt_b_in, job, stride, lds);
    convert_weight<0>(p.b_w_out, D_MODEL, D_MODEL, p.wt_b_out, job, stride, lds);
    __syncthreads();
#if CONV_MODE == 0
    moe_convert<3>(p, 0, 64, lds);
#endif
}

struct RouteDec { int ea, eb; float wa, wb; };
__device__ __forceinline__ void route_decide(CParams& p, const int layer, const float (&acc)[36], RouteDec* out) {
    const float* bg = p.moe_b_group + layer * 4; const float* be = p.moe_b_expert + layer * 32;
    float lg[4];
#pragma unroll
    for (int j = 0; j < 4; ++j) lg[j] = acc[j] + bg[j];
    int gt = 0; float gm = lg[0];
#pragma unroll
    for (int j = 1; j < 4; ++j) if (lg[j] > gm) { gm = lg[j]; gt = j; }
    float gs = 0.f;
#pragma unroll
    for (int j = 0; j < 4; ++j) gs += __expf(lg[j] - gm);
    const float wgp = 1.f / gs;
    int ea = 0, eb = -1; float m0 = -3.0e38f, m1 = -3.0e38f;
#pragma unroll
    for (int k = 0; k < 32; ++k) { const float v = ((k >> 3) == gt) ? acc[4 + k] + be[k] : -3.0e38f; if (v > m0) { m0 = v; ea = k; } }
#pragma unroll
    for (int k = 0; k < 32; ++k) { const float v = ((k >> 3) == gt && k != ea) ? acc[4 + k] + be[k] : -3.0e38f; if (v > m1) { m1 = v; eb = k; } }
    const float e1 = __expf(m1 - m0);
    out->ea = ea; out->eb = eb; out->wa = wgp / (1.f + e1); out->wb = wgp * e1 / (1.f + e1);
}
#define DPP_ADD(v, CTRL) v += __int_as_float(__builtin_amdgcn_update_dpp(0, __float_as_int(v), CTRL, 0xf, 0xf, false))
__device__ __forceinline__ void reduce36(float (&a)[36]) {
    float u[9];
#pragma unroll
    for (int i = 0; i < 9; ++i) {
        float z[2];
#pragma unroll
        for (int h = 0; h < 2; ++h) {
            const u32x2 s = __builtin_amdgcn_permlane32_swap(__float_as_uint(a[4 * i + 2 * h]), __float_as_uint(a[4 * i + 2 * h + 1]), false, false);
            z[h] = __uint_as_float(s[0]) + __uint_as_float(s[1]); }
        const u32x2 t = __builtin_amdgcn_permlane16_swap(__float_as_uint(z[0]), __float_as_uint(z[1]), false, false);
        float x = __uint_as_float(t[0]) + __uint_as_float(t[1]);
        DPP_ADD(x, 0x128); DPP_ADD(x, 0x124); DPP_ADD(x, 0x122); DPP_ADD(x, 0x121);
        u[i] = x; }
#pragma unroll
    for (int i = 0; i < 9; ++i) {
        a[4 * i + 0] = __int_as_float(__builtin_amdgcn_readlane(__float_as_int(u[i]), 0));  a[4 * i + 2] = __int_as_float(__builtin_amdgcn_readlane(__float_as_int(u[i]), 16));
        a[4 * i + 1] = __int_as_float(__builtin_amdgcn_readlane(__float_as_int(u[i]), 32)); a[4 * i + 3] = __int_as_float(__builtin_amdgcn_readlane(__float_as_int(u[i]), 48)); }
}
#define NR_MAXROWS 512
#define NRW 4
__device__ __forceinline__ void phase_norm_route(CParams& p, const bf16_t* h, const int layer, char* lds) {
    const int tid = tidx(), wid = tid >> 6, lane = tid & 63;
    const float* nw = p.ffn_norm_w + layer * D_MODEL;
    float* fin = (float*)lds;
    float* rsl = (float*)(lds + 57344);
    float* part = (float*)(lds + 65536);
    RouteDec* dec = (RouteDec*)(lds + 40960);
    int* dtok = (int*)(lds + 40960 + NR_MAXROWS * 16);
    int* hist = dtok + NR_MAXROWS;
    int* posa = hist + 64; int* posb = posa + NR_MAXROWS;
    if (tid < 64) hist[tid] = 0;
    int nrows = 0;
    for (int rb = blockIdx.x; rb < T_TOK / (8 * NRW); rb += gridDim.x, nrows += 8 * NRW) {
        const int row0 = rb * (8 * NRW) + wid * NRW;
        float rs[NRW];
#pragma unroll
        for (int r = 0; r < NRW; ++r) { f32x4 v[8]; load_row_bf16(h + (size_t)(row0 + r) * D_MODEL, lane, v);
            rs[r] = row_rstd(v);
            norm_store_bf16(v, rs[r], nw, p.xn + (size_t)(row0 + r) * D_MODEL, lane); }
        if (lane == 0) {
#pragma unroll
            for (int r = 0; r < NRW; ++r) rsl[wid * NRW + r] = rs[r]; }
        __syncthreads();
        { const int j = lane & 31, hi = lane >> 5; const float rsj = rsl[j];
          f32x16 d0 = {}, d1 = {};
          const bf16_t* hrow = h + (size_t)(rb * (8 * NRW) + j) * D_MODEL + wid * 256 + 8 * hi;
          const float* nwp = nw + wid * 256 + 8 * hi;
          const bf16_t* wh = p.rw_hi + ((size_t)(layer * 64 + j) * D_MODEL) + wid * 256 + 8 * hi; const bf16_t* wl = p.rw_lo + ((size_t)(layer * 64 + j) * D_MODEL) + wid * 256 + 8 * hi;
#pragma unroll 4
          for (int ks = 0; ks < 16; ++ks) {
              const u32x4 hv = *(const u32x4*)(hrow + ks * 16); const f32x4 na = *(const f32x4*)(nwp + ks * 16), nb = *(const f32x4*)(nwp + ks * 16 + 4);
              float x[8];
              x[0] = __uint_as_float(hv.x << 16) * (rsj * na[0]); x[1] = __uint_as_float(hv.x & 0xffff0000u) * (rsj * na[1]);
              x[2] = __uint_as_float(hv.y << 16) * (rsj * na[2]); x[3] = __uint_as_float(hv.y & 0xffff0000u) * (rsj * na[3]);
              x[4] = __uint_as_float(hv.z << 16) * (rsj * nb[0]); x[5] = __uint_as_float(hv.z & 0xffff0000u) * (rsj * nb[1]);
              x[6] = __uint_as_float(hv.w << 16) * (rsj * nb[2]); x[7] = __uint_as_float(hv.w & 0xffff0000u) * (rsj * nb[3]);
              u32x4 xh, xl;
              xh.x = cvtpk(x[0], x[1]); xh.y = cvtpk(x[2], x[3]); xh.z = cvtpk(x[4], x[5]); xh.w = cvtpk(x[6], x[7]);
              xl.x = cvtpk(x[0] - __uint_as_float(xh.x << 16), x[1] - __uint_as_float(xh.x & 0xffff0000u)); xl.y = cvtpk(x[2] - __uint_as_float(xh.y << 16), x[3] - __uint_as_float(xh.y & 0xffff0000u));
              xl.z = cvtpk(x[4] - __uint_as_float(xh.z << 16), x[5] - __uint_as_float(xh.z & 0xffff0000u)); xl.w = cvtpk(x[6] - __uint_as_float(xh.w << 16), x[7] - __uint_as_float(xh.w & 0xffff0000u));
              const bf16x8 xhf = __builtin_bit_cast(bf16x8, xh), xlf = __builtin_bit_cast(bf16x8, xl);
              const bf16x8 wh0 = *(const bf16x8*)(wh + ks * 16), wl0 = *(const bf16x8*)(wl + ks * 16);
              const bf16x8 wh1 = *(const bf16x8*)(wh + (size_t)32 * D_MODEL + ks * 16), wl1 = *(const bf16x8*)(wl + (size_t)32 * D_MODEL + ks * 16);
              d0 = __builtin_amdgcn_mfma_f32_32x32x16_bf16(wh0, xhf, d0, 0, 0, 0); d0 = __builtin_amdgcn_mfma_f32_32x32x16_bf16(wl0, xhf, d0, 0, 0, 0); d0 = __builtin_amdgcn_mfma_f32_32x32x16_bf16(wh0, xlf, d0, 0, 0, 0);
              d1 = __builtin_amdgcn_mfma_f32_32x32x16_bf16(wh1, xhf, d1, 0, 0, 0); d1 = __builtin_amdgcn_mfma_f32_32x32x16_bf16(wl1, xhf, d1, 0, 0, 0); d1 = __builtin_amdgcn_mfma_f32_32x32x16_bf16(wh1, xlf, d1, 0, 0, 0); }
          float* pw = part + ((size_t)(wid * 32 + j)) * 40;
#pragma unroll
          for (int r = 0; r < 16; ++r) pw[(r & 3) + 8 * (r >> 2) + 4 * hi] = d0[r];
          if (hi == 0) {
#pragma unroll
              for (int r = 0; r < 4; ++r) pw[32 + r] = d1[r]; } }
        __syncthreads();
        for (int idx = tid; idx < 32 * 36; idx += NTHREADS) { const int row = idx / 36, e = idx - row * 36; float s = 0.f;
#pragma unroll
            for (int w = 0; w < 8; ++w) s += part[(size_t)(w * 32 + row) * 40 + e];
            fin[idx] = s; }
        __syncthreads();
        if (tid < 32 && nrows + tid < NR_MAXROWS) { float acc[36];
#pragma unroll
            for (int e = 0; e < 36; ++e) acc[e] = fin[tid * 36 + e];
            route_decide(p, layer, acc, &dec[nrows + tid]); dtok[nrows + tid] = rb * (8 * NRW) + tid; }
        __syncthreads();
    }
    __syncthreads();
    if (nrows > NR_MAXROWS) nrows = NR_MAXROWS;
    if (tid < nrows) { posa[tid] = atomicAdd(&hist[dec[tid].ea], 1); posb[tid] = atomicAdd(&hist[dec[tid].eb], 1); }
    __syncthreads();
    if (tid < 32) { const int c = hist[tid]; hist[32 + tid] = c ? (int)atomicAdd(p.cnt + layer * 32 + tid, (unsigned)c) : 0; }
    __syncthreads();
    if (tid < nrows) { const RouteDec d = dec[tid]; const int tok = dtok[tid];
        const int ra = hist[32 + d.ea] + posa[tid], rb2 = hist[32 + d.eb] + posb[tid];
        p.list_tok[d.ea * LIST_CAP + ra] = tok; p.list_w[d.ea * LIST_CAP + ra] = d.wa;
        p.list_tok[d.eb * LIST_CAP + rb2] = tok; p.list_w[d.eb * LIST_CAP + rb2] = d.wb;
        p.slot_ref[tok * 2 + 0] = (d.ea << 16) | ra; p.slot_ref[tok * 2 + 1] = (d.eb << 16) | rb2; }
    __syncthreads();
}
template <int MODE>
__device__ __forceinline__ void phase_combine(CParams& p, const bf16_t* hold, bf16_t* hnew, const float* w, const int layer, char* lds) {
    MoeTab* tb = (MoeTab*)lds; (void)layer;
    const int wid = tidx() >> 6, lane = tidx() & 63;
#define CB_FIN(row, v) do { \
        if (MODE == 0) { \
            _Pragma("unroll") for (int i = 0; i < 8; ++i) { u32x2 o; o.x = cvtpk(v[i][0], v[i][1]); o.y = cvtpk(v[i][2], v[i][3]); *(u32x2*)(hnew + (size_t)(row) * D_MODEL + (i * 64 + lane) * 4) = o; } \
            const float rs = row_rstd(v); \
            norm_store_bf16(v, rs, w, p.xn + (size_t)(row) * D_MODEL, lane); \
        } else { \
            const float rs = row_rstd(v); \
            _Pragma("unroll") for (int i = 0; i < 8; ++i) { const f32x4 wv = *(const f32x4*)(w + (i * 64 + lane) * 4); \
                f32x4 o; o[0] = v[i][0] * rs * wv[0]; o[1] = v[i][1] * rs * wv[1]; o[2] = v[i][2] * rs * wv[2]; o[3] = v[i][3] * rs * wv[3]; \
                *(f32x4*)(p.out + (size_t)(row) * D_MODEL + (i * 64 + lane) * 4) = o; } } } while (0)
    const int rstep = gridDim.x * 8;
    for (int row = blockIdx.x * 8 + wid; row < T_TOK; row += 2 * rstep) {
        const int rowb = row + rstep; const bool hb = rowb < T_TOK; const int rb_ = hb ? rowb : row;
        const int a0 = p.slot_ref[row * 2], a1 = p.slot_ref[row * 2 + 1], b0 = p.slot_ref[rb_ * 2], b1 = p.slot_ref[rb_ * 2 + 1];
        f32x4 va[8], vb[8];
        load_row_bf16(hold + (size_t)row * D_MODEL, lane, va); load_row_bf16(hold + (size_t)rb_ * D_MODEL, lane, vb);
        const int ra0 = tb->rbase[a0 >> 16] + (a0 & 0xffff), ra1 = tb->rbase[a1 >> 16] + (a1 & 0xffff);
        const int rb0 = tb->rbase[b0 >> 16] + (b0 & 0xffff), rb1 = tb->rbase[b1 >> 16] + (b1 & 0xffff);
        add_bf16_row(p.ybuf + (size_t)ra0 * D_MODEL, lane, va); add_bf16_row(p.ybuf + (size_t)rb0 * D_MODEL, lane, vb);
        add_bf16_row(p.ybuf + (size_t)ra1 * D_MODEL, lane, va); add_bf16_row(p.ybuf + (size_t)rb1 * D_MODEL, lane, vb);
        CB_FIN(row, va);
        if (hb) CB_FIN(rowb, vb);
    }
#undef CB_FIN
    __syncthreads();
}

#define GEMM_LDS_OFF 1024
#ifdef PROBE_QKV_GT
__device__ __forceinline__ void phase_qkv(CParams& p, char* lds) {
    for (int u = blockIdx.x; u < 32 * 48; u += gridDim.x) { const int mt = u & 31, nt = u >> 5;
        gemm_tile(ARows{p.xn, D_MODEL, mt * 256, T_TOK}, BBf16T{p.wt_a_in, D_MODEL, nt * 128}, EpBf16{p.qkv, A_IN, mt * 256, nt * 128, T_TOK, A_IN}, D_MODEL, lds + GEMM_LDS_OFF, 0xFu); }
}
#else
__device__ __forceinline__ void phase_qkv(CParams& p, char* lds) {
    int it = 0; const int myslot = blockIdx.x & 3;
    for (int u = wgid_v(lds); u < 32 * 24; u += gridDim.x, ++it) { int pm, pn; g8_order_c(u, 32, 24, pm, pn);
        if (CONV_MODE == 1 && it == myslot) moe_convert<1>(p, 0, 16, lds);
        unsigned ao[2][2], bo[2]; g8_offsets2(ao[0], pm * 256, D_MODEL); ao[1][0] = ao[1][1] = 0u; g8_offsets2_perm(bo, pn * 256, D_MODEL);
        gemm8_unit<false>(p.xn, ao, D_MODEL, p.wt_a_in, bo, D_MODEL, lds + GEMM_LDS_OFF, E8Bf16{p.qkv, A_IN, pm * 256, pn * 256, A_IN}, true); }
    if (CONV_MODE == 1 && myslot >= it) moe_convert<1>(p, 0, 16, lds);
}
#endif
template <bool RB>
__device__ __forceinline__ void phase_oproj(CParams& p, const bf16_t* wt, const void* res, bf16_t* hout, char* lds) {
    for (int u = wgid_v(lds); u < 32 * 8; u += gridDim.x) { int pm, pn; g8_order_c(u, 32, 8, pm, pn);
        unsigned ao[2][2], bo[2]; g8_offsets2(ao[0], pm * 256, D_MODEL); ao[1][0] = ao[1][1] = 0u; g8_offsets2_perm(bo, pn * 256, D_MODEL);
        gemm8_unit<false>(p.attn_o, ao, D_MODEL, wt, bo, D_MODEL, lds + GEMM_LDS_OFF, E8ResBf16<RB>{hout, res, pm * 256, pn * 256}, true); }
}
__device__ __forceinline__ void phase_proj(CParams& p, char* lds) {
    int it = 0; const int myslot = blockIdx.x & 3;
    for (int u = wgid_v(lds); u < 32 * 21; u += gridDim.x, ++it) { int pm, pn; g8_order_c(u, 32, 21, pm, pn);
        if (CONV_MODE == 1 && it == myslot) moe_convert<1>(p, 32, 43, lds);
        unsigned ao[2][2], bo[2]; g8_offsets2(ao[0], pm * 256, D_MODEL); ao[1][0] = ao[1][1] = 0u; g8_offsets2_perm(bo, pn * 256, D_MODEL);
        gemm8_unit<false>(p.xn, ao, D_MODEL, p.wt_b_in, bo, D_MODEL, lds + GEMM_LDS_OFF, E8Proj{p.qkv, p.gate, pm * 256, pn * 256}, true); }
    if (CONV_MODE == 1 && myslot >= it) moe_convert<1>(p, 32, 43, lds);
    __syncthreads();
    { const int tid = tidx();
      for (int w = (int)gridDim.x - 1 - wgid_v(lds); w < 64; w += gridDim.x) {
        const int o = tid & 7, ks = tid >> 3, out = w * 8 + o, t = out >> 8, n = out & 255;
        const float* pe = p.b_cmp_pos + (size_t)t * 4096; const float* w1 = p.b_cmp_w1 + (size_t)t * 4096 * 256 + n;
        float s = 0.f;
        for (int k = ks; k < 4096; k += 64) s += pe[k] * w1[(size_t)k * 256];
        float* red = (float*)lds; red[tid] = s; __syncthreads();
        if (tid < 8) { float a = 0.f; for (int i = 0; i < 64; ++i) a += red[i * 8 + tid]; p.cbias[w * 8 + tid] = a; }
        __syncthreads();
      } }
}
__device__ __forceinline__ void phase_cmp1(CParams& p, char* lds) {
    for (int u = blockIdx.x; u < 256; u += gridDim.x) { const int sp = u >> 5, t = (u >> 4) & 1, mt = (u >> 1) & 7, nt = u & 1;
        gemm_tile<true>(ACompress{p.qkv, 2048 + t * 512, mt * 256, sp * 512}, BPlain{p.b_cmp_w1 + ((size_t)t * 4096 + sp * 512) * 256, 256, nt * 128, 256},
                  EpF32{p.cslab + ((size_t)sp * 2 + t) * 2048 * 256, 256, mt * 256, nt * 128}, 512, lds + GEMM_LDS_OFF, 0xFu); }
}
__device__ __forceinline__ void phase_cmp_reduce(CParams& p) {
    for (int i = blockIdx.x * NTHREADS + tidx(); i < 2 * 2048 * 256 / 4; i += gridDim.x * NTHREADS) {
        const int c = (i & 63) * 4, t = i >> 17; f32x4 s = *(const f32x4*)(p.cbias + t * 256 + c);
#pragma unroll
        for (int sp = 0; sp < 8; ++sp) s += *(const f32x4*)(p.cslab + (size_t)sp * 2 * 2048 * 256 + (size_t)i * 4);
        u32x2 w; w.x = cvtpk(gelu_tanh(s[0]), gelu_tanh(s[1])); w.y = cvtpk(gelu_tanh(s[2]), gelu_tanh(s[3]));
        *(u32x2*)(p.chid + (size_t)i * 4) = w; }
}
__device__ __forceinline__ void phase_cmp2(CParams& p, char* lds) {
    for (int u = blockIdx.x; u < 16; u += gridDim.x) { const int t = u >> 3, mt = u & 7;
        gemm_tile<true>(ARows{p.chid + (size_t)t * 2048 * 256, 256, mt * 256, 2048}, BPlain{p.b_cmp_w2 + (size_t)t * 256 * 128, 128, 0, 128},
                  EpBf16{p.kvcmp + (size_t)t * 2048 * 128, 128, mt * 256, 0, 2048, 128}, 256, lds + GEMM_LDS_OFF, 0xFu); }
}
__device__ __forceinline__ int moe_first_unit() { const int w = blockIdx.x; return gridDim.x == 256 ? 32 * (w & 7) + (w >> 3) : w; }
__device__ __forceinline__ bool moe_decode(const MoeTab* tb, int u, int& e, int& mt, int& nt) {
    if (u >= tb->ustart[32]) return false;
    e = 0;
#pragma unroll 1
    for (int i = 1; i < 32; ++i) if (u >= tb->ustart[i]) e = i;
    const int loc = u - tb->ustart[e], tiles = (tb->cnt[e] + 255) >> 8;
    nt = loc / tiles; mt = loc - nt * tiles; return true;
}
__device__ __forceinline__ unsigned moe_rowmask(int cnt, int mt) { const int rem = cnt - mt * 256; return rem >= 193 ? 0xFu : rem >= 129 ? 0x7u : rem >= 65 ? 0x3u : 0x1u; }
__device__ __forceinline__ bool moe_decode8(const MoeTab* tb, int u, int& e, int& mt, int& nt);
#define SCAL(v) __builtin_amdgcn_readfirstlane((int)(v))
__device__ __forceinline__ bool moe_decode8(const MoeTab* tb, int u, int& e, int& mt, int& nt);
__device__ __forceinline__ unsigned moe_rowmask(int cnt, int mt);
struct UpUnits { typedef BGateUp256 BFT; typedef EpSiluMul256 EPT; static constexpr size_t LDB = D_EXPERT;
    CParams& p; const MoeTab* tb; int layer; int u, G, nfull; AGather af; BGateUp256 bf; EpSiluMul256 ep; unsigned rowmask;
    __device__ __forceinline__ bool load() { if (u >= nfull) return false; int e, mt, nt; moe_decode8(tb, u, e, mt, nt); e = SCAL(e); mt = SCAL(mt); nt = SCAL(nt);
        const size_t wo = ((size_t)layer * N_EXPERTS + e) * D_MODEL * D_EXPERT; const int cnt = SCAL(tb->cnt[e]), rb = SCAL(tb->rbase[e]);
        af = AGather{p.xn, D_MODEL, p.list_tok + e * LIST_CAP, mt * 256, cnt}; bf = BGateUp256{p.moe_w_gate + wo, (long long)(p.moe_w_up - p.moe_w_gate), D_EXPERT, nt * 128};
        ep = EpSiluMul256{p.hmid, rb + mt * 256, nt * 128}; rowmask = moe_rowmask(cnt, mt); return true; }
    __device__ __forceinline__ bool first() { return load(); }
    __device__ __forceinline__ bool next() { u += G; return load(); }
};
struct DownUnits { typedef BPlain256 BFT; typedef EpScaleRow256 EPT; static constexpr size_t LDB = D_MODEL;
    CParams& p; const MoeTab* tb; int layer; int u, G, nfull; ARows af; BPlain256 bf; EpScaleRow256 ep; unsigned rowmask;
    __device__ __forceinline__ bool load() { if (u >= nfull) return false; int e, mt, nt; moe_decode8(tb, u, e, mt, nt); e = SCAL(e); mt = SCAL(mt); nt = SCAL(nt);
        const size_t wo = ((size_t)layer * N_EXPERTS + e) * D_EXPERT * D_MODEL; const int cnt = SCAL(tb->cnt[e]), rb = SCAL(tb->rbase[e]), r0 = rb + mt * 256;
        af = ARows{p.hmid, D_EXPERT, r0, rb + cnt}; bf = BPlain256{p.moe_w_down + wo, D_MODEL, nt * 256};
        ep = EpScaleRow256{p.ybuf, p.list_w + e * LIST_CAP, mt * 256, cnt, r0, nt * 256}; rowmask = moe_rowmask(cnt, mt); return true; }
    __device__ __forceinline__ bool first() { return load(); }
    __device__ __forceinline__ bool next() { u += G; return load(); }
};
#define SCAL3(a, b, c) do { a = SCAL(a); b = SCAL(b); c = SCAL(c); } while (0)
template <int PROBE = 0>
__device__ __forceinline__ void phase_moe_up_direct(CParams& p, const int layer, char* lds) {
    MoeTab* tb = (MoeTab*)lds; moe_tables(p.cnt + layer * 32, tb);
    const int T = tb->ustart[32] / 2, G = gridDim.x, nfull = (2 * (T % G) > G) ? T : (T / G) * G;
    bf16_t* const hout = PROBE ? (bf16_t*)p.wgu_t : p.hmid;
    int e, mt, nt;
    if (PROBE == 0) { UpUnits un{p, tb, layer, wgid_v(lds), G, nfull, AGather{}, BGateUp256{}, EpSiluMul256{}, 0u}; gemm_tile256_seq(un, D_MODEL, lds + GEMM_LDS_OFF); }
    else
    for (int u = wgid_v(lds); u < nfull; u += G) { moe_decode8(tb, u, e, mt, nt); SCAL3(e, mt, nt);
        const int eb = PROBE >= 2 ? 0 : e, ntb = PROBE >= 2 ? 0 : nt, ea = PROBE >= 3 ? 0 : e, mta = PROBE >= 3 ? 0 : mt;
        const size_t wo = ((size_t)layer * N_EXPERTS + eb) * D_MODEL * D_EXPERT; const int cnt = SCAL(tb->cnt[e]), rb = SCAL(tb->rbase[e]);
        gemm_tile256(AGather{p.xn, D_MODEL, p.list_tok + ea * LIST_CAP, mta * 256, PROBE >= 3 ? 256 : cnt}, BGateUp256{p.moe_w_gate + wo, (long long)(p.moe_w_up - p.moe_w_gate), D_EXPERT, ntb * 128},
                     EpSiluMul256{hout, rb + mt * 256, nt * 128}, D_MODEL, lds + GEMM_LDS_OFF, moe_rowmask(cnt, mt)); }
    for (int j = wgid_v(lds); j < 2 * (T - nfull); j += G) { moe_decode8(tb, nfull + (j >> 1), e, mt, nt); const int n2 = 2 * nt + (j & 1);
        const int eb = PROBE >= 2 ? 0 : e, n2b = PROBE >= 2 ? 0 : n2, ea = PROBE >= 3 ? 0 : e, mta = PROBE >= 3 ? 0 : mt;
        const size_t wo = ((size_t)layer * N_EXPERTS + eb) * D_MODEL * D_EXPERT; const int cnt = tb->cnt[e];
        gemm_tile(AGather{p.xn, D_MODEL, p.list_tok + ea * LIST_CAP, mta * 256, PROBE >= 3 ? 256 : cnt}, BGateUp{p.moe_w_gate + wo, (long long)(p.moe_w_up - p.moe_w_gate), D_EXPERT, n2b * 64},
                  EpSiluMul{hout, tb->rbase[e] + mt * 256, n2 * 64}, D_MODEL, lds + GEMM_LDS_OFF, moe_rowmask(cnt, mt)); }
    __syncthreads();
}
__device__ __forceinline__ void phase_moe_down_direct(CParams& p, const int layer, char* lds) {
    MoeTab* tb = (MoeTab*)lds; (void)layer;
    const int T = tb->ustart[32] / 2, G = gridDim.x, nfull = (2 * (T % G) > G) ? T : (T / G) * G;
    int e, mt, nt;
    { DownUnits un{p, tb, layer, wgid_v(lds), G, nfull, ARows{}, BPlain256{}, EpScaleRow256{}, 0u}; gemm_tile256_seq(un, D_EXPERT, lds + GEMM_LDS_OFF); }
    for (int j = wgid_v(lds); j < 2 * (T - nfull); j += G) { moe_decode8(tb, nfull + (j >> 1), e, mt, nt); const int n2 = 2 * nt + (j & 1);
        const size_t wo = ((size_t)layer * N_EXPERTS + e) * D_EXPERT * D_MODEL; const int cnt = tb->cnt[e], r0 = tb->rbase[e] + mt * 256;
        gemm_tile(ARows{p.hmid, D_EXPERT, r0, tb->rbase[e] + cnt}, BPlain{p.moe_w_down + wo, D_MODEL, n2 * 128, D_MODEL},
                  EpScaleRow{p.ybuf, p.list_w + e * LIST_CAP, mt * 256, cnt, r0, n2 * 128}, D_EXPERT, lds + GEMM_LDS_OFF, moe_rowmask(cnt, mt)); }
    __syncthreads();
}
__device__ __forceinline__ bool moe_decode8(const MoeTab* tb, int u, int& e, int& mt, int& nt) {
    if (2 * u >= tb->ustart[32]) return false;
    { const int l = tidx() & 63; const int us = tb->ustart[l < 32 ? l : 32];
      const unsigned long long m = __ballot(l < 32 && 2 * u >= us);
      e = 63 - __builtin_clzll(m); }
    const int loc = u - tb->ustart[e] / 2, tiles = (tb->cnt[e] + 255) >> 8;
    nt = loc / tiles; mt = loc - nt * tiles; return true;
}
__device__ __forceinline__ void phase_moe_up(CParams& p, const int layer, char* lds) {
    MoeTab* tb = (MoeTab*)lds; moe_tables(p.cnt + layer * 32, tb);
    int e, mt, nt; int it = 0; const int myslot = blockIdx.x & 1;
    for (int u = blockIdx.x; moe_decode8(tb, u, e, mt, nt); u += gridDim.x, ++it) {
        if (CONV_MODE == 1 && it == myslot) moe_convert<2>(p, layer * 32, layer * 32 + 32, lds + 1024);
        const int cnt = tb->cnt[e]; const int* list = p.list_tok + e * LIST_CAP;
        unsigned ao[2][2], bo[2];
        { const int tid = tidx();
#pragma unroll
          for (int i = 0; i < 2; ++i) { int R, C; stage_rc(tid * 16 + i * 8192, R, C);
#pragma unroll
              for (int h = 0; h < 2; ++h) { const int g = mt * 256 + h * 128 + R; const int tok = g < cnt ? list[g] : 0; ao[h][i] = (unsigned)(tok * D_MODEL + C); } } }
        g8_offsets2(bo, nt * 256, D_MODEL);
        gemm8_unit<true>(p.xn, ao, D_MODEL, p.wgu_t + (size_t)(layer * N_EXPERTS + e) * 2048 * 2048, bo, D_MODEL, lds + GEMM_LDS_OFF,
                   E8SiluMul{p.hmid, tb->rbase[e] + mt * 256, nt * 128}, cnt - mt * 256 > 128); }
    if (CONV_MODE == 1 && myslot >= it) moe_convert<2>(p, layer * 32, layer * 32 + 32, lds + 1024);
    __syncthreads();
}
__device__ __forceinline__ void phase_moe_down(CParams& p, const int layer, char* lds) {
    MoeTab* tb = (MoeTab*)lds; moe_tables(p.cnt + layer * 32, tb);
    int e, mt, nt;
    for (int u = blockIdx.x; moe_decode8(tb, u, e, mt, nt); u += gridDim.x) {
        const int cnt = tb->cnt[e], r0 = tb->rbase[e] + mt * 256;
        unsigned ao[2][2], bo[2]; g8_offsets2(ao[0], r0, D_EXPERT); ao[1][0] = ao[1][1] = 0u; g8_offsets2(bo, nt * 256, D_EXPERT);
        gemm8_unit<false>(p.hmid, ao, D_EXPERT, p.wd_t + (size_t)(layer * N_EXPERTS + e) * 2048 * 1024, bo, D_EXPERT, lds + GEMM_LDS_OFF,
                   E8ScaleRow{p.ybuf, p.list_w + e * LIST_CAP, mt * 256, cnt, r0, nt * 256}, cnt - mt * 256 > 128); }
    __syncthreads();
}

#define NPHASE 18
template <int PH> __device__ __forceinline__ void run_phase(CParams& p, char* lds) {
    if (PH == 0) phase_first(p, lds);
    if (PH == 1) phase_qkv(p, lds);
    if (PH == 2) phase_diff_attn(p, lds);
    if (PH == 3) phase_oproj<false>(p, p.wt_a_out, p.x, p.h1, lds);
    if (PH == 4) phase_norm_route(p, p.h1, 0, lds);
    if (PH == 5) { if (MOE_G8) phase_moe_up(p, 0, lds); else phase_moe_up_direct(p, 0, lds); }
    if (PH == 6) { if (MOE_G8) phase_moe_down(p, 0, lds); else phase_moe_down_direct(p, 0, lds); }
    if (PH == 7) phase_combine<0>(p, p.h1, p.h2, p.attn_norm_w + D_MODEL, 0, lds);
    if (PH == 8) phase_proj(p, lds);
    if (PH == 9) phase_cmp1(p, lds);
    if (PH == 10) phase_cmp_reduce(p);
    if (PH == 11) phase_cmp2(p, lds);
    if (PH == 12) phase_nsa(p, lds);
    if (PH == 13) phase_oproj<true>(p, p.wt_b_out, p.h2, p.h1, lds);
    if (PH == 14) phase_norm_route(p, p.h1, 1, lds);
    if (PH == 15) { if (MOE_G8) phase_moe_up(p, 1, lds); else phase_moe_up_direct(p, 1, lds); }
    if (PH == 16) { if (MOE_G8) phase_moe_down(p, 1, lds); else phase_moe_down_direct(p, 1, lds); }
    if (PH == 17) phase_combine<1>(p, p.h1, nullptr, p.final_norm_w, 1, lds);
}
#if defined(ONLY_PH)
#define PHASE(PH) do { if (PH == ONLY_PH) { CParams* q_ = kp; asm volatile("" : "+s"(q_)); run_phase<PH>(*q_, lds); } } while (0)
#elif N_LAUNCH_MODE == 1
#ifndef DUP_MASK
#define DUP_MASK 0
#endif
#define PHASE(PH) do { { CParams* q_ = kp; asm volatile("" : "+s"(q_)); run_phase<PH>(*q_, lds); } \
        if ((DUP_MASK >> PH) & 1) { xcd_barrier(bar); CParams* q_ = kp; asm volatile("" : "+s"(q_)); run_phase<PH>(*q_, lds); } \
        if (PH + 1 < NPHASE) xcd_barrier(bar); } while (0)
#else
#define PHASE(PH) do { if (kp->phase_lo == PH) { CParams* q_ = kp; asm volatile("" : "+s"(q_)); run_phase<PH>(*q_, lds); } } while (0)
#endif
__global__ void __launch_bounds__(NTHREADS, 2) fwd_kernel(Params p_unused) {
    extern __shared__ __attribute__((aligned(16))) char lds[];
    CParams* kp = (CParams*)__builtin_amdgcn_kernarg_segment_ptr();
    if (threadIdx.x == 0) *(uint4*)(lds + LDS_BYTES - 16) = make_uint4(0u, 0u, 0u, 0u);
    __syncthreads();
    XcdBarrier bar = xcd_barrier_post(kp->bar, (volatile LAS unsigned*)(lds + LDS_BYTES - 16));
    (void)bar;
    PHASE(0);
#if N_LAUNCH_MODE == 1 && !defined(ONLY_PH)
    { volatile LAS unsigned* st_ = (volatile LAS unsigned*)(lds + LDS_BYTES - 16);
      if (threadIdx.x == 0) { unsigned base_ = 0u;
          _Pragma("unroll") for (unsigned j = 0; j < 16; ++j) { const unsigned c_ = xb_ld(&bar.bar[XB_XCNT(j)]); base_ += j < bar.x ? c_ : 0u; }
          st_[2] = base_ + bar.rank; }
      __syncthreads(); }
#endif
    PHASE(1); PHASE(2); PHASE(3); PHASE(4); PHASE(5);
#if defined(PROBE_UP) && N_LAUNCH_MODE == 1 && !defined(ONLY_PH)
    { CParams* q_ = kp; asm volatile("" : "+s"(q_)); phase_moe_up_direct<PROBE_UP>(*q_, 0, lds); xcd_barrier(bar); }
#endif
    PHASE(6); PHASE(7); PHASE(8);
    PHASE(9); PHASE(10); PHASE(11); PHASE(12); PHASE(13); PHASE(14); PHASE(15); PHASE(16); PHASE(17);
}

static inline size_t al256(size_t v) { return (v + 255) & ~(size_t)255; }
extern "C" void kernel_launch(void* const* d_in, const int* in_sizes, int n_in, void* d_out, int out_size, void* d_ws, size_t ws_size, hipStream_t stream) {
    (void)in_sizes; (void)n_in; (void)out_size; (void)ws_size;
    Params p; memset(&p, 0, sizeof(p));
    p.x = (const float*)d_in[0]; p.attn_norm_w = (const float*)d_in[1]; p.ffn_norm_w = (const float*)d_in[2]; p.final_norm_w = (const float*)d_in[3];
    p.a_w_in = (const float*)d_in[4]; p.a_lambda = (const float*)d_in[5]; p.a_subln_w = (const float*)d_in[6]; p.a_w_out = (const float*)d_in[7];
    p.b_w_in = (const float*)d_in[8]; p.b_cmp_pos = (const float*)d_in[9]; p.b_cmp_w1 = (const float*)d_in[10]; p.b_cmp_w2 = (const float*)d_in[11]; p.b_w_out = (const float*)d_in[12];
    p.moe_w_group = (const float*)d_in[13]; p.moe_b_group = (const float*)d_in[14]; p.moe_w_expert = (const float*)d_in[15]; p.moe_b_expert = (const float*)d_in[16];
    p.moe_w_gate = (const float*)d_in[17]; p.moe_w_up = (const float*)d_in[18]; p.moe_w_down = (const float*)d_in[19];
    p.out = (float*)d_out;
    char* w = (char*)d_ws; size_t off = 0;
#define CARVE(ptr, type, bytes) do { ptr = (type)(w + off); off = al256(off + (size_t)(bytes)); } while (0)
    CARVE(p.bar, unsigned*, XCD_BAR_WORDS * 4);
    CARVE(p.cnt, unsigned*, 128 * 4);
    CARVE(p.rw_hi, bf16_t*, (size_t)2 * 64 * D_MODEL * 2);
    CARVE(p.rw_lo, bf16_t*, (size_t)2 * 64 * D_MODEL * 2);
    CARVE(p.diag, unsigned*, 256 * 4);
    CARVE(p.xn, bf16_t*, (size_t)T_TOK * D_MODEL * 2);
    CARVE(p.qkv, bf16_t*, (size_t)T_TOK * A_IN * 2);
    CARVE(p.gate, float*, (size_t)T_TOK * 48 * 4);
    CARVE(p.attn_o, bf16_t*, (size_t)T_TOK * D_MODEL * 2);
    CARVE(p.h1, bf16_t*, (size_t)T_TOK * D_MODEL * 2);
    CARVE(p.h2, bf16_t*, (size_t)T_TOK * D_MODEL * 2);
    CARVE(p.hmid, bf16_t*, (size_t)MAX_ROWS * D_EXPERT * 2);
    CARVE(p.ybuf, bf16_t*, (size_t)MAX_ROWS * D_MODEL * 2);
    CARVE(p.list_tok, int*, (size_t)32 * LIST_CAP * 4);
    CARVE(p.list_w, float*, (size_t)32 * LIST_CAP * 4);
    CARVE(p.slot_ref, int*, (size_t)T_TOK * 2 * 4);
    CARVE(p.cbias, float*, 512 * 4);
    CARVE(p.cslab, float*, (size_t)8 * 2 * 2048 * 256 * 4);
    CARVE(p.chid, bf16_t*, (size_t)2 * 2048 * 256 * 2);
    CARVE(p.kvcmp, bf16_t*, (size_t)2 * 2048 * 128 * 2);
    CARVE(p.wt_a_in, bf16_t*, (size_t)A_IN * D_MODEL * 2);
    CARVE(p.wt_a_out, bf16_t*, (size_t)D_MODEL * D_MODEL * 2);
    CARVE(p.wt_b_in, bf16_t*, (size_t)5376 * D_MODEL * 2);
    CARVE(p.wt_b_out, bf16_t*, (size_t)D_MODEL * D_MODEL * 2);
    CARVE(p.wgu_t, bf16_t*, (size_t)64 * 2048 * 2048 * 2);
    CARVE(p.wd_t, bf16_t*, (size_t)64 * 2048 * 1024 * 2);
    static int grid = 0;
    if (!grid) {
        (void)hipFuncSetAttribute((const void*)fwd_kernel, hipFuncAttributeMaxDynamicSharedMemorySize, LDS_BYTES);
        int dev = 0, cus = 0, per_cu = 0;
        (void)hipGetDevice(&dev);
        if (hipDeviceGetAttribute(&cus, hipDeviceAttributeMultiprocessorCount, dev) != hipSuccess || cus <= 0) cus = 256;
        if (hipOccupancyMaxActiveBlocksPerMultiprocessor(&per_cu, (const void*)fwd_kernel, NTHREADS, LDS_BYTES) != hipSuccess || per_cu < 1) per_cu = 1;
        grid = cus * 1;
        if (grid > 256) grid = 256;
    }
    (void)hipMemsetAsync(p.bar, 0, XCD_BAR_WORDS * 4, stream);
#if N_LAUNCH_MODE == 1
    p.phase_lo = 0; p.phase_hi = NPHASE;
    hipLaunchKernelGGL(fwd_kernel, dim3(grid), dim3(NTHREADS), LDS_BYTES, stream, p);
#else
    for (int ph = 0; ph < NPHASE; ++ph) { p.phase_lo = ph; p.phase_hi = ph + 1; hipLaunchKernelGGL(fwd_kernel, dim3(grid), dim3(NTHREADS), LDS_BYTES, stream, p); }
#endif
}
```

```cpp
#include <hip/hip_runtime.h>
#include <stdint.h>
#include <stdio.h>
#include <string.h>

#ifndef CONV_MODE
#define CONV_MODE 2
#endif
#ifndef MOE_G8
#define MOE_G8 0
#endif
#ifndef PP_MODE
#define PP_MODE 1
#endif
#ifndef N_LAUNCH_MODE
#define N_LAUNCH_MODE 1
#endif

#define D_MODEL 2048
#define BATCH 2
#define SEQ 4096
#define T_TOK (BATCH * SEQ)
#define A_HEADS 8
#define A_IN 6144
#define B_HEADS 16
#define B_GROUPS 4
#define B_IN 5168
#define B_MAIN 5120
#define NC 255
#define N_EXPERTS 32
#define D_EXPERT 1024
#define LIST_CAP 8192
#define MAX_ROWS (16384 + 32 * 256)
#define EPS 1e-6f

typedef unsigned short bf16_t;
typedef short bf16x8 __attribute__((ext_vector_type(8)));
typedef short s16x4 __attribute__((ext_vector_type(4)));
typedef float f32x4 __attribute__((ext_vector_type(4)));
typedef float f32x16 __attribute__((ext_vector_type(16)));
typedef unsigned u32x4 __attribute__((ext_vector_type(4)));
typedef unsigned u32x2 __attribute__((ext_vector_type(2)));

#define NTHREADS 512
#define LDS_BYTES (160 * 1024 - 256)

__device__ __forceinline__ unsigned cvtpk(float lo, float hi) {
    unsigned r; asm volatile("v_cvt_pk_bf16_f32 %0, %1, %2" : "=v"(r) : "v"(lo), "v"(hi)); return r;
}
__device__ __forceinline__ float bf2f(bf16_t v) { return __uint_as_float(((unsigned)v) << 16); }
__device__ __forceinline__ bf16_t f2bf(float f) { return (bf16_t)(cvtpk(f, 0.f) & 0xffffu); }
__device__ __forceinline__ int tidx() { int t = threadIdx.x; asm volatile("" : "+v"(t)); return t; }
template <int O> __device__ __forceinline__ int shx_i(int v) {
    if constexpr (O < 32) return __builtin_amdgcn_ds_swizzle(v, (O << 10) | 0x1f);
    else { const int l = tidx(); return __builtin_amdgcn_ds_bpermute(((l & 63) ^ 32) << 2, v); }
}
template <int O> __device__ __forceinline__ float shx(float v) { return __int_as_float(shx_i<O>(__float_as_int(v))); }
__device__ __forceinline__ float wave_sum(float v) {
    v += shx<32>(v); v += shx<16>(v); v += shx<8>(v); v += shx<4>(v); v += shx<2>(v); v += shx<1>(v);
    return v;
}

#define XB_TMO      128
#define XB_XCNT(j)  (256  + 64 * (j))
#define XB_XSUB(j)  (1280 + 64 * (j))
#define XB_XGEN(j)  (2304 + 64 * (j))
#define XB_TOP      3328
#define XB_TOPGEN   3392
#define XCD_BAR_WORDS 3456
#define XB_SPIN_CAP (1u << 22)
#define LAS __attribute__((address_space(3)))

__device__ __forceinline__ unsigned xb_ld(unsigned* p)              { return __hip_atomic_load(p, __ATOMIC_RELAXED, __HIP_MEMORY_SCOPE_AGENT); }
__device__ __forceinline__ unsigned xb_add(unsigned* p, unsigned v) { return __hip_atomic_fetch_add(p, v, __ATOMIC_RELAXED, __HIP_MEMORY_SCOPE_AGENT); }
__device__ __forceinline__ unsigned xb_xcc_id() { return (unsigned)__builtin_amdgcn_s_getreg((3 << 11) | 20) & 0xFu; }
#define XB_SPIN(cond, bar) do { unsigned _sp = 0; while (cond) { __builtin_amdgcn_s_sleep(1); \
    if ((++_sp & 255u) == 0u) { if (xb_ld(&(bar)[XB_TMO])) break; if (_sp > XB_SPIN_CAP) { atomicAdd(&(bar)[XB_TMO], 1u); break; } } } } while (0)

struct XcdBarrier { unsigned* bar; unsigned x; volatile LAS unsigned* st; unsigned rank; };

__device__ __forceinline__ XcdBarrier xcd_barrier_post(unsigned* bar, volatile LAS unsigned* st) {
    XcdBarrier b; b.bar = bar; b.x = xb_xcc_id(); b.st = st; b.rank = 0u;
    if (threadIdx.x == 0) b.rank = xb_add(&bar[XB_XCNT(b.x)], 1u);
    return b;
}
__device__ __forceinline__ void xcd_barrier_complete(unsigned* bar, unsigned x, unsigned& nloc, unsigned& nx) {
    const unsigned G = gridDim.x * gridDim.y * gridDim.z;
    unsigned sum, cnt, mine, sp = 0u;
    for (;;) {
        sum = 0u; cnt = 0u; mine = 0u;
#pragma unroll
        for (unsigned j = 0; j < 16; ++j) { const unsigned c = xb_ld(&bar[XB_XCNT(j)]); sum += c; cnt += (c > 0u) ? 1u : 0u; mine = (j == x) ? c : mine; }
        if (sum == G) break;
        __builtin_amdgcn_s_sleep(1);
        if ((++sp & 255u) == 0u) { if (xb_ld(&bar[XB_TMO])) break; if (sp > XB_SPIN_CAP) { atomicAdd(&bar[XB_TMO], 1u); break; } }
    }
    nloc = mine > 0u ? mine : 1u; nx = cnt > 0u ? cnt : 1u;
}
__device__ __forceinline__ void xcd_barrier(const XcdBarrier& b) {
    asm volatile("s_waitcnt vmcnt(0)" ::: "memory");
    __syncthreads();
    if (threadIdx.x == 0) {
        unsigned* bar = b.bar;
        __builtin_amdgcn_s_waitcnt(0);
        unsigned nloc = b.st[0], nx = b.st[1];
        if (nloc == 0u) { xcd_barrier_complete(bar, b.x, nloc, nx); b.st[0] = nloc; b.st[1] = nx; }
        const unsigned old = xb_add(&bar[XB_XSUB(b.x)], 1u);
        const unsigned gen = old / nloc;
        if (old + 1u == (gen + 1u) * nloc) {
            __builtin_amdgcn_fence(__ATOMIC_RELEASE, "agent");
            asm volatile("s_waitcnt vmcnt(0)" ::: "memory");
            const unsigned og = xb_add(&bar[XB_TOP], 1u);
            const unsigned tg = og / nx;
            if (og + 1u == (tg + 1u) * nx) xb_add(&bar[XB_TOPGEN], 1u);
            else XB_SPIN(xb_ld(&bar[XB_TOPGEN]) == tg, bar);
            __builtin_amdgcn_fence(__ATOMIC_ACQUIRE, "agent");
            xb_add(&bar[XB_XGEN(b.x)], 1u);
            asm volatile("s_waitcnt vmcnt(0)" ::: "memory");
        } else {
            XB_SPIN(xb_ld(&bar[XB_XGEN(b.x)]) == gen, bar);
            __builtin_amdgcn_fence(__ATOMIC_ACQUIRE, "agent");
            asm volatile("s_waitcnt vmcnt(0)" ::: "memory");
        }
    }
    __syncthreads();
}

__device__ __forceinline__ int wgid_v(char* lds);
struct Params {
    const float* x; const float* attn_norm_w; const float* ffn_norm_w; const float* final_norm_w;
    const float* a_w_in; const float* a_lambda; const float* a_subln_w; const float* a_w_out;
    const float* b_w_in; const float* b_cmp_pos; const float* b_cmp_w1; const float* b_cmp_w2; const float* b_w_out;
    const float* moe_w_group; const float* moe_b_group; const float* moe_w_expert; const float* moe_b_expert;
    const float* moe_w_gate; const float* moe_w_up; const float* moe_w_down;
    float* out;
    unsigned* bar;
    unsigned* cnt;
    bf16_t* xn;
    bf16_t* qkv;
    float* gate;
    bf16_t* attn_o;
    bf16_t* h1;
    bf16_t* h2;
    bf16_t* rw_hi;
    bf16_t* rw_lo;
    bf16_t* hmid;
    bf16_t* ybuf;
    int* list_tok;
    float* list_w;
    int* slot_ref;
    float* cbias;
    float* cslab;
    bf16_t* chid;
    bf16_t* kvcmp;
    bf16_t* wt_a_in; bf16_t* wt_a_out; bf16_t* wt_b_in; bf16_t* wt_b_out;
    bf16_t* wgu_t; bf16_t* wd_t;
    unsigned* diag;
    int phase_lo, phase_hi;
};
typedef const __attribute__((address_space(4))) Params CParams;

__device__ __forceinline__ int lds_byte(int r, int c) { const int st = (r >> 4) * 2 + (c >> 5), rr = r & 15, cc = c & 31, ob = rr * 64 + cc * 2; return st * 1024 + (ob ^ (((ob >> 9) & 1) << 5)); }

#define G_BM 256
#define G_BN 128
#define G_BK 64
#define G_ABYTES (G_BM * G_BK * 2)
#define G_BBYTES (G_BN * G_BK * 2)
#define G_BUF (G_ABYTES + G_BBYTES)

template <bool LIGHT = false, class AF, class BF, class EP>
__device__ __forceinline__ void gemm_tile(const AF& af, const BF& bf, const EP& ep, const int K, char* lds, const unsigned rowmask  ) {
    const int tid = tidx(), wid = tid >> 6, lane = tid & 63, wr = wid >> 1, wc = wid & 1, fr = lane & 15, fq = lane >> 4;
    f32x4 acc[4][4];
#pragma unroll
    for (int m = 0; m < 4; ++m)
#pragma unroll
        for (int n = 0; n < 4; ++n) acc[m][n] = (f32x4){0.f, 0.f, 0.f, 0.f};
    const int a_r0 = tid >> 3, a_kc = (tid & 7) * 8;
    const bf16_t* ap[4]; unsigned avm = 0u;
#pragma unroll
    for (int i = 0; i < 4; ++i) { ap[i] = af.a_row(a_r0 + 64 * i); if (ap[i]) avm |= 1u << i; else ap[i] = af.safe(); }
    const int b_nb = (lane & 7) + 8 * (wid >> 1), b_kb = (lane >> 3) + 8 * (wid & 1);
    const float* bp = bf.colptr(4 * b_nb); const bool bvm = bp != nullptr; if (!bvm) bp = bf.safe();
    const bf16_t* bt16 = bf.bt16();
    const size_t ldb = bf.ldb;
    u32x4 ar0[4], ar1[4], ar2[4]; f32x4 br0[4], br1[4], br2[4];
    const int nk = K / G_BK;
    const bool act = (rowmask >> wr) & 1u;
    const int sa_base = lds_byte(a_r0, a_kc), sb_base = lds_byte(4 * b_nb, 4 * b_kb);
    const int fa_base = lds_byte(wr * 64 + fr, fq * 8), fb_base = lds_byte(wc * 64 + fr, fq * 8);

#define G_LOAD(kt, AR, BR) do { const int k0_ = (kt) * G_BK; const int ko_ = af.koff(k0_) + a_kc; \
        _Pragma("unroll") for (int i = 0; i < 4; ++i) AR[i] = *(const u32x4*)(ap[i] + ko_); \
        if (BF::IS_BF16) { _Pragma("unroll") for (int i = 0; i < 2; ++i) BR[i] = *(const f32x4*)(bt16 + (size_t)(a_r0 + 64 * i) * ldb + k0_ + a_kc); } \
        else { _Pragma("unroll") for (int i = 0; i < 4; ++i) BR[i] = *(const f32x4*)(bp + (size_t)(k0_ + 4 * b_kb + i) * ldb); } } while (0)
#define G_STORE(kt, AR, BR) do { char* A_ = lds + ((kt) & 1) * G_BUF; char* B_ = A_ + G_ABYTES; \
        _Pragma("unroll") for (int i = 0; i < 4; ++i) *(u32x4*)(A_ + sa_base + i * 8192) = ((avm >> i) & 1u) ? AR[i] : (u32x4){0u, 0u, 0u, 0u}; \
        _Pragma("unroll") for (int j = 0; j < 4; ++j) { u32x2 w_; w_.x = cvtpk(BR[0][j], BR[1][j]); w_.y = cvtpk(BR[2][j], BR[3][j]); if (!bvm) { w_.x = 0u; w_.y = 0u; } \
            *(u32x2*)(B_ + sb_base + j * 64) = w_; } } while (0)
#define G_COMPUTE(kt) do { if (act) { const char* A_ = lds + ((kt) & 1) * G_BUF; const char* B_ = A_ + G_ABYTES; \
        _Pragma("unroll") for (int ks = 0; ks < 2; ++ks) { bf16x8 a[4], b[4]; \
            _Pragma("unroll") for (int m = 0; m < 4; ++m) a[m] = *(const bf16x8*)(A_ + fa_base + m * 2048 + ks * 1024); \
            _Pragma("unroll") for (int n = 0; n < 4; ++n) b[n] = *(const bf16x8*)(B_ + fb_base + n * 2048 + ks * 1024); \
            _Pragma("unroll") for (int m = 0; m < 4; ++m) _Pragma("unroll") for (int n = 0; n < 4; ++n) \
                acc[m][n] = __builtin_amdgcn_mfma_f32_16x16x32_bf16(b[n], a[m], acc[m][n], 0, 0, 0); } } } while (0)
#define G_STEP(kt, ARc, BRc, ARn, BRn) do { G_LOAD((kt) + 3, ARc, BRc); G_COMPUTE(kt); G_STORE((kt) + 1, ARn, BRn); __syncthreads(); } while (0)
#define G_TAIL(kt, ARn, BRn) do { if ((kt) < nk) { G_COMPUTE(kt); if ((kt) + 1 < nk) G_STORE((kt) + 1, ARn, BRn); __syncthreads(); } } while (0)

    if (LIGHT) {
        G_LOAD(0, ar0, br0); G_STORE(0, ar0, br0); __syncthreads();
        for (int k1 = 0; k1 < nk; ++k1) { if (k1 + 1 < nk) G_LOAD(k1 + 1, ar0, br0); G_COMPUTE(k1); if (k1 + 1 < nk) G_STORE(k1 + 1, ar0, br0); __syncthreads(); }
        if (act) ep(acc, wr, wc, fr, fq);
        __syncthreads();
        return;
    }
#if PP_MODE == 0
    G_LOAD(0, ar0, br0); G_LOAD(1, ar1, br1); G_LOAD(2, ar2, br2);
    G_STORE(0, ar0, br0);
    __syncthreads();
    { int kt = 0;
      for (; kt + 5 < nk; kt += 3) { G_STEP(kt, ar0, br0, ar1, br1); G_STEP(kt + 1, ar1, br1, ar2, br2); G_STEP(kt + 2, ar2, br2, ar0, br0); }
      if (kt + 3 < nk) G_LOAD(kt + 3, ar0, br0);
      G_COMPUTE(kt); if (kt + 1 < nk) G_STORE(kt + 1, ar1, br1); __syncthreads();
      if (kt + 4 < nk) G_LOAD(kt + 4, ar1, br1);
      G_TAIL(kt + 1, ar2, br2); G_TAIL(kt + 2, ar0, br0); G_TAIL(kt + 3, ar1, br1); G_TAIL(kt + 4, ar2, br2); }
#else
#define PP_STAGE(t) (lds + ((t) % 3) * G_BUF)
#define PP_STORE(t, AR, BR) do { char* A_ = PP_STAGE(t); char* B_ = A_ + G_ABYTES; \
        _Pragma("unroll") for (int i = 0; i < 4; ++i) *(u32x4*)(A_ + sa_base + i * 8192) = ((avm >> i) & 1u) ? AR[i] : (u32x4){0u, 0u, 0u, 0u}; \
        if (BF::IS_BF16) { _Pragma("unroll") for (int i = 0; i < 2; ++i) *(f32x4*)(B_ + sa_base + i * 8192) = BR[i]; } \
        else { _Pragma("unroll") for (int j = 0; j < 4; ++j) { u32x2 w_; w_.x = cvtpk(BR[0][j], BR[1][j]); w_.y = cvtpk(BR[2][j], BR[3][j]); if (!bvm) { w_.x = 0u; w_.y = 0u; } \
            *(u32x2*)(B_ + sb_base + j * 64) = w_; } } } while (0)
#define PP_READ(t, ks) do { if (act) { const char* A_ = PP_STAGE(t); const char* B_ = A_ + G_ABYTES; \
        _Pragma("unroll") for (int m = 0; m < 4; ++m) fa[m] = *(const bf16x8*)(A_ + fa_base + m * 2048 + (ks) * 1024); \
        _Pragma("unroll") for (int n = 0; n < 4; ++n) fb[n] = *(const bf16x8*)(B_ + fb_base + n * 2048 + (ks) * 1024); } } while (0)
#define PP_MMA() do { if (act) { __builtin_amdgcn_s_setprio(1); \
        _Pragma("unroll") for (int m = 0; m < 4; ++m) _Pragma("unroll") for (int n = 0; n < 4; ++n) \
            acc[m][n] = __builtin_amdgcn_mfma_f32_16x16x32_bf16(fb[n], fa[m], acc[m][n], 0, 0, 0); \
        __builtin_amdgcn_s_setprio(0); } } while (0)
#define PP_BAR() __builtin_amdgcn_s_barrier()
#define PP_WL() asm volatile("s_waitcnt lgkmcnt(0)" ::: "memory")
#define PP_STEP(kt, ARs, BRs, DOLOAD, DOSTORE) do { \
        PP_READ(kt, 0); PP_BAR(); PP_WL(); PP_MMA(); PP_BAR(); \
        PP_READ(kt, 1); if (DOSTORE) PP_STORE((kt) + 2, ARs, BRs); if (DOLOAD) G_LOAD((kt) + 5, ARs, BRs); PP_BAR(); PP_WL(); PP_MMA(); PP_BAR(); } while (0)
    bf16x8 fa[4], fb[4];
    const bool grp1 = wid >= 4;
    G_LOAD(0, ar0, br0); G_LOAD(1, ar1, br1); G_LOAD(2, ar2, br2);
    PP_STORE(0, ar0, br0); G_LOAD(3, ar0, br0);
    PP_STORE(1, ar1, br1); G_LOAD(4, ar1, br1);
    asm volatile("s_waitcnt lgkmcnt(0)" ::: "memory");
    __syncthreads();
    if (grp1) PP_BAR();
    int kt = 0;
    for (; kt + 7 < nk; kt += 3) {
        PP_STEP(kt, ar2, br2, true, true);
        PP_STEP(kt + 1, ar0, br0, true, true);
        PP_STEP(kt + 2, ar1, br1, true, true);
    }
#define PP_TAIL(kk, ARs, BRs) do { if ((kk) < nk) { const bool ld_ = (kk) + 5 < nk, st_ = (kk) + 2 < nk; \
        PP_READ(kk, 0); PP_BAR(); PP_WL(); PP_MMA(); PP_BAR(); \
        PP_READ(kk, 1); if (st_) PP_STORE((kk) + 2, ARs, BRs); if (ld_) G_LOAD((kk) + 5, ARs, BRs); PP_BAR(); PP_WL(); PP_MMA(); PP_BAR(); } } while (0)
    PP_TAIL(kt, ar2, br2); PP_TAIL(kt + 1, ar0, br0); PP_TAIL(kt + 2, ar1, br1);
    PP_TAIL(kt + 3, ar2, br2); PP_TAIL(kt + 4, ar0, br0); PP_TAIL(kt + 5, ar1, br1); PP_TAIL(kt + 6, ar2, br2);
    if (!grp1) PP_BAR();
#endif
#undef PP_STAGE
#undef PP_STORE
#undef PP_READ
#undef PP_MMA
#undef PP_BAR
#undef PP_WL
#undef PP_STEP
#undef PP_TAIL
#undef G_LOAD
#undef G_STORE
#undef G_COMPUTE
#undef G_STEP
#undef G_TAIL
    if (act) ep(acc, wr, wc, fr, fq);
    __syncthreads();
}

#define G2_BUF (G_ABYTES + 2 * G_BBYTES)
__device__ __forceinline__ void stage_rc(int b, int& R, int& C);
__device__ __forceinline__ void glds16_asm(const void* gsrc, unsigned lds_dst) {
    unsigned keep;
    asm volatile("s_mov_b32 %0, m0\n\ts_mov_b32 m0, %2\n\ts_nop 0\n\tglobal_load_lds_dwordx4 %1, off\n\ts_mov_b32 m0, %0" : "=&s"(keep) : "v"(gsrc), "s"(lds_dst) : "memory");
}
__device__ __forceinline__ void glds16_asm_s(const void* sbase, unsigned voff, unsigned lds_dst) {
    unsigned keep;
    asm volatile("s_mov_b32 %0, m0\n\ts_mov_b32 m0, %3\n\ts_nop 0\n\tglobal_load_lds_dwordx4 %1, %2\n\ts_mov_b32 m0, %0" : "=&s"(keep) : "v"(voff), "s"(sbase), "s"(lds_dst) : "memory");
}
template <class AF, class BF, class EP>
__device__ __forceinline__ void gemm_tile256(const AF& af, const BF& bf, const EP& ep, const int K, char* lds, const unsigned rowmask) {
    const int tid = tidx(), wid = __builtin_amdgcn_readfirstlane(tid >> 6), lane = tid & 63, wr = wid >> 1, wc = wid & 1, fr = lane & 15, fq = lane >> 4;
    f32x4 acc[4][8];
#pragma unroll
    for (int m = 0; m < 4; ++m)
#pragma unroll
        for (int n = 0; n < 8; ++n) acc[m][n] = (f32x4){0.f, 0.f, 0.f, 0.f};
    const bf16_t* abase = af.safe(); unsigned aoff[4];
#pragma unroll
    for (int i = 0; i < 4; ++i) { int R, C; stage_rc(tid * 16 + (i & 1) * 8192, R, C);
        aoff[i] = 2u * (af.a_off((i >> 1) * 128 + R) + (unsigned)C); }
    const unsigned lds_a = (unsigned)(uintptr_t)lds + (unsigned)wid * 1024u;
    const int b_nl = (lane & 3) + 4 * ((lane >> 5) & 1), b_kl = ((lane >> 2) & 3) + 4 * ((lane >> 4) & 1);
    const size_t ldb = bf.ldb;
    const unsigned boff = (unsigned)((4 * (b_kl + 8 * (wid & 1))) * (int)ldb + 4 * (b_nl + 8 * (wid >> 1))) * 4u;
    const __amdgpu_buffer_rsrc_t rs0 = __builtin_amdgcn_make_buffer_rsrc((void*)bf.base(0), 0, 0x7fffffff, 0x00020000);
    const __amdgpu_buffer_rsrc_t rs1 = __builtin_amdgcn_make_buffer_rsrc((void*)bf.base(1), 0, 0x7fffffff, 0x00020000);
    const unsigned lpk = (unsigned)lds_byte(lane & 15, (lane >> 4) * 8) | ((unsigned)lds_byte((lane & 15) ^ ((lane >> 2) & 1), (lane >> 4) * 8) << 10)
                       | ((unsigned)(lds_byte(4 * b_nl, 4 * b_kl) + (lane & 1) * 64) << 20);
    const int s_fa = (wid >> 1) * 8192, s_fb = (wid & 1) * 16384, s_sb = lds_byte(BF::wrow(wid >> 1), 32 * (wid & 1));
    f32x4 br[8];
    const int nk = K / G_BK;
    const bool act = __builtin_amdgcn_readfirstlane((int)((rowmask >> wr) & 1u)) != 0;
#define G2_SB() ((int)(lpk >> 20) + s_sb)
#define G2_SB1(sb0_) ((sb0_) ^ 64)
#define G2_FA() ((int)(lpk & 1023u) + s_fa)
#define G2_FB() ((int)((lpk >> 10) & 1023u) + s_fb)
#define G2_ADMA(kt) do { const int ko_ = af.koff((kt) * G_BK); const unsigned d_ = lds_a + (unsigned)(((kt) & 1) * G2_BUF); \
        _Pragma("unroll") for (int i = 0; i < 4; ++i) glds16_asm_s(abase + ko_, aoff[i], d_ + (unsigned)(i * 8192)); } while (0)
#define G2_BLOADH(kt, hh) do { const int so_ = (kt) * G_BK * (int)ldb * 4; \
        _Pragma("unroll") for (int i = 0; i < 4; ++i) br[4 * (hh) + i] = __builtin_bit_cast(f32x4, __builtin_amdgcn_raw_buffer_load_b128((hh) ? rs1 : rs0, (int)boff, so_ + i * (int)ldb * 4, 0)); } while (0)
#define G2_PIECE(Bw_, sb_, sb1_, pc) do { u32x2 w_; \
        w_.x = cvtpk(br[4 * ((pc) >> 2) + 0][(pc) & 3], br[4 * ((pc) >> 2) + 1][(pc) & 3]); w_.y = cvtpk(br[4 * ((pc) >> 2) + 2][(pc) & 3], br[4 * ((pc) >> 2) + 3][(pc) & 3]); \
        *(u32x2*)(Bw_ + (((pc) & 1) ? sb1_ : sb_) + ((pc) >> 2) * (BF::HROW * 128) + (((pc) >> 1) & 1) * 128) = w_; } while (0)
#define G2_BSTORE(kt) do { char* Bw_ = lds + ((kt) & 1) * G2_BUF + G_ABYTES; const int sb_ = G2_SB(), sb1_ = G2_SB1(sb_); \
        _Pragma("unroll") for (int pc = 0; pc < 8; ++pc) G2_PIECE(Bw_, sb_, sb1_, pc); } while (0)
#define G2_COMPUTE(kt, ST, RL, ACT, DMA) do { char* Bw_ = lds + (((kt) + 1) & 1) * G2_BUF + G_ABYTES; const int sb_ = (ST) ? G2_SB() : 0, sb1_ = (ST) ? G2_SB1(sb_) : 0; \
        const char* A_ = lds + ((kt) & 1) * G2_BUF; const char* B_ = A_ + G_ABYTES; const int fa_base = (ACT) ? G2_FA() : 0, fb_base = (ACT) ? G2_FB() : 0; \
        bf16x8 a[4], bc; \
        if (ACT) { _Pragma("unroll") for (int m = 0; m < 4; ++m) a[m] = *(const bf16x8*)(A_ + fa_base + m * 2048); \
                   bc = *(const bf16x8*)(B_ + fb_base); } \
        if (DMA) G2_ADMA((kt) + 1);                                  \
        __builtin_amdgcn_sched_barrier(0); \
        _Pragma("unroll") for (int ks = 0; ks < 2; ++ks) { \
            _Pragma("unroll") for (int n = 0; n < 8; ++n) { \
                if (ACT) { const bf16x8 bn = bc; \
                    if (n < 7) bc = *(const bf16x8*)(B_ + fb_base + (n + 1) * 2048 + ks * 1024); \
                    else if (ks == 0) bc = *(const bf16x8*)(B_ + fb_base + 1024); \
                    __builtin_amdgcn_s_setprio(1); \
                    _Pragma("unroll") for (int m = 0; m < 4; ++m) { acc[m][n] = __builtin_amdgcn_mfma_f32_16x16x32_bf16(bn, a[m], acc[m][n], 0, 0, 0); \
                        if (ks == 0 && n == 7) { __builtin_amdgcn_sched_barrier(0); a[m] = *(const bf16x8*)(A_ + fa_base + m * 2048 + 1024); } }     \
                    __builtin_amdgcn_s_setprio(0); } \
                if ((ST) && (n & 1)) G2_PIECE(Bw_, sb_, sb1_, ks * 4 + (n >> 1)); \
                if ((RL) && n == 7) G2_BLOADH((kt) + 2, ks); \
                __builtin_amdgcn_sched_barrier(0); } } } while (0)
    G2_ADMA(0); G2_BLOADH(0, 0); G2_BLOADH(0, 1);
    G2_BSTORE(0);
    __builtin_amdgcn_sched_barrier(0);
    if (nk > 1) { G2_BLOADH(1, 0); G2_BLOADH(1, 1); asm volatile("s_waitcnt vmcnt(8)" ::: "memory"); }
    else asm volatile("s_waitcnt vmcnt(0)" ::: "memory");
    __syncthreads();
#define G2_LOOP(ACT) do { int kt = 0; \
    for (; kt + 2 < nk; ++kt) { G2_COMPUTE(kt, 1, 1, ACT, 1); asm volatile("s_waitcnt vmcnt(8)" ::: "memory"); __syncthreads(); } \
    if (kt + 1 < nk) { G2_COMPUTE(kt, 1, 0, ACT, 1); asm volatile("s_waitcnt vmcnt(0)" ::: "memory"); __syncthreads(); ++kt; } \
    G2_COMPUTE(kt, 0, 0, ACT, 0); \
    __syncthreads(); } while (0)
    if (act) G2_LOOP(1); else G2_LOOP(0);
#undef G2_LOOP
#undef G2_BLOADH
#undef G2_PIECE
#undef G2_SB
#undef G2_SB1
#undef G2_FA
#undef G2_FB
#undef G2_ADMA
#undef G2_BSTORE
#undef G2_COMPUTE
    { const int l2_ = tidx() & 63; if (act) ep(acc, wr, wc, l2_ & 15, l2_ >> 4); }
    __syncthreads();
}
template <class UN>
__device__ __forceinline__ void gemm_tile256_seq(UN& un, const int K, char* lds) {
    typedef typename UN::BFT BF;
    const int tid = tidx(), wid = __builtin_amdgcn_readfirstlane(tid >> 6), lane = tid & 63, wr = wid >> 1, wc = wid & 1, fr = lane & 15, fq = lane >> 4;
    f32x4 acc[4][8];
    const bf16_t* abase = nullptr; unsigned aoff[4] = {0u, 0u, 0u, 0u};
    const unsigned lds_a = (unsigned)(uintptr_t)lds + (unsigned)wid * 1024u;
    const int b_nl = (lane & 3) + 4 * ((lane >> 5) & 1), b_kl = ((lane >> 2) & 3) + 4 * ((lane >> 4) & 1);
    const size_t ldb = UN::LDB;
    const int s_bo = ((32 * (wid & 1)) * (int)ldb + 32 * (wid >> 1)) * 4;
    __amdgpu_buffer_rsrc_t rs0 = __builtin_amdgcn_make_buffer_rsrc((void*)nullptr, 0, 0x7fffffff, 0x00020000), rs1 = rs0;
#define T2_SETUP() do { abase = un.af.safe(); \
        _Pragma("unroll") for (int i = 0; i < 4; ++i) { int R, C; stage_rc(tidx() * 16 + (i & 1) * 8192, R, C); aoff[i] = 2u * (un.af.a_off((i >> 1) * 128 + R) + (unsigned)C); } \
        rs0 = __builtin_amdgcn_make_buffer_rsrc((void*)un.bf.base(0), 0, 0x7fffffff, 0x00020000); rs1 = __builtin_amdgcn_make_buffer_rsrc((void*)un.bf.base(1), 0, 0x7fffffff, 0x00020000); } while (0)
    const unsigned lpk = (unsigned)lds_byte(lane & 15, (lane >> 4) * 8) | ((unsigned)lds_byte((lane & 15) ^ ((lane >> 2) & 1), (lane >> 4) * 8) << 10)
                       | ((unsigned)(lds_byte(4 * b_nl, 4 * b_kl) + (lane & 1) * 64) << 20);
    const int s_fa = (wid >> 1) * 8192, s_fb = (wid & 1) * 16384, s_sb = lds_byte(BF::wrow(wid >> 1), 32 * (wid & 1));
    f32x4 br[8];
    const int nk = K / G_BK;
#define G2_SB() ((int)(lpk >> 20) + s_sb)
#define G2_SB1(sb0_) ((sb0_) ^ 64)
#define G2_FA() ((int)(lpk & 1023u) + s_fa)
#define G2_FB() ((int)((lpk >> 10) & 1023u) + s_fb)
#define G2_ADMA(kt) do { const int ko_ = (kt) * G_BK; const unsigned d_ = lds_a + (unsigned)(((kt) & 1) * G2_BUF); \
        _Pragma("unroll") for (int i = 0; i < 4; ++i) glds16_asm_s(abase + ko_, aoff[i], d_ + (unsigned)(i * 8192)); } while (0)
#define G2_BLOADH(kt, hh) do { const int so_ = (kt) * G_BK * (int)ldb * 4 + s_bo; const int l_ = tidx() & 63; \
        const int bo_ = (((l_ >> 2) & 3) + 4 * ((l_ >> 4) & 1)) * (16 * (int)ldb) + ((l_ & 3) + 4 * ((l_ >> 5) & 1)) * 16;        \
        _Pragma("unroll") for (int i = 0; i < 4; ++i) br[4 * (hh) + i] = __builtin_bit_cast(f32x4, __builtin_amdgcn_raw_buffer_load_b128((hh) ? rs1 : rs0, bo_, so_ + i * (int)ldb * 4, 0)); } while (0)
#define G2_PIECE(Bw_, sb_, sb1_, pc) do { u32x2 w_; \
        w_.x = cvtpk(br[4 * ((pc) >> 2) + 0][(pc) & 3], br[4 * ((pc) >> 2) + 1][(pc) & 3]); w_.y = cvtpk(br[4 * ((pc) >> 2) + 2][(pc) & 3], br[4 * ((pc) >> 2) + 3][(pc) & 3]); \
        *(u32x2*)(Bw_ + (((pc) & 1) ? sb1_ : sb_) + ((pc) >> 2) * (BF::HROW * 128) + (((pc) >> 1) & 1) * 128) = w_; } while (0)
#define G2_BSTORE(kt) do { char* Bw_ = lds + ((kt) & 1) * G2_BUF + G_ABYTES; const int sb_ = G2_SB(), sb1_ = G2_SB1(sb_); \
        _Pragma("unroll") for (int pc = 0; pc < 8; ++pc) G2_PIECE(Bw_, sb_, sb1_, pc); } while (0)
#define G2_COMPUTE(kt, ST, RL, ACT, DMA) do { char* Bw_ = lds + (((kt) + 1) & 1) * G2_BUF + G_ABYTES; const int sb_ = (ST) ? G2_SB() : 0, sb1_ = (ST) ? G2_SB1(sb_) : 0; \
        const char* A_ = lds + ((kt) & 1) * G2_BUF; const char* B_ = A_ + G_ABYTES; const int fa_base = (ACT) ? G2_FA() : 0, fb_base = (ACT) ? G2_FB() : 0; \
        bf16x8 a[4], bc; \
        if (ACT) { _Pragma("unroll") for (int m = 0; m < 4; ++m) a[m] = *(const bf16x8*)(A_ + fa_base + m * 2048); \
                   bc = *(const bf16x8*)(B_ + fb_base); } \
        if (DMA) G2_ADMA((kt) + 1);                                  \
        __builtin_amdgcn_sched_barrier(0); \
        _Pragma("unroll") for (int ks = 0; ks < 2; ++ks) { \
            _Pragma("unroll") for (int n = 0; n < 8; ++n) { \
                if (ACT) { const bf16x8 bn = bc; \
                    if (n < 7) bc = *(const bf16x8*)(B_ + fb_base + (n + 1) * 2048 + ks * 1024); \
                    else if (ks == 0) bc = *(const bf16x8*)(B_ + fb_base + 1024); \
                    __builtin_amdgcn_s_setprio(1); \
                    _Pragma("unroll") for (int m = 0; m < 4; ++m) { acc[m][n] = __builtin_amdgcn_mfma_f32_16x16x32_bf16(bn, a[m], acc[m][n], 0, 0, 0); \
                        if (ks == 0 && n == 7) { __builtin_amdgcn_sched_barrier(0); a[m] = *(const bf16x8*)(A_ + fa_base + m * 2048 + 1024); } }     \
                    __builtin_amdgcn_s_setprio(0); } \
                if ((ST) && (n & 1)) G2_PIECE(Bw_, sb_, sb1_, ks * 4 + (n >> 1)); \
                if ((RL) && n == 7) G2_BLOADH((kt) + 2, ks); \
                __builtin_amdgcn_sched_barrier(0); } } } while (0)
#define G2_LOOP(ACT) do { int kt = 0; \
    for (; kt + 2 < nk; ++kt) { G2_COMPUTE(kt, 1, 1, ACT, 1); asm volatile("s_waitcnt vmcnt(8)" ::: "memory"); __syncthreads(); } \
    if (kt + 1 < nk) { G2_COMPUTE(kt, 1, 0, ACT, 1); asm volatile("s_waitcnt vmcnt(0)" ::: "memory"); __syncthreads(); ++kt; } \
    G2_COMPUTE(kt, 0, 0, ACT, 0); \
    __syncthreads(); } while (0)
    bool have = un.first();
    if (have) { T2_SETUP(); G2_ADMA(0); G2_BLOADH(0, 0); G2_BLOADH(0, 1); }
#pragma unroll 1
    while (have) {
        const typename UN::EPT ep = un.ep;
        const bool act = __builtin_amdgcn_readfirstlane((int)((un.rowmask >> wr) & 1u)) != 0;
#pragma unroll
        for (int m = 0; m < 4; ++m)
#pragma unroll
            for (int n = 0; n < 8; ++n) acc[m][n] = (f32x4){0.f, 0.f, 0.f, 0.f};
        G2_BSTORE(0);
        __builtin_amdgcn_sched_barrier(0);
        if (nk > 1) { G2_BLOADH(1, 0); G2_BLOADH(1, 1); asm volatile("s_waitcnt vmcnt(8)" ::: "memory"); }
        else asm volatile("s_waitcnt vmcnt(0)" ::: "memory");
        __syncthreads();
        if (act) G2_LOOP(1); else G2_LOOP(0);
        have = un.next();
        if (have) { T2_SETUP(); G2_ADMA(0); G2_BLOADH(0, 0); G2_BLOADH(0, 1); }
        __builtin_amdgcn_sched_barrier(0);
        { const int l2_ = tidx() & 63; if (act) ep(acc, wr, wc, l2_ & 15, l2_ >> 4); }
    }
    __syncthreads();
#undef G2_LOOP
#undef T2_SETUP
#undef G2_BLOADH
#undef G2_PIECE
#undef G2_SB
#undef G2_SB1
#undef G2_FA
#undef G2_FB
#undef G2_ADMA
#undef G2_BSTORE
#undef G2_COMPUTE
}
struct ARows {
    const bf16_t* base; int lda; int row0; int mlim;
    __device__ __forceinline__ const bf16_t* a_row(int r) const { const int g = row0 + r; return g < mlim ? base + (size_t)g * lda : nullptr; }
    __device__ __forceinline__ unsigned a_off(int r) const { const int g = row0 + r; return g < mlim ? (unsigned)g * (unsigned)lda : 0u; }
    __device__ __forceinline__ const bf16_t* safe() const { return base; }
    __device__ __forceinline__ int koff(int k0) const { return k0; }
};
struct AGather {
    const bf16_t* base; int lda; const int* list; int r0; int cnt;
    __device__ __forceinline__ const bf16_t* a_row(int r) const { const int g = r0 + r; return g < cnt ? base + (size_t)list[g] * lda : nullptr; }
    __device__ __forceinline__ unsigned a_off(int r) const { const int g = r0 + r; return g < cnt ? (unsigned)list[g] * (unsigned)lda : 0u; }
    __device__ __forceinline__ const bf16_t* safe() const { return base; }
    __device__ __forceinline__ int koff(int k0) const { return k0; }
};
struct ACompress {
    const bf16_t* src; int col0; int row0; int kbase;
    __device__ __forceinline__ const bf16_t* a_row(int r) const {
        const int g = row0 + r; const int b = g >> 10, c = (g >> 2) & 255, gg = g & 3;
        if (c >= NC) return nullptr;
        return src + ((size_t)(b * SEQ + 16 * c)) * B_MAIN + col0 + gg * 128;
    }
    __device__ __forceinline__ const bf16_t* safe() const { return src; }
    __device__ __forceinline__ int koff(int k0) const { const int k = kbase + k0; return (k >> 7) * B_MAIN + (k & 127); }
};
struct BPlain {           static constexpr bool IS_BF16 = false;
    const float* base; size_t ldb; int n0; int nlim;
    __device__ __forceinline__ const float* colptr(int nl) const { const int c = n0 + nl; return c < nlim ? base + c : nullptr; }
    __device__ __forceinline__ const float* safe() const { return base; }
    __device__ __forceinline__ const bf16_t* bt16() const { return nullptr; }
};
struct BGateUp {          static constexpr bool IS_BF16 = false;
    const float* wg; long long du; size_t ldb; int c0;
    __device__ __forceinline__ const float* colptr(int nl) const {
        const int wc = nl >> 6, q = (nl >> 4) & 3, w = nl & 15; const int col = c0 + wc * 32 + (q & 1) * 16 + w;
        return wg + (long long)(q >> 1) * du + col;
    }
    __device__ __forceinline__ const float* safe() const { return wg; }
    __device__ __forceinline__ const bf16_t* bt16() const { return nullptr; }
};

struct BGateUp256 {
    static constexpr int HROW = 64;
    const float* wg; long long du; size_t ldb; int c0;
    __device__ __forceinline__ const float* base(int hh) const { return wg + (hh ? du : 0ll) + c0; }
    static __device__ __forceinline__ int wrow(int wq) { return (wq >> 1) * 128 + (wq & 1) * 32; }
};
struct BPlain256 {
    static constexpr int HROW = 128;
    const float* wbase; size_t ldb; int n0;
    __device__ __forceinline__ const float* base(int hh) const { return wbase + n0 + 128 * hh; }
    static __device__ __forceinline__ int wrow(int wq) { return wq * 32; }
};
struct EpSiluMul256 {
    bf16_t* out; int row0; int c0;
    __device__ __forceinline__ void operator()(const f32x4 (&acc)[4][8], int wr, int wc, int fr, int fq) const {
#pragma unroll
        for (int m = 0; m < 4; ++m) { const int r = row0 + wr * 64 + m * 16 + fr;
#pragma unroll
            for (int n = 0; n < 4; ++n) { const int c = c0 + wc * 64 + n * 16 + fq * 4; float hh[4];
#pragma unroll
                for (int j = 0; j < 4; ++j) { const float g = acc[m][n][j]; hh[j] = g / (1.f + __expf(-g)) * acc[m][n + 4][j]; }
                u32x2 w; w.x = cvtpk(hh[0], hh[1]); w.y = cvtpk(hh[2], hh[3]);
                *(u32x2*)(out + (size_t)r * D_EXPERT + c) = w; } }
    }
};
struct EpScaleRow256 {
    bf16_t* out; const float* roww; int rw0; int cnt; int row0; int col0;
    __device__ __forceinline__ void operator()(const f32x4 (&acc)[4][8], int wr, int wc, int fr, int fq) const {
#pragma unroll
        for (int m = 0; m < 4; ++m) { const int rl = wr * 64 + m * 16 + fr; const float s = (rw0 + rl < cnt) ? roww[rw0 + rl] : 0.f; const int r = row0 + rl;
#pragma unroll
            for (int n = 0; n < 8; ++n) { const int c = col0 + wc * 128 + n * 16 + fq * 4;
                u32x2 w; w.x = cvtpk(acc[m][n][0] * s, acc[m][n][1] * s); w.y = cvtpk(acc[m][n][2] * s, acc[m][n][3] * s);
                *(u32x2*)(out + (size_t)r * D_MODEL + c) = w; } }
    }
};
struct BBf16T {           static constexpr bool IS_BF16 = true;
    const bf16_t* base; size_t ldb; int n0;
    __device__ __forceinline__ const float* colptr(int) const { return nullptr; }
    __device__ __forceinline__ const float* safe() const { return nullptr; }
    __device__ __forceinline__ const bf16_t* bt16() const { return base + (size_t)n0 * ldb; }
};
struct EpBf16 {
    bf16_t* out; int ldc; int row0; int col0; int mlim; int nlim;
    __device__ __forceinline__ void operator()(const f32x4 (&acc)[4][4], int wr, int wc, int fr, int fq) const {
#pragma unroll
        for (int m = 0; m < 4; ++m) { const int r = row0 + wr * 64 + m * 16 + fr; if (r >= mlim) continue;
#pragma unroll
            for (int n = 0; n < 4; ++n) { const int c = col0 + wc * 64 + n * 16 + fq * 4; if (c >= nlim) continue;
                u32x2 w; w.x = cvtpk(acc[m][n][0], acc[m][n][1]); w.y = cvtpk(acc[m][n][2], acc[m][n][3]);
                *(u32x2*)(out + (size_t)r * ldc + c) = w; } }
    }
};
struct EpResF32 {
    float* out; const float* res; int ldc; int row0; int col0;
    __device__ __forceinline__ void operator()(const f32x4 (&acc)[4][4], int wr, int wc, int fr, int fq) const {
#pragma unroll
        for (int m = 0; m < 4; ++m) { const int r = row0 + wr * 64 + m * 16 + fr;
#pragma unroll
            for (int n = 0; n < 4; ++n) { const int c = col0 + wc * 64 + n * 16 + fq * 4;
                const f32x4 rv = *(const f32x4*)(res + (size_t)r * ldc + c);
                *(f32x4*)(out + (size_t)r * ldc + c) = rv + acc[m][n]; } }
    }
};
struct EpF32 {
    float* out; int ldc; int row0; int col0;
    __device__ __forceinline__ void operator()(const f32x4 (&acc)[4][4], int wr, int wc, int fr, int fq) const {
#pragma unroll
        for (int m = 0; m < 4; ++m) { const int r = row0 + wr * 64 + m * 16 + fr;
#pragma unroll
            for (int n = 0; n < 4; ++n) { const int c = col0 + wc * 64 + n * 16 + fq * 4; *(f32x4*)(out + (size_t)r * ldc + c) = acc[m][n]; } }
    }
};
struct EpProj {
    bf16_t* out; float* gate; int row0; int col0;
    __device__ __forceinline__ void operator()(const f32x4 (&acc)[4][4], int wr, int wc, int fr, int fq) const {
#pragma unroll
        for (int m = 0; m < 4; ++m) { const int r = row0 + wr * 64 + m * 16 + fr;
#pragma unroll
            for (int n = 0; n < 4; ++n) { const int c = col0 + wc * 64 + n * 16 + fq * 4;
                if (c < B_MAIN) { u32x2 w; w.x = cvtpk(acc[m][n][0], acc[m][n][1]); w.y = cvtpk(acc[m][n][2], acc[m][n][3]);
                    *(u32x2*)(out + (size_t)r * B_MAIN + c) = w; }
                else if (c < B_IN) { f32x4 g;
#pragma unroll
                    for (int j = 0; j < 4; ++j) g[j] = 1.f / (1.f + __expf(-acc[m][n][j]));
                    *(f32x4*)(gate + (size_t)r * 48 + (c - B_MAIN)) = g; } } }
    }
};
struct EpSiluMul {
    bf16_t* out; int row0; int c0;
    __device__ __forceinline__ void operator()(const f32x4 (&acc)[4][4], int wr, int wc, int fr, int fq) const {
#pragma unroll
        for (int m = 0; m < 4; ++m) { const int r = row0 + wr * 64 + m * 16 + fr;
#pragma unroll
            for (int n = 0; n < 2; ++n) { const int c = c0 + wc * 32 + n * 16 + fq * 4; float h[4];
#pragma unroll
                for (int j = 0; j < 4; ++j) { const float g = acc[m][n][j]; h[j] = g / (1.f + __expf(-g)) * acc[m][n + 2][j]; }
                u32x2 w; w.x = cvtpk(h[0], h[1]); w.y = cvtpk(h[2], h[3]);
                *(u32x2*)(out + (size_t)r * D_EXPERT + c) = w; } }
    }
};
struct EpScaleRow {
    bf16_t* out; const float* roww; int rw0; int cnt; int row0; int col0;
    __device__ __forceinline__ void operator()(const f32x4 (&acc)[4][4], int wr, int wc, int fr, int fq) const {
#pragma unroll
        for (int m = 0; m < 4; ++m) { const int rl = wr * 64 + m * 16 + fr; const float s = (rw0 + rl < cnt) ? roww[rw0 + rl] : 0.f; const int r = row0 + rl;
#pragma unroll
            for (int n = 0; n < 4; ++n) { const int c = col0 + wc * 64 + n * 16 + fq * 4;
                u32x2 w; w.x = cvtpk(acc[m][n][0] * s, acc[m][n][1] * s); w.y = cvtpk(acc[m][n][2] * s, acc[m][n][3] * s);
                *(u32x2*)(out + (size_t)r * D_MODEL + c) = w; } }
    }
};
__device__ __forceinline__ float gelu_tanh(float x) {
    const float u = 0.7978845608028654f * (x + 0.044715f * x * x * x);
    const float e = __expf(2.f * u); const float t = 1.f - 2.f / (e + 1.f);
    return 0.5f * x * (1.f + t);
}
struct EpGeluBias {
    bf16_t* out; const float* bias; int row0; int col0;
    __device__ __forceinline__ void operator()(const f32x4 (&acc)[4][4], int wr, int wc, int fr, int fq) const {
#pragma unroll
        for (int m = 0; m < 4; ++m) { const int r = row0 + wr * 64 + m * 16 + fr;
#pragma unroll
            for (int n = 0; n < 4; ++n) { const int c = col0 + wc * 64 + n * 16 + fq * 4; const f32x4 bv = *(const f32x4*)(bias + c); float h[4];
#pragma unroll
                for (int j = 0; j < 4; ++j) h[j] = gelu_tanh(acc[m][n][j] + bv[j]);
                u32x2 w; w.x = cvtpk(h[0], h[1]); w.y = cvtpk(h[2], h[3]);
                *(u32x2*)(out + (size_t)r * 256 + c) = w; } }
    }
};

__device__ __forceinline__ void stage_rc(int b, int& R, int& C) { const int st = b / 1024, sb = b % 1024, swz = sb ^ (((sb >> 9) & 1) << 5); R = (st >> 1) * 16 + swz / 64; C = (st & 1) * 32 + (swz % 64) / 2; }
#define G8_HT 16384
template <bool GATHER, class EP>
__device__ __forceinline__ void gemm8_unit(const bf16_t* __restrict__ A, const unsigned (&ao)[2][2], const int lda, const bf16_t* __restrict__ Bt, const unsigned (&bo2)[2], const int K, char* lds, const EP& ep, const bool hi_act) {
    const int tid = tidx(), wid = tid >> 6, lane = tid & 63, wr = wid >> 2, wc = wid & 3, fr = lane & 15, fq = lane >> 4;
#define SA(b, h) (((b) * 2 + (h)) * G8_HT)
#define SB(b, h) ((4 + (b) * 2 + (h)) * G8_HT)
#define STG(P, BASE, OFF, kt) do { const bf16_t* g_ = (BASE) + (kt) * 64; \
        __builtin_amdgcn_global_load_lds((const unsigned*)(g_ + (OFF)[0]), (unsigned*)(lds + (P) + tid * 16), 16, 0, 0); \
        __builtin_amdgcn_global_load_lds((const unsigned*)(g_ + (OFF)[1]), (unsigned*)(lds + (P) + 8192 + tid * 16), 16, 0, 0); } while (0)
#define LDA(dst, b, h) _Pragma("unroll") for (int m = 0; m < 4; ++m) _Pragma("unroll") for (int k = 0; k < 2; ++k) \
        dst[m][k] = *reinterpret_cast<const bf16x8*>(lds + SA(b, h) + fa_base + m * 2048 + k * 1024)
#define LDB(dst, b, h) _Pragma("unroll") for (int n = 0; n < 2; ++n) _Pragma("unroll") for (int k = 0; k < 2; ++k) \
        dst[n][k] = *reinterpret_cast<const bf16x8*>(lds + SB(b, h) + fb_base + n * 2048 + k * 1024)
#define MMA(ai, bj, At_, Bt_) do { __builtin_amdgcn_s_setprio(1); \
        _Pragma("unroll") for (int m = 0; m < 4; ++m) _Pragma("unroll") for (int n = 0; n < 2; ++n) _Pragma("unroll") for (int k = 0; k < 2; ++k) \
            acc[ai][bj][m][n] = __builtin_amdgcn_mfma_f32_16x16x32_bf16(Bt_[n][k], At_[m][k], acc[ai][bj][m][n], 0, 0, 0); \
        __builtin_amdgcn_s_setprio(0); } while (0)
#define MMAH(bj, At_, Bt_) do { if (hi_act) MMA(1, bj, At_, Bt_); } while (0)
#define WAIT_V(n) asm volatile("s_waitcnt vmcnt(" #n ")" ::: "memory")
#define WAIT_L(n) asm volatile("s_waitcnt lgkmcnt(" #n ")" ::: "memory")
#define BAR __builtin_amdgcn_s_barrier()
#define SCHED __builtin_amdgcn_sched_barrier(0)
    const int fa_base = lds_byte(wr * 64 + fr, fq * 8), fb_base = lds_byte(wc * 32 + fr, fq * 8);
    f32x4 acc[2][2][4][2];
#pragma unroll
    for (int a = 0; a < 2; ++a)
#pragma unroll
        for (int b = 0; b < 2; ++b)
#pragma unroll
            for (int m = 0; m < 4; ++m)
#pragma unroll
                for (int n = 0; n < 2; ++n) acc[a][b][m][n] = (f32x4){0.f, 0.f, 0.f, 0.f};
    bf16x8 At[4][2], B0[2][2], B1[2][2];
    const int nt = K / 64;
    const bf16_t* Bt1 = Bt + (size_t)128 * K;
    const bf16_t* A1 = GATHER ? A : A + (size_t)128 * lda;
#define AO1 ao[GATHER ? 1 : 0]
    STG(SB(0, 0), Bt, bo2, 0); STG(SA(0, 0), A, ao[0], 0);
    STG(SB(0, 1), Bt1, bo2, 0); STG(SA(0, 1), A1, AO1, 0);
    if (wr == 1) BAR;
    WAIT_V(4); BAR;
    STG(SB(1, 0), Bt, bo2, 1); STG(SA(1, 0), A, ao[0], 1); STG(SB(1, 1), Bt1, bo2, 1);
    WAIT_V(6); BAR;
    for (int t = 0; t < nt - 2; t += 2) {
        LDB(B0, 0, 0); SCHED; LDA(At, 0, 0); STG(SA(1, 1), A1, AO1, t + 1);
        WAIT_L(8); BAR; WAIT_L(0); MMA(0, 0, At, B0); BAR; SCHED;
        LDB(B1, 0, 1); STG(SB(0, 0), Bt, bo2, t + 2);
        BAR; WAIT_L(0); MMA(0, 1, At, B1); BAR;
        LDA(At, 0, 1); STG(SA(0, 0), A, ao[0], t + 2);
        BAR; WAIT_L(0); MMAH(0, At, B0); BAR; SCHED;
        STG(SB(0, 1), Bt1, bo2, t + 2);
        WAIT_V(6); BAR; MMAH(1, At, B1); BAR;
        LDB(B0, 1, 0); SCHED; LDA(At, 1, 0); STG(SA(0, 1), A1, AO1, t + 2);
        WAIT_L(8); BAR; WAIT_L(0); MMA(0, 0, At, B0); BAR; SCHED;
        LDB(B1, 1, 1); STG(SB(1, 0), Bt, bo2, t + 3);
        BAR; WAIT_L(0); MMA(0, 1, At, B1); BAR;
        LDA(At, 1, 1); STG(SA(1, 0), A, ao[0], t + 3);
        BAR; WAIT_L(0); MMAH(0, At, B0); BAR; SCHED;
        STG(SB(1, 1), Bt1, bo2, t + 3);
        WAIT_V(6); BAR; MMAH(1, At, B1); BAR;
    }
    { LDB(B0, 0, 0); WAIT_V(0); LDA(At, 0, 0); STG(SA(1, 1), A1, AO1, nt - 1);
      BAR; WAIT_L(0); MMA(0, 0, At, B0); BAR;
      LDB(B1, 0, 1); BAR; WAIT_L(0); MMA(0, 1, At, B1); BAR;
      LDA(At, 0, 1); WAIT_V(4); BAR; WAIT_L(0); MMAH(0, At, B0); MMAH(1, At, B1); BAR; }
    { LDB(B0, 1, 0); LDA(At, 1, 0); WAIT_V(2); BAR; WAIT_L(0); MMA(0, 0, At, B0); BAR;
      LDB(B1, 1, 1); WAIT_V(0); BAR; WAIT_L(0); MMA(0, 1, At, B1); BAR;
      LDA(At, 1, 1); BAR; WAIT_L(0); MMAH(0, At, B0); MMAH(1, At, B1); BAR; }
    if (wr == 0) BAR;
    ep(acc, wr, wc, fr, fq);
    __syncthreads();
#undef SA
#undef AO1
#undef SB
#undef STG
#undef LDA
#undef LDB
#undef MMA
#undef MMAH
#undef WAIT_V
#undef WAIT_L
#undef BAR
#undef SCHED
}
__device__ __forceinline__ void g8_offsets2(unsigned (&o)[2], int row0, int ld) {
    const int tid = tidx();
#pragma unroll
    for (int i = 0; i < 2; ++i) { int R, C; stage_rc(tid * 16 + i * 8192, R, C); o[i] = (unsigned)((row0 + R) * ld + C); }
}
__device__ __forceinline__ void g8_offsets2_perm(unsigned (&o)[2], int row0, int ld) {
    const int tid = tidx();
#pragma unroll
    for (int i = 0; i < 2; ++i) { int R, C; stage_rc(tid * 16 + i * 8192, R, C); const int rho = R & 31, nn = rho >> 4, ii = rho & 15;
        const int Rp = (R & ~31) + 8 * (ii >> 2) + 4 * nn + (ii & 3); o[i] = (unsigned)((row0 + Rp) * ld + C); }
}
__device__ __forceinline__ void g8_offsets(unsigned (&o)[2][2], int row0, int ld) {
    const int tid = tidx();
#pragma unroll
    for (int i = 0; i < 2; ++i) { int R, C; stage_rc(tid * 16 + i * 8192, R, C);
#pragma unroll
        for (int h = 0; h < 2; ++h) o[h][i] = (unsigned)((row0 + h * 128 + R) * ld + C); }
}
__device__ __forceinline__ int wgid_v(char* lds) {
#if N_LAUNCH_MODE == 1
    return __builtin_amdgcn_readfirstlane((int)((volatile LAS unsigned*)(lds + LDS_BYTES - 16))[2]);
#else
    (void)lds; return (int)blockIdx.x;
#endif
}
__device__ __forceinline__ void g8_order_c(int L, int nM, int nN, int& pm, int& pn) {
    const int nig = 8 * nN, gid = L / nig, fm = gid * 8, gsz = (nM - fm) < 8 ? (nM - fm) : 8;
    pm = fm + ((L % nig) % gsz); pn = (L % nig) / gsz;
}
__device__ __forceinline__ void g8_order(int L, int nM, int nN, int& pm, int& pn) {
    const int nwg = nM * nN; int wgid = L; { const int q = nwg / 8, r = nwg % 8, xcd = wgid % 8, off = wgid / 8; wgid = (xcd < r ? xcd * (q + 1) : r * (q + 1) + (xcd - r) * q) + off; }
    const int nig = 8 * nN, gid = wgid / nig, fm = gid * 8, gsz = (nM - fm) < 8 ? (nM - fm) : 8;
    pm = fm + ((wgid % nig) % gsz); pn = (wgid % nig) / gsz;
}
struct E8Bf16 {
    bf16_t* out; int ldc; int row0; int col0; int nlim;
    __device__ __forceinline__ void operator()(const f32x4 (&acc)[2][2][4][2], int wr, int wc, int fr, int fq) const {
#pragma unroll
        for (int ai = 0; ai < 2; ++ai)
#pragma unroll
            for (int m = 0; m < 4; ++m) { const int r = row0 + ai * 128 + wr * 64 + m * 16 + fr;
#pragma unroll
                for (int bj = 0; bj < 2; ++bj) { const int c = col0 + bj * 128 + wc * 32 + 8 * fq; if (c >= nlim) continue;
                    const f32x4 v0 = acc[ai][bj][m][0], v1 = acc[ai][bj][m][1];
                    u32x4 w; w.x = cvtpk(v0[0], v0[1]); w.y = cvtpk(v0[2], v0[3]); w.z = cvtpk(v1[0], v1[1]); w.w = cvtpk(v1[2], v1[3]);
                    *(u32x4*)(out + (size_t)r * ldc + c) = w; } }
    }
};
template <bool RB>
struct E8ResBf16 {
    bf16_t* out; const void* res; int row0; int col0;
    __device__ __forceinline__ void operator()(const f32x4 (&acc)[2][2][4][2], int wr, int wc, int fr, int fq) const {
#pragma unroll
        for (int ai = 0; ai < 2; ++ai)
#pragma unroll
            for (int m = 0; m < 4; ++m) { const int r = row0 + ai * 128 + wr * 64 + m * 16 + fr;
#pragma unroll
                for (int bj = 0; bj < 2; ++bj) { const int c = col0 + bj * 128 + wc * 32 + 8 * fq;
                    f32x4 r0, r1;
                    if (RB) { const u32x4 rw = *(const u32x4*)((const bf16_t*)res + (size_t)r * D_MODEL + c);
                        r0[0] = __uint_as_float(rw.x << 16); r0[1] = __uint_as_float(rw.x & 0xffff0000u); r0[2] = __uint_as_float(rw.y << 16); r0[3] = __uint_as_float(rw.y & 0xffff0000u);
                        r1[0] = __uint_as_float(rw.z << 16); r1[1] = __uint_as_float(rw.z & 0xffff0000u); r1[2] = __uint_as_float(rw.w << 16); r1[3] = __uint_as_float(rw.w & 0xffff0000u); }
                    else { r0 = *(const f32x4*)((const float*)res + (size_t)r * D_MODEL + c); r1 = *(const f32x4*)((const float*)res + (size_t)r * D_MODEL + c + 4); }
                    const f32x4 v0 = r0 + acc[ai][bj][m][0], v1 = r1 + acc[ai][bj][m][1];
                    u32x4 w; w.x = cvtpk(v0[0], v0[1]); w.y = cvtpk(v0[2], v0[3]); w.z = cvtpk(v1[0], v1[1]); w.w = cvtpk(v1[2], v1[3]);
                    *(u32x4*)(out + (size_t)r * D_MODEL + c) = w; } }
    }
};
struct E8Proj {
    bf16_t* out; float* gate; int row0; int col0;
    __device__ __forceinline__ void operator()(const f32x4 (&acc)[2][2][4][2], int wr, int wc, int fr, int fq) const {
#pragma unroll
        for (int ai = 0; ai < 2; ++ai)
#pragma unroll
            for (int m = 0; m < 4; ++m) { const int r = row0 + ai * 128 + wr * 64 + m * 16 + fr;
#pragma unroll
                for (int bj = 0; bj < 2; ++bj) { const int c = col0 + bj * 128 + wc * 32 + 8 * fq; const f32x4 v0 = acc[ai][bj][m][0], v1 = acc[ai][bj][m][1];
                    if (c < B_MAIN) { u32x4 w; w.x = cvtpk(v0[0], v0[1]); w.y = cvtpk(v0[2], v0[3]); w.z = cvtpk(v1[0], v1[1]); w.w = cvtpk(v1[2], v1[3]);
                        *(u32x4*)(out + (size_t)r * B_MAIN + c) = w; }
                    else if (c < B_IN) { f32x4 g0, g1;
#pragma unroll
                        for (int j = 0; j < 4; ++j) { g0[j] = 1.f / (1.f + __expf(-v0[j])); g1[j] = 1.f / (1.f + __expf(-v1[j])); }
                        *(f32x4*)(gate + (size_t)r * 48 + (c - B_MAIN)) = g0; *(f32x4*)(gate + (size_t)r * 48 + (c - B_MAIN) + 4) = g1; } } }
    }
};
template <int MODE>
__device__ __forceinline__ void convert_weight(const float* __restrict__ src, const int K, const int N, bf16_t* __restrict__ dst, int& job, const int stride, char* lds) {
    (void)lds;
    const int tid = tidx(), kb = (tid >> 2) & 7, nb = (tid & 3) + 4 * (tid >> 5); const int nK = K / 64, nN = (N + 255) / 256; const int njobs = nK * nN;
    for (; job < njobs;) {
        const int j1 = job + stride; const bool two = j1 < njobs;
        const int kt0 = job % nK, nt0 = job / nK, kt1 = two ? j1 % nK : kt0, nt1 = two ? j1 / nK : nt0;
        f32x4 v[2][8];
#pragma unroll
        for (int jj = 0; jj < 2; ++jj) { const int kt = jj ? kt1 : kt0, ntl = jj ? nt1 : nt0;
            const int n = ntl * 256 + nb * 4; const float* s = src + (size_t)(kt * 64 + 8 * kb) * N + n;
#pragma unroll
            for (int i = 0; i < 8; ++i) v[jj][i] = n < N ? *(const f32x4*)(s + (size_t)i * N) : (f32x4){0.f, 0.f, 0.f, 0.f}; }
#pragma unroll
        for (int jj = 0; jj < 2; ++jj) { if (jj == 1 && !two) break;
            const int kt = jj ? kt1 : kt0, ntl = jj ? nt1 : nt0; const int n = ntl * 256 + nb * 4;
#pragma unroll
            for (int j = 0; j < 4; ++j) { const int ng = n + j;
                const int drow = MODE == 0 ? ng : ((ng >> 7) * 256 + (ng & 127) + (MODE == 2 ? 128 : 0));
                u32x4 w; w.x = cvtpk(v[jj][0][j], v[jj][1][j]); w.y = cvtpk(v[jj][2][j], v[jj][3][j]); w.z = cvtpk(v[jj][4][j], v[jj][5][j]); w.w = cvtpk(v[jj][6][j], v[jj][7][j]);
                *(u32x4*)(dst + (size_t)drow * K + kt * 64 + 8 * kb) = w; } }
        job += two ? 2 * stride : stride;
    }
    job -= njobs;
}
struct E8SiluMul {
    bf16_t* out; int row0; int c0;
    __device__ __forceinline__ void operator()(const f32x4 (&acc)[2][2][4][2], int wr, int wc, int fr, int fq) const {
#pragma unroll
        for (int ai = 0; ai < 2; ++ai)
#pragma unroll
            for (int m = 0; m < 4; ++m) { const int r = row0 + ai * 128 + wr * 64 + m * 16 + fr;
#pragma unroll
                for (int n = 0; n < 2; ++n) { const int c = c0 + wc * 32 + n * 16 + fq * 4; float h[4];
#pragma unroll
                    for (int j = 0; j < 4; ++j) { const float g = acc[ai][0][m][n][j]; h[j] = g / (1.f + __expf(-g)) * acc[ai][1][m][n][j]; }
                    u32x2 w; w.x = cvtpk(h[0], h[1]); w.y = cvtpk(h[2], h[3]);
                    *(u32x2*)(out + (size_t)r * D_EXPERT + c) = w; } }
    }
};
struct E8ScaleRow {
    bf16_t* out; const float* roww; int rw0; int cnt; int row0; int col0;
    __device__ __forceinline__ void operator()(const f32x4 (&acc)[2][2][4][2], int wr, int wc, int fr, int fq) const {
#pragma unroll
        for (int ai = 0; ai < 2; ++ai)
#pragma unroll
            for (int m = 0; m < 4; ++m) { const int rl = ai * 128 + wr * 64 + m * 16 + fr; const float s = (rw0 + rl < cnt) ? roww[rw0 + rl] : 0.f; const int r = row0 + rl;
#pragma unroll
                for (int bj = 0; bj < 2; ++bj)
#pragma unroll
                    for (int n = 0; n < 2; ++n) { const int c = col0 + bj * 128 + wc * 32 + n * 16 + fq * 4; const f32x4 v = acc[ai][bj][m][n];
                        u32x2 w; w.x = cvtpk(v[0] * s, v[1] * s); w.y = cvtpk(v[2] * s, v[3] * s);
                        *(u32x2*)(out + (size_t)r * D_MODEL + c) = w; } }
    }
};

template <int WHICH>
__device__ __forceinline__ void moe_convert(CParams& p, const int le0, const int le1, char* lds, int job = -1, int stride = 0) {
    if (job < 0) { job = blockIdx.x; stride = gridDim.x; }
#pragma unroll 1
    for (int le = le0; le < le1; ++le) {
        if (WHICH & 1) {
            convert_weight<1>(p.moe_w_gate + (size_t)le * D_MODEL * D_EXPERT, D_MODEL, D_EXPERT, p.wgu_t + (size_t)le * 2048 * 2048, job, stride, lds);
            convert_weight<2>(p.moe_w_up + (size_t)le * D_MODEL * D_EXPERT, D_MODEL, D_EXPERT, p.wgu_t + (size_t)le * 2048 * 2048, job, stride, lds); }
        if (WHICH & 2)
            convert_weight<0>(p.moe_w_down + (size_t)le * D_EXPERT * D_MODEL, D_EXPERT, D_MODEL, p.wd_t + (size_t)le * 2048 * 1024, job, stride, lds);
    }
    __syncthreads();
}
#define KSWZ(row, colB) ((row) * 256 + ((colB) ^ (((row) & 7) << 4)))
#define SBAR() __builtin_amdgcn_sched_barrier(0)
#define TILE_B 16384
__device__ __forceinline__ int v_rd_base(int lane) { return ((lane & 3) << 3) | (((lane >> 2) & 3) << 6) | (((lane >> 4) & 1) << 5) | (((lane >> 5) & 1) << 8); }
constexpr int v_rd_off(int d0, int ks, int half) { return d0 * 512 + ks * 4096 + half * 2048; }
__device__ __forceinline__ int crow(int r, int hi) { return (r & 3) + 8 * (r >> 2) + 4 * hi; }

__device__ __forceinline__ unsigned fill_koff(int tid, int ld) { const int row = tid >> 4, cp = tid & 15; return (unsigned)(row * ld + ((cp ^ (row & 7)) << 3)); }
__device__ __forceinline__ unsigned fill_voff(int tid, int ld) { const int L = tid; const int kk = ((L >> 7) << 3) | ((L >> 2) & 7), c = (((L >> 5) & 3) << 5) | ((L & 3) << 3);
    const int k = (kk & ~0xC) | ((kk & 4) << 1) | ((kk & 8) >> 1); return (unsigned)(k * ld + c); }
__device__ __forceinline__ void fill_tile(const bf16_t* src, unsigned off, int ld, char* dst, int tid) {
    __builtin_amdgcn_global_load_lds((const unsigned*)(src + off), (unsigned*)(dst + tid * 16), 16, 0, 0);
    __builtin_amdgcn_global_load_lds((const unsigned*)(src + 32 * ld + off), (unsigned*)(dst + 8192 + tid * 16), 16, 0, 0);
}
__device__ __forceinline__ void qkt(f32x16& p0, f32x16& p1, const char* Kt, int r32, int hi, const bf16x8* qr) {
    p0 = f32x16{}; p1 = f32x16{};
    const char* kb[4];
#pragma unroll
    for (int dd = 0; dd < 4; ++dd) kb[dd] = Kt + KSWZ(r32, (dd * 16 + hi * 8) * 2);
    __builtin_amdgcn_s_setprio(1);
#pragma unroll
    for (int d0 = 0; d0 < 8; ++d0) { const char* a = kb[d0 & 3] + (d0 >> 2) * 128;
        bf16x8 b0 = *reinterpret_cast<const bf16x8*>(a);
        bf16x8 b1 = *reinterpret_cast<const bf16x8*>(a + 32 * 256);
        p0 = __builtin_amdgcn_mfma_f32_32x32x16_bf16(b0, qr[d0], p0, 0, 0, 0);
        p1 = __builtin_amdgcn_mfma_f32_32x32x16_bf16(b1, qr[d0], p1, 0, 0, 0); }
    __builtin_amdgcn_s_setprio(0);
}
__device__ __forceinline__ void qkt_lds(f32x16& p0, f32x16& p1, const char* Kt, int r32, int hi, const char* qb) {
    p0 = f32x16{}; p1 = f32x16{};
    const char* kb[4];
#pragma unroll
    for (int dd = 0; dd < 4; ++dd) kb[dd] = Kt + KSWZ(r32, (dd * 16 + hi * 8) * 2);
#pragma unroll
    for (int d0 = 0; d0 < 8; ++d0) { const char* a = kb[d0 & 3] + (d0 >> 2) * 128;
        bf16x8 b0 = *reinterpret_cast<const bf16x8*>(a);
        bf16x8 b1 = *reinterpret_cast<const bf16x8*>(a + 32 * 256);
        bf16x8 q = *reinterpret_cast<const bf16x8*>(qb + d0 * 1024);
        p0 = __builtin_amdgcn_mfma_f32_32x32x16_bf16(b0, q, p0, 0, 0, 0);
        p1 = __builtin_amdgcn_mfma_f32_32x32x16_bf16(b1, q, p1, 0, 0, 0); }
}
__device__ __forceinline__ void pv_tile(f32x16* o, int vb0, bf16x8 pa0, bf16x8 pa1, bf16x8 pa2, bf16x8 pa3) {
#define TRRD(dst, off) asm volatile("ds_read_b64_tr_b16 %0, %1 offset:%2" : "=&v"(dst) : "v"(vb0), "i"(off) : "memory")
#define PV_D0(d0) do { s16x4 l0, l1, l2, l3, h0, h1, h2, h3; constexpr int b_ = v_rd_off(d0, 0, 0); \
        TRRD(l0, b_); TRRD(h0, b_ + 2048); TRRD(l1, b_ + 4096); TRRD(h1, b_ + 6144); TRRD(l2, b_ + 8192); TRRD(h2, b_ + 10240); TRRD(l3, b_ + 12288); TRRD(h3, b_ + 14336); \
        asm volatile("s_waitcnt lgkmcnt(0)" ::: "memory"); SBAR(); \
        o[d0] = __builtin_amdgcn_mfma_f32_32x32x16_bf16(pa0, (bf16x8){l0[0], l0[1], l0[2], l0[3], h0[0], h0[1], h0[2], h0[3]}, o[d0], 0, 0, 0); \
        o[d0] = __builtin_amdgcn_mfma_f32_32x32x16_bf16(pa1, (bf16x8){l1[0], l1[1], l1[2], l1[3], h1[0], h1[1], h1[2], h1[3]}, o[d0], 0, 0, 0); \
        o[d0] = __builtin_amdgcn_mfma_f32_32x32x16_bf16(pa2, (bf16x8){l2[0], l2[1], l2[2], l2[3], h2[0], h2[1], h2[2], h2[3]}, o[d0], 0, 0, 0); \
        o[d0] = __builtin_amdgcn_mfma_f32_32x32x16_bf16(pa3, (bf16x8){l3[0], l3[1], l3[2], l3[3], h3[0], h3[1], h3[2], h3[3]}, o[d0], 0, 0, 0); } while (0)
    __builtin_amdgcn_s_setprio(1);
    PV_D0(0); PV_D0(1); PV_D0(2); PV_D0(3);
    __builtin_amdgcn_s_setprio(0);
#undef PV_D0
#undef TRRD
}
__device__ __forceinline__ float half_max(float v) { auto rr = __builtin_amdgcn_permlane32_swap(__float_as_uint(v), __float_as_uint(v), false, false); return fmaxf(__uint_as_float(rr[0]), __uint_as_float(rr[1])); }
__device__ __forceinline__ float half_sum(float v) { auto rr = __builtin_amdgcn_permlane32_swap(__float_as_uint(v), __float_as_uint(v), false, false); return __uint_as_float(rr[0]) + __uint_as_float(rr[1]); }
__device__ __forceinline__ void pack_p(const f32x16& p0, const f32x16& p1, bf16x8& pa0, bf16x8& pa1, bf16x8& pa2, bf16x8& pa3) {
#define PK4(P, B_, OUT) do { unsigned a0 = cvtpk(P[B_+0], P[B_+1]), a1 = cvtpk(P[B_+2], P[B_+3]);                          \
        unsigned b0 = cvtpk(P[B_+4], P[B_+5]), b1 = cvtpk(P[B_+6], P[B_+7]);                                             \
        auto r0 = __builtin_amdgcn_permlane32_swap(a0, b0, false, false); auto r1 = __builtin_amdgcn_permlane32_swap(a1, b1, false, false); \
        u32x4 w = {r0[0], r1[0], r0[1], r1[1]}; OUT = *reinterpret_cast<bf16x8*>(&w); } while (0)
    PK4(p0, 0, pa0); PK4(p0, 8, pa1); PK4(p1, 0, pa2); PK4(p1, 8, pa3);
#undef PK4
}
__device__ __forceinline__ float online_sm(f32x16& p0, f32x16& p1, float& m_reg, float& l_reg) {
    float pmax = p0[0];
#pragma unroll
    for (int r = 1; r < 16; ++r) pmax = fmaxf(pmax, p0[r]);
#pragma unroll
    for (int r = 0; r < 16; ++r) pmax = fmaxf(pmax, p1[r]);
    pmax = half_max(pmax);
    float mn, alpha;
    if (__all(pmax - m_reg <= 8.f)) { mn = m_reg; alpha = 1.f; }
    else { mn = fmaxf(m_reg, pmax); alpha = __builtin_amdgcn_exp2f(m_reg - mn); m_reg = mn; }
    float ps = 0.f;
#pragma unroll
    for (int r = 0; r < 16; ++r) { p0[r] = __builtin_amdgcn_exp2f(p0[r] - mn); ps += p0[r]; }
#pragma unroll
    for (int r = 0; r < 16; ++r) { p1[r] = __builtin_amdgcn_exp2f(p1[r] - mn); ps += p1[r]; }
    ps = half_sum(ps);
    l_reg = l_reg * alpha + ps;
    return alpha;
}
#define ROWX(scr, val, out16) do { if (hi == 0) (scr)[r32] = (val); asm volatile("s_waitcnt lgkmcnt(0)" ::: "memory"); \
        _Pragma("unroll") for (int r_ = 0; r_ < 16; ++r_) (out16)[r_] = (scr)[crow(r_, hi)]; asm volatile("s_waitcnt lgkmcnt(0)" ::: "memory"); } while (0)

__device__ __forceinline__ void diff_attn_unit(CParams& p, const int b, const int h, const int qb, char* lds, const float lam, const float one_m_li) {
    const int tid = tidx(), wid = __builtin_amdgcn_readfirstlane(tid >> 6), lane = tid & 63, r32 = lane & 31, hi = lane >> 5;
    const int rg = wid & 3, comp = wid >> 2;
    const int P0 = qb * 128, qlo = P0 + rg * 32, qpos = qlo + r32;
    const bf16_t* base = p.qkv + (size_t)b * SEQ * A_IN;
    const bf16_t* Kc0 = base + 2048 + (h * 2 + 0) * 128;
    const bf16_t* Vb = base + 4096 + h * 256;
    bf16x8 qr[8];
    { const bf16_t* qp = base + (size_t)qpos * A_IN + (h * 2 + comp) * 128 + hi * 8;
#pragma unroll
        for (int d0 = 0; d0 < 8; ++d0) qr[d0] = *(const bf16x8*)(qp + d0 * 16); }
    const int NT = 2 * qb + 2;
    const float slope = exp2f(-(float)(h + 1));
    const float C2 = 1.4426950408889634f * 0.08838834764831845f, sl2 = 1.4426950408889634f * slope;
    float m_reg = -1e30f, l_reg = 0.f; f32x16 o[8];
#pragma unroll
    for (int d = 0; d < 8; ++d) o[d] = f32x16{};
    const unsigned ko = fill_koff(tid, A_IN), vo = fill_voff(tid, A_IN);
#define DA_FILLK(t, bf) do { const size_t ro_ = (size_t)(t) * 64 * A_IN; char* B_ = lds + (bf) * 4 * TILE_B; \
        fill_tile(Kc0 + ro_, ko, A_IN, B_, tid); fill_tile(Kc0 + ro_ + 128, ko, A_IN, B_ + TILE_B, tid); } while (0)
#define DA_FILLV(t, bf) do { const size_t ro_ = (size_t)(t) * 64 * A_IN; char* B_ = lds + (bf) * 4 * TILE_B; \
        fill_tile(Vb + ro_, vo, A_IN, B_ + 2 * TILE_B, tid); fill_tile(Vb + ro_ + 128, vo, A_IN, B_ + 3 * TILE_B, tid); } while (0)
    DA_FILLK(0, 0); DA_FILLV(0, 0);
    __syncthreads();
    if (comp == 1) __syncthreads();
    for (int t = 0; t < NT; ++t) {
        const int bf = t & 1;
        const int kb = t * 64;
        const bool active = kb <= qlo + 31;
        bf16x8 pa0, pa1, pa2, pa3;
        if (t + 1 < NT) DA_FILLK(t + 1, bf ^ 1);
        if (active) {
            float* scr = (float*)(lds + 8 * TILE_B) + wid * 32;
            f32x16 p0, p1;
            qkt(p0, p1, lds + bf * 4 * TILE_B + comp * TILE_B, r32, hi, qr);
            float sl = sl2; asm volatile("" : "+v"(sl));
            const float bb = sl * (float)(kb - P0 + 4 * hi);
#pragma unroll
            for (int r = 0; r < 16; ++r) { const int c = (r & 3) + 8 * (r >> 2);
                p0[r] = fmaf(p0[r], C2, fmaf(sl, (float)c, bb)); p1[r] = fmaf(p1[r], C2, fmaf(sl, (float)(c + 32), bb)); }
            if (kb + 63 > qlo) {
                const int dq = qpos - kb - 4 * hi;
#pragma unroll
                for (int r = 0; r < 16; ++r) { const int c = (r & 3) + 8 * (r >> 2);
                    if (c > dq) p0[r] = -__builtin_inff();
                    if (c + 32 > dq) p1[r] = -__builtin_inff(); }
            }
            const float alpha = online_sm(p0, p1, m_reg, l_reg);
            if (__any(alpha < 1.f)) { float al[16]; ROWX(scr, alpha, al);
#pragma unroll
                for (int d = 0; d < 8; ++d)
#pragma unroll
                    for (int r = 0; r < 16; ++r) o[d][r] *= al[r]; }
            pack_p(p0, p1, pa0, pa1, pa2, pa3);
        }
        __syncthreads();
        if (t + 1 < NT) DA_FILLV(t + 1, bf ^ 1);
        if (active) {
            const int vb_lane = (int)(uintptr_t)lds + v_rd_base(lane) + bf * 4 * TILE_B;
            pv_tile(o, vb_lane + 2 * TILE_B, pa0, pa1, pa2, pa3);
            pv_tile(o + 4, vb_lane + 3 * TILE_B, pa0, pa1, pa2, pa3);
        }
        __syncthreads();
    }
    if (comp == 0) __syncthreads();
#undef DA_FILLK
#undef DA_FILLV
    int tz = tidx(); asm volatile("" : "+v"(tz));
    const int lane2 = tz & 63, r2 = lane2 & 31, h2 = lane2 >> 5, wid2 = tz >> 6, rg2 = wid2 & 3, comp2 = wid2 >> 2;
    { float il[16];
      { float* scr = (float*)(lds + 8 * TILE_B) + wid2 * 32; const int r32 = r2, hi = h2; ROWX(scr, 1.f / l_reg, il); }
#pragma unroll
      for (int d = 0; d < 8; ++d)
#pragma unroll
          for (int r = 0; r < 16; ++r) o[d][r] *= il[r]; }
    float* xch = (float*)lds + rg2 * 8192;
    if (comp2 == 1) {
#pragma unroll
        for (int d = 0; d < 8; ++d)
#pragma unroll
            for (int r = 0; r < 16; ++r) xch[(d * 16 + r) * 64 + lane2] = o[d][r];
    }
    __syncthreads();
    if (comp2 == 0) {
        float ssq[16];
#pragma unroll
        for (int r = 0; r < 16; ++r) ssq[r] = 0.f;
#pragma unroll
        for (int d = 0; d < 8; ++d) {
#pragma unroll
            for (int r = 0; r < 16; ++r) { float* q = xch + (d * 16 + r) * 64 + lane2; const float v = o[d][r] - lam * *q; *q = v; ssq[r] = fmaf(v, v, ssq[r]); }
            SBAR(); }
        float* rsc = (float*)(lds + 8 * TILE_B) + wid2 * 32;
#pragma unroll
        for (int r = 0; r < 16; ++r) {
            ssq[r] += shx<1>(ssq[r]); ssq[r] += shx<2>(ssq[r]); ssq[r] += shx<4>(ssq[r]); ssq[r] += shx<8>(ssq[r]); ssq[r] += shx<16>(ssq[r]);
            if (r2 == 0) rsc[crow(r, h2)] = rsqrtf(ssq[r] * (1.f / 256.f) + EPS) * one_m_li; }
        asm volatile("s_waitcnt lgkmcnt(0)" ::: "memory");
        bf16_t* ob = p.attn_o + ((size_t)b * SEQ + qb * 128 + rg2 * 32) * D_MODEL + h * 256;
#pragma unroll 4
        for (int i = 0; i < 16; ++i) { const int id = i * 64 + lane2, row = id >> 5, cc = id & 31;
            const int hh_ = (row >> 2) & 1, rr_ = (row & 3) + 4 * (row >> 3);
            const float* q = xch + ((cc >> 2) * 16 + rr_) * 64 + hh_ * 32 + (cc & 3) * 8;
            const f32x4 a = *(const f32x4*)q, c4 = *(const f32x4*)(q + 4);
            const f32x4 w0 = *(const f32x4*)(p.a_subln_w + cc * 8), w1 = *(const f32x4*)(p.a_subln_w + cc * 8 + 4);
            const float rs = rsc[row];
            u32x4 o4; o4.x = cvtpk(a[0] * rs * w0[0], a[1] * rs * w0[1]); o4.y = cvtpk(a[2] * rs * w0[2], a[3] * rs * w0[3]);
            o4.z = cvtpk(c4[0] * rs * w1[0], c4[1] * rs * w1[1]); o4.w = cvtpk(c4[2] * rs * w1[2], c4[3] * rs * w1[3]);
            *(u32x4*)(ob + (size_t)row * D_MODEL + cc * 8) = o4; }
    }
    __syncthreads();
}
__device__ __forceinline__ void phase_diff_attn(CParams& p, char* lds) {
    float lam;
    { const int lane = tidx() & 63; const float* L = p.a_lambda;
        float s1 = L[lane] * L[128 + lane] + L[64 + lane] * L[128 + 64 + lane];
        float s2 = L[256 + lane] * L[384 + lane] + L[256 + 64 + lane] * L[384 + 64 + lane];
        s1 = wave_sum(s1); s2 = wave_sum(s2);
        lam = __expf(s1) - __expf(s2) + 0.2f; }
    int it = 0; const int myslot = blockIdx.x % 3;
#pragma unroll 1
    for (int w = wgid_v(lds); w < 512; w += gridDim.x, ++it) {
        if (CONV_MODE == 1 && it == myslot) moe_convert<1>(p, 16, 32, lds);
        const int ww = w & 255, b = ww >> 7, h = (ww >> 4) & 7, qp = ww & 15;
        diff_attn_unit(p, b, h, w < 256 ? 31 - qp : qp, lds, lam, 0.8f);
    }
    if (CONV_MODE == 1 && myslot >= it) moe_convert<1>(p, 16, 32, lds);
}
#define NSA_IMP_OFF (4 * TILE_B)
#define NSA_SEL_OFF (8 * TILE_B)
#define NSA_UM_OFF (8 * TILE_B + 512)
#define NSA_SCR_OFF (8 * TILE_B + 1024)
#define NSA_LANE() int tz_ = tidx(); asm volatile("" : "+v"(tz_)); const int tid = tz_, wid = __builtin_amdgcn_readfirstlane(tz_ >> 6), lane = tz_ & 63, r32 = lane & 31, hi = lane >> 5; \
    const int hh = wid >> 1, th = wid & 1, tl = th * 32 + r32, pos = P0 + tl, Hh = g * 4 + hh; (void)tid; (void)hh; (void)th; (void)tl; (void)pos; (void)Hh; (void)hi; \
    float* scr = (float*)(lds + NSA_SCR_OFF) + wid * 32; (void)scr; const int vb_lane = (int)(uintptr_t)lds + v_rd_base(lane); (void)vb_lane; \
    const float sl2 = 1.4426950408889634f * exp2f(-0.5f * (float)(Hh + 1)); (void)sl2;
#define NSA_C2 (1.4426950408889634f * 0.08838834764831845f)
#define NSA_RESCALE(o, alpha) do { if (__any((alpha) < 1.f)) { float al_[16]; ROWX(scr, (alpha), al_); \
        _Pragma("unroll") for (int d_ = 0; d_ < 4; ++d_) _Pragma("unroll") for (int r_ = 0; r_ < 16; ++r_) (o)[d_][r_] *= al_[r_]; } } while (0)
#define NSA_ACCUM(tot, o, fac, first) do { float f_[16]; ROWX(scr, (fac), f_); \
        _Pragma("unroll") for (int d_ = 0; d_ < 4; ++d_) _Pragma("unroll") for (int q_ = 0; q_ < 8; ++q_) { \
            float a_ = (o)[d_][2 * q_] * f_[2 * q_], b_ = (o)[d_][2 * q_ + 1] * f_[2 * q_ + 1]; \
            if (!(first)) { a_ += __uint_as_float((tot)[d_][q_] << 16); b_ += __uint_as_float((tot)[d_][q_] & 0xffff0000u); } \
            (tot)[d_][q_] = cvtpk(a_, b_); } } while (0)

__device__ __forceinline__ void nsa_unit(CParams& p, const int b, const int g, const int qb, char* lds) {
    const int P0 = qb * 64;
    const bf16_t* proj = p.qkv + (size_t)b * SEQ * B_MAIN;
    bf16x8 qr[8];
    unsigned tot[4][8];
    {   NSA_LANE();
        const bf16_t* qp = proj + (size_t)pos * B_MAIN + Hh * 128 + hi * 8;
#pragma unroll
        for (int d0 = 0; d0 < 8; ++d0) qr[d0] = *(const bf16x8*)(qp + d0 * 16);
        float* ir = (float*)(lds + NSA_IMP_OFF) + ((size_t)hh * 64 + tl) * 64 + hi * 32;
#pragma unroll
        for (int i = 0; i < 8; ++i) *(f32x4*)(ir + 4 * i) = (f32x4){0.f, 0.f, 0.f, 0.f};
    }
    {   NSA_LANE();
        const bf16_t* kcmp = p.kvcmp + ((size_t)(b * 256) * 4 + g) * 128;
        const bf16_t* vcmp = kcmp + (size_t)2048 * 128;
        const unsigned ko = fill_koff(tid, 512), vo = fill_voff(tid, 512);
        const int NTc = (4 * qb + 2) / 64 + 1;
        const int cmaxl = pos >= 31 ? ((pos - 31) >> 4) : -1;
        float m_c = -1e30f, l_c = 0.f;
#define CMP_SCORES(t) do { float sl_ = sl2 * 16.f; asm volatile("" : "+v"(sl_)); const float bb = sl_ * (float)((t) * 64 + 4 * hi); const int dq = cmaxl - (t) * 64 - 4 * hi; \
        _Pragma("unroll") for (int r = 0; r < 16; ++r) { const int c = (r & 3) + 8 * (r >> 2); \
            p0[r] = c > dq ? -__builtin_inff() : fmaf(p0[r], NSA_C2, fmaf(sl_, (float)c, bb)); \
            p1[r] = c + 32 > dq ? -__builtin_inff() : fmaf(p1[r], NSA_C2, fmaf(sl_, (float)(c + 32), bb)); } } while (0)
        fill_tile(kcmp, ko, 512, lds, tid);
        __syncthreads();
        for (int t = 0; t < NTc; ++t) {
            const int bf = t & 1;
            if (t + 1 < NTc) fill_tile(kcmp + (size_t)(t + 1) * 64 * 512, ko, 512, lds + (bf ^ 1) * 2 * TILE_B, tid);
            f32x16 p0, p1;
            qkt(p0, p1, lds + bf * 2 * TILE_B, r32, hi, qr);
            CMP_SCORES(t);
            (void)online_sm(p0, p1, m_c, l_c);
            __syncthreads();
        }
        const float inv_l = l_c > 0.f ? 1.f / l_c : 0.f;
        f32x16 o[4];
#pragma unroll
        for (int d = 0; d < 4; ++d) o[d] = f32x16{};
        float carry = 0.f;
        fill_tile(kcmp, ko, 512, lds, tid); fill_tile(vcmp, vo, 512, lds + TILE_B, tid);
        __syncthreads();
        for (int t = 0; t < NTc; ++t) {
            const int bf = t & 1;
            if (t + 1 < NTc) { fill_tile(kcmp + (size_t)(t + 1) * 64 * 512, ko, 512, lds + (bf ^ 1) * 2 * TILE_B, tid);
                               fill_tile(vcmp + (size_t)(t + 1) * 64 * 512, vo, 512, lds + (bf ^ 1) * 2 * TILE_B + TILE_B, tid); }
            f32x16 p0, p1;
            qkt(p0, p1, lds + bf * 2 * TILE_B, r32, hi, qr);
            CMP_SCORES(t);
#pragma unroll
            for (int r = 0; r < 16; ++r) { p0[r] = __builtin_amdgcn_exp2f(p0[r] - m_c) * inv_l; p1[r] = __builtin_amdgcn_exp2f(p1[r] - m_c) * inv_l; }
            { float mv[8], sp[8], ps[8];
#pragma unroll
                for (int q = 0; q < 4; ++q) { sp[q] = 0.5f * p0[4 * q + 3]; mv[q] = p0[4 * q] + p0[4 * q + 1] + p0[4 * q + 2] + sp[q];
                                              sp[4 + q] = 0.5f * p1[4 * q + 3]; mv[4 + q] = p1[4 * q] + p1[4 * q + 1] + p1[4 * q + 2] + sp[4 + q]; }
#pragma unroll
                for (int q = 0; q < 8; ++q) ps[q] = shx<32>(sp[q]);
                float* ir = (float*)(lds + NSA_IMP_OFF) + ((size_t)hh * 64 + tl) * 64 + 16 * t + hi;
#pragma unroll
                for (int q = 0; q < 8; ++q) { const float lo = q > 0 ? ps[q > 0 ? q - 1 : 0] : carry; ir[2 * q] = mv[q] + (hi ? ps[q] : lo); }
                carry = ps[7]; }
            bf16x8 pa0, pa1, pa2, pa3; pack_p(p0, p1, pa0, pa1, pa2, pa3);
            pv_tile(o, vb_lane + bf * 2 * TILE_B + TILE_B, pa0, pa1, pa2, pa3);
            __syncthreads();
        }
#undef CMP_SCORES
        const float g0 = p.gate[((size_t)b * SEQ + pos) * 48 + Hh * 3 + 0];
        NSA_ACCUM(tot, o, g0, true);
    }
    {
        const int lane = tidx() & 63, wid = __builtin_amdgcn_readfirstlane(tidx() >> 6);
        const float* imp = (const float*)(lds + NSA_IMP_OFF);
        unsigned long long* selm = (unsigned long long*)(lds + NSA_SEL_OFF);
#pragma unroll 1
        for (int i0 = 0; i0 < 8; i0 += 8) { const int j = lane;
            unsigned key[8], thr[8];
#pragma unroll
            for (int q = 0; q < 8; ++q) { const int tk = wid * 8 + i0 + q;
                const float* ir = imp + (size_t)tk * 64 + j;
                const float v = ((ir[0] + ir[64 * 64]) + ir[2 * 64 * 64]) + ir[3 * 64 * 64];
                const bool forced = (j == 0) || (j == qb) || (j == qb - 1);
                const float sc = forced ? 1e4f : (j <= qb ? v : -1e4f);
                unsigned k_ = __float_as_uint(sc); key[q] = (k_ & 0x80000000u) ? ~k_ : (k_ | 0x80000000u); thr[q] = 0u; }
#pragma unroll 1
            for (int bit = 31; bit >= 0; --bit) {
#pragma unroll
                for (int q = 0; q < 8; ++q) { const unsigned cand = thr[q] | (1u << bit);
                    if (__popcll(__ballot(key[q] >= cand)) >= 16) thr[q] = cand; } }
#pragma unroll
            for (int q = 0; q < 8; ++q) { const int tk = wid * 8 + i0 + q;
                const unsigned long long gt = __ballot(key[q] > thr[q]), eq = __ballot(key[q] == thr[q]);
                const int need = 16 - __popcll(gt);
                const bool sel = (key[q] > thr[q]) || (key[q] == thr[q] && __popcll(eq & ((1ull << j) - 1ull)) < need);
                const unsigned long long sm = __ballot(sel && j <= qb);
                if (lane == 0) selm[tk] = sm; } }
        __syncthreads();
        if (wid == 0) { unsigned long long u = selm[lane];
#define UM_STEP(S) do { const unsigned lo = (unsigned)shx_i<S>((int)(unsigned)u), hi2 = (unsigned)shx_i<S>((int)(unsigned)(u >> 32)); u |= ((unsigned long long)hi2 << 32) | lo; } while (0)
            UM_STEP(32); UM_STEP(16); UM_STEP(8); UM_STEP(4); UM_STEP(2); UM_STEP(1);
#undef UM_STEP
            if (lane == 0) *(unsigned long long*)(lds + NSA_UM_OFF) = u; }
        { char* qd = lds + NSA_IMP_OFF + wid * 8192 + lane * 16;
#pragma unroll
            for (int d0 = 0; d0 < 8; ++d0) *(bf16x8*)(qd + d0 * 1024) = qr[d0]; }
        __syncthreads();
    }
    {   NSA_LANE();
        const unsigned long long mysel = ((const unsigned long long*)(lds + NSA_SEL_OFF))[tl];
        unsigned long long um = *(const unsigned long long*)(lds + NSA_UM_OFF);
        um = ((unsigned long long)__builtin_amdgcn_readfirstlane((unsigned)(um >> 32)) << 32) | (unsigned)__builtin_amdgcn_readfirstlane((unsigned)um);
        const bf16_t* Ks = proj + 3072 + g * 128; const bf16_t* Vs = proj + 3584 + g * 128;
        const unsigned ko = fill_koff(tid, B_MAIN), vo = fill_voff(tid, B_MAIN);
        float m_s = -1e30f, l_s = 0.f; f32x16 o[4];
#pragma unroll
        for (int d = 0; d < 4; ++d) o[d] = f32x16{};
        int j = __builtin_ctzll(um); um &= um - 1; int idx = 0;
        fill_tile(Ks + (size_t)j * 64 * B_MAIN, ko, B_MAIN, lds, tid); fill_tile(Vs + (size_t)j * 64 * B_MAIN, vo, B_MAIN, lds + TILE_B, tid);
        __syncthreads();
        for (;;) {
            const int bf = idx & 1; int jn = -1;
            if (um) { jn = __builtin_ctzll(um); um &= um - 1;
                fill_tile(Ks + (size_t)jn * 64 * B_MAIN, ko, B_MAIN, lds + (bf ^ 1) * 2 * TILE_B, tid); fill_tile(Vs + (size_t)jn * 64 * B_MAIN, vo, B_MAIN, lds + (bf ^ 1) * 2 * TILE_B + TILE_B, tid); }
            const bool ms = (mysel >> j) & 1ull;
            if (__any(ms)) {
                f32x16 p0, p1;
                qkt_lds(p0, p1, lds + bf * 2 * TILE_B, r32, hi, lds + NSA_IMP_OFF + wid * 8192 + lane * 16);
                float sl_ = sl2; asm volatile("" : "+v"(sl_));
                const float bb = sl_ * (float)(j * 64 - P0 + 4 * hi); const int dq = !ms ? -1000 : (j == qb) ? (tl - 4 * hi) : 1000;
#pragma unroll
                for (int r = 0; r < 16; ++r) { const int c = (r & 3) + 8 * (r >> 2);
                    p0[r] = (c > dq) ? -__builtin_inff() : fmaf(p0[r], NSA_C2, fmaf(sl_, (float)c, bb));
                    p1[r] = (c + 32 > dq) ? -__builtin_inff() : fmaf(p1[r], NSA_C2, fmaf(sl_, (float)(c + 32), bb)); }
                const float alpha = online_sm(p0, p1, m_s, l_s);
                NSA_RESCALE(o, alpha);
                bf16x8 pa0, pa1, pa2, pa3; pack_p(p0, p1, pa0, pa1, pa2, pa3);
                pv_tile(o, vb_lane + bf * 2 * TILE_B + TILE_B, pa0, pa1, pa2, pa3);
            }
            __syncthreads();
            if (jn < 0) break;
            j = jn; ++idx;
        }
        const float g1 = p.gate[((size_t)b * SEQ + pos) * 48 + Hh * 3 + 1];
        NSA_ACCUM(tot, o, g1 / l_s, false);
    }
    {   NSA_LANE();
        const bf16_t* Kw = proj + 4096 + g * 128; const bf16_t* Vw = proj + 4608 + g * 128;
        const unsigned ko = fill_koff(tid, B_MAIN), vo = fill_voff(tid, B_MAIN);
        float m_w = -1e30f, l_w = 0.f; f32x16 o[4];
#pragma unroll
        for (int d = 0; d < 4; ++d) o[d] = f32x16{};
        const int j0 = qb >= 8 ? qb - 8 : 0, NTw = qb - j0 + 1;
        fill_tile(Kw + (size_t)j0 * 64 * B_MAIN, ko, B_MAIN, lds, tid); fill_tile(Vw + (size_t)j0 * 64 * B_MAIN, vo, B_MAIN, lds + TILE_B, tid);
        __syncthreads();
        for (int t = 0; t < NTw; ++t) {
            const int bf = t & 1, j = j0 + t;
            if (t + 1 < NTw) { fill_tile(Kw + (size_t)(j + 1) * 64 * B_MAIN, ko, B_MAIN, lds + (bf ^ 1) * 2 * TILE_B, tid); fill_tile(Vw + (size_t)(j + 1) * 64 * B_MAIN, vo, B_MAIN, lds + (bf ^ 1) * 2 * TILE_B + TILE_B, tid); }
            f32x16 p0, p1;
            qkt_lds(p0, p1, lds + bf * 2 * TILE_B, r32, hi, lds + NSA_IMP_OFF + wid * 8192 + lane * 16);
            float sl_ = sl2; asm volatile("" : "+v"(sl_));
            const float bb = sl_ * (float)(j * 64 - P0 + 4 * hi);
#pragma unroll
            for (int r = 0; r < 16; ++r) { const int c = (r & 3) + 8 * (r >> 2);
                p0[r] = fmaf(p0[r], NSA_C2, fmaf(sl_, (float)c, bb)); p1[r] = fmaf(p1[r], NSA_C2, fmaf(sl_, (float)(c + 32), bb)); }
            if (j == qb || j == qb - 8) { const int dq = pos - j * 64 - 4 * hi;
#pragma unroll
                for (int r = 0; r < 16; ++r) { const int c = (r & 3) + 8 * (r >> 2);
                    if ((unsigned)(dq - c) >= 512u) p0[r] = -__builtin_inff();
                    if ((unsigned)(dq - c - 32) >= 512u) p1[r] = -__builtin_inff(); } }
            const float alpha = online_sm(p0, p1, m_w, l_w);
            NSA_RESCALE(o, alpha);
            bf16x8 pa0, pa1, pa2, pa3; pack_p(p0, p1, pa0, pa1, pa2, pa3);
            pv_tile(o, vb_lane + bf * 2 * TILE_B + TILE_B, pa0, pa1, pa2, pa3);
            __syncthreads();
        }
        const float g2 = p.gate[((size_t)b * SEQ + pos) * 48 + Hh * 3 + 2];
        NSA_ACCUM(tot, o, g2 / l_w, false);
    }
    {   NSA_LANE();
        bf16_t* st = (bf16_t*)(lds + wid * 8192);
#pragma unroll
        for (int d = 0; d < 4; ++d) {
#pragma unroll
            for (int r = 0; r < 16; ++r) st[crow(r, hi) * 128 + d * 32 + r32] = (bf16_t)((r & 1) ? (tot[d][r >> 1] >> 16) : (tot[d][r >> 1] & 0xffffu));
            SBAR(); }
        asm volatile("s_waitcnt lgkmcnt(0)" ::: "memory");
        bf16_t* ob = p.attn_o + ((size_t)b * SEQ + P0 + th * 32) * D_MODEL + Hh * 128;
#pragma unroll
        for (int i = 0; i < 8; ++i) { const int id = i * 64 + lane, row = id >> 4, cc = id & 15;
            *(u32x4*)(ob + (size_t)row * D_MODEL + cc * 8) = *(const u32x4*)(st + row * 128 + cc * 8); }
    }
    __syncthreads();
}
__device__ __forceinline__ void phase_nsa(CParams& p, char* lds) {
    int it = 0; const int myslot = blockIdx.x % 3;
#pragma unroll 1
    for (int w = wgid_v(lds); w < 512; w += gridDim.x, ++it) {
        if (CONV_MODE == 1 && it == myslot) moe_convert<1>(p, 54, 64, lds);
        const int ww = w & 255, b = ww >> 7, g = (ww >> 5) & 3, qp = ww & 31;
        nsa_unit(p, b, g, w < 256 ? 63 - qp : qp, lds);
    }
    if (CONV_MODE == 1 && myslot >= it) moe_convert<1>(p, 54, 64, lds);
}
__device__ __forceinline__ void load_row(const float* src, int lane, f32x4 (&v)[8]) {
#pragma unroll
    for (int i = 0; i < 8; ++i) v[i] = *(const f32x4*)(src + (i * 64 + lane) * 4);
}
__device__ __forceinline__ void load_row_bf16(const bf16_t* src, int lane, f32x4 (&v)[8]) {
#pragma unroll
    for (int i = 0; i < 8; ++i) { const u32x2 w = *(const u32x2*)(src + (i * 64 + lane) * 4);
        v[i][0] = __uint_as_float(w.x << 16); v[i][1] = __uint_as_float(w.x & 0xffff0000u);
        v[i][2] = __uint_as_float(w.y << 16); v[i][3] = __uint_as_float(w.y & 0xffff0000u); }
}
__device__ __forceinline__ void add_bf16_row(const bf16_t* src, int lane, f32x4 (&v)[8]) {
#pragma unroll
    for (int i = 0; i < 8; ++i) { const u32x2 w = *(const u32x2*)(src + (i * 64 + lane) * 4);
        v[i][0] += __uint_as_float(w.x << 16); v[i][1] += __uint_as_float(w.x & 0xffff0000u);
        v[i][2] += __uint_as_float(w.y << 16); v[i][3] += __uint_as_float(w.y & 0xffff0000u); }
}
__device__ __forceinline__ float row_rstd(const f32x4 (&v)[8]) {
    float ss = 0.f;
#pragma unroll
    for (int i = 0; i < 8; ++i) ss += v[i][0] * v[i][0] + v[i][1] * v[i][1] + v[i][2] * v[i][2] + v[i][3] * v[i][3];
    ss = wave_sum(ss); return rsqrtf(ss * (1.f / D_MODEL) + EPS);
}
__device__ __forceinline__ void norm_store_bf16(f32x4 (&v)[8], float rs, const float* w, bf16_t* dst, int lane) {
#pragma unroll
    for (int i = 0; i < 8; ++i) { const f32x4 wv = *(const f32x4*)(w + (i * 64 + lane) * 4);
        v[i][0] *= rs * wv[0]; v[i][1] *= rs * wv[1]; v[i][2] *= rs * wv[2]; v[i][3] *= rs * wv[3];
        u32x2 o; o.x = cvtpk(v[i][0], v[i][1]); o.y = cvtpk(v[i][2], v[i][3]);
        *(u32x2*)(dst + (i * 64 + lane) * 4) = o; }
}
struct MoeTab { int cnt[32]; int rbase[32]; int ustart[33]; int next; };
__device__ __forceinline__ void moe_tables(const unsigned* cnt, MoeTab* tb) {
    if (tidx() == 0) { int acc = 0;
        for (int e = 0; e < 32; ++e) { const int c = (int)cnt[e]; tb->cnt[e] = c; tb->rbase[e] = acc * 256; tb->ustart[e] = acc * 16; acc += (c + 255) >> 8; }
        tb->ustart[32] = acc * 16; }
    __syncthreads();
}

__device__ __forceinline__ void phase_first(CParams& p, char* lds) {
    const int tid = tidx(), wid = tid >> 6, lane = tid & 63;
    if (blockIdx.x == 0 && tid < 128) p.cnt[tid] = 0u;
    for (int i = blockIdx.x * NTHREADS + tid; i < 2 * 64 * D_MODEL; i += gridDim.x * NTHREADS) { const int l = i >> 17, e = (i >> 11) & 63, k = i & 2047;
        const float w = e < 4 ? p.moe_w_group[((size_t)l * D_MODEL + k) * 4 + e] : e < 36 ? p.moe_w_expert[((size_t)l * D_MODEL + k) * 32 + (e - 4)] : 0.f;
        const bf16_t whi = f2bf(w); p.rw_hi[i] = whi; p.rw_lo[i] = f2bf(w - bf2f(whi)); }
    { const int rstep = gridDim.x * 8;
      for (int row = blockIdx.x * 8 + wid; row < T_TOK; row += 2 * rstep) {
        const int rowb = row + rstep; const bool hb = rowb < T_TOK; const int rb_ = hb ? rowb : row;
        f32x4 va[8], vb[8]; load_row(p.x + (size_t)row * D_MODEL, lane, va); load_row(p.x + (size_t)rb_ * D_MODEL, lane, vb);
        const float rsa = row_rstd(va), rsb = row_rstd(vb);
        norm_store_bf16(va, rsa, p.attn_norm_w, p.xn + (size_t)row * D_MODEL, lane);
        if (hb) norm_store_bf16(vb, rsb, p.attn_norm_w, p.xn + (size_t)rowb * D_MODEL, lane);
      } }
    __syncthreads();
    int job = blockIdx.x; const int stride = gridDim.x;
    convert_weight<0>(p.a_w_in, D_MODEL, A_IN, p.wt_a_in, job, stride, lds);
    convert_weight<0>(p.a_w_out, D_MODEL, D_MODEL, p.wt_a_out, job, stride, lds);
    convert_weight<0>(p.b_w_in, D_MODEL, B_IN, p.wt_b_in, job, stride, lds);
    convert_weight<0>(p.b_w_out, D_MODEL, D_MODEL, p.wt_b_out, job, stride, lds);
    __syncthreads();
#if CONV_MODE == 0
    moe_convert<3>(p, 0, 64, lds);
#endif
}

struct RouteDec { int ea, eb; float wa, wb; };
__device__ __forceinline__ void route_decide(CParams& p, const int layer, const float (&acc)[36], RouteDec* out) {
    const float* bg = p.moe_b_group + layer * 4; const float* be = p.moe_b_expert + layer * 32;
    float lg[4];
#pragma unroll
    for (int j = 0; j < 4; ++j) lg[j] = acc[j] + bg[j];
    int gt = 0; float gm = lg[0];
#pragma unroll
    for (int j = 1; j < 4; ++j) if (lg[j] > gm) { gm = lg[j]; gt = j; }
    float gs = 0.f;
#pragma unroll
    for (int j = 0; j < 4; ++j) gs += __expf(lg[j] - gm);
    const float wgp = 1.f / gs;
    int ea = 0, eb = -1; float m0 = -3.0e38f, m1 = -3.0e38f;
#pragma unroll
    for (int k = 0; k < 32; ++k) { const float v = ((k >> 3) == gt) ? acc[4 + k] + be[k] : -3.0e38f; if (v > m0) { m0 = v; ea = k; } }
#pragma unroll
    for (int k = 0; k < 32; ++k) { const float v = ((k >> 3) == gt && k != ea) ? acc[4 + k] + be[k] : -3.0e38f; if (v > m1) { m1 = v; eb = k; } }
    const float e1 = __expf(m1 - m0);
    out->ea = ea; out->eb = eb; out->wa = wgp / (1.f + e1); out->wb = wgp * e1 / (1.f + e1);
}
#define DPP_ADD(v, CTRL) v += __int_as_float(__builtin_amdgcn_update_dpp(0, __float_as_int(v), CTRL, 0xf, 0xf, false))
__device__ __forceinline__ void reduce36(float (&a)[36]) {
    float u[9];
#pragma unroll
    for (int i = 0; i < 9; ++i) {
        float z[2];
#pragma unroll
        for (int h = 0; h < 2; ++h) {
            const u32x2 s = __builtin_amdgcn_permlane32_swap(__float_as_uint(a[4 * i + 2 * h]), __float_as_uint(a[4 * i + 2 * h + 1]), false, false);
            z[h] = __uint_as_float(s[0]) + __uint_as_float(s[1]); }
        const u32x2 t = __builtin_amdgcn_permlane16_swap(__float_as_uint(z[0]), __float_as_uint(z[1]), false, false);
        float x = __uint_as_float(t[0]) + __uint_as_float(t[1]);
        DPP_ADD(x, 0x128); DPP_ADD(x, 0x124); DPP_ADD(x, 0x122); DPP_ADD(x, 0x121);
        u[i] = x; }
#pragma unroll
    for (int i = 0; i < 9; ++i) {
        a[4 * i + 0] = __int_as_float(__builtin_amdgcn_readlane(__float_as_int(u[i]), 0));  a[4 * i + 2] = __int_as_float(__builtin_amdgcn_readlane(__float_as_int(u[i]), 16));
        a[4 * i + 1] = __int_as_float(__builtin_amdgcn_readlane(__float_as_int(u[i]), 32)); a[4 * i + 3] = __int_as_float(__builtin_amdgcn_readlane(__float_as_int(u[i]), 48)); }
}
#define NR_MAXROWS 512
#define NRW 4
__device__ __forceinline__ void phase_norm_route(CParams& p, const bf16_t* h, const int layer, char* lds) {
    const int tid = tidx(), wid = tid >> 6, lane = tid & 63;
    const float* nw = p.ffn_norm_w + layer * D_MODEL;
    float* fin = (float*)lds;
    float* rsl = (float*)(lds + 57344);
    float* part = (float*)(lds + 65536);
    RouteDec* dec = (RouteDec*)(lds + 40960);
    int* dtok = (int*)(lds + 40960 + NR_MAXROWS * 16);
    int* hist = dtok + NR_MAXROWS;
    int* posa = hist + 64; int* posb = posa + NR_MAXROWS;
    if (tid < 64) hist[tid] = 0;
    int nrows = 0;
    for (int rb = blockIdx.x; rb < T_TOK / (8 * NRW); rb += gridDim.x, nrows += 8 * NRW) {
        const int row0 = rb * (8 * NRW) + wid * NRW;
        float rs[NRW];
#pragma unroll
        for (int r = 0; r < NRW; r += 2) { f32x4 va[8], vb[8];
            load_row_bf16(h + (size_t)(row0 + r) * D_MODEL, lane, va); load_row_bf16(h + (size_t)(row0 + r + 1) * D_MODEL, lane, vb);
            rs[r] = row_rstd(va); rs[r + 1] = row_rstd(vb);
            norm_store_bf16(va, rs[r], nw, p.xn + (size_t)(row0 + r) * D_MODEL, lane);
            norm_store_bf16(vb, rs[r + 1], nw, p.xn + (size_t)(row0 + r + 1) * D_MODEL, lane); }
        if (lane == 0) {
#pragma unroll
            for (int r = 0; r < NRW; ++r) rsl[wid * NRW + r] = rs[r]; }
        __syncthreads();
        { const int j = lane & 31, hi = lane >> 5; const float rsj = rsl[j];
          f32x16 d0 = {}, d1 = {};
          const bf16_t* hrow = h + (size_t)(rb * (8 * NRW) + j) * D_MODEL + wid * 256 + 8 * hi;
          const float* nwp = nw + wid * 256 + 8 * hi;
          const bf16_t* wh = p.rw_hi + ((size_t)(layer * 64 + j) * D_MODEL) + wid * 256 + 8 * hi; const bf16_t* wl = p.rw_lo + ((size_t)(layer * 64 + j) * D_MODEL) + wid * 256 + 8 * hi;
#pragma unroll 4
          for (int ks = 0; ks < 16; ++ks) {
              const u32x4 hv = *(const u32x4*)(hrow + ks * 16); const f32x4 na = *(const f32x4*)(nwp + ks * 16), nb = *(const f32x4*)(nwp + ks * 16 + 4);
              float x[8];
              x[0] = __uint_as_float(hv.x << 16) * (rsj * na[0]); x[1] = __uint_as_float(hv.x & 0xffff0000u) * (rsj * na[1]);
              x[2] = __uint_as_float(hv.y << 16) * (rsj * na[2]); x[3] = __uint_as_float(hv.y & 0xffff0000u) * (rsj * na[3]);
              x[4] = __uint_as_float(hv.z << 16) * (rsj * nb[0]); x[5] = __uint_as_float(hv.z & 0xffff0000u) * (rsj * nb[1]);
              x[6] = __uint_as_float(hv.w << 16) * (rsj * nb[2]); x[7] = __uint_as_float(hv.w & 0xffff0000u) * (rsj * nb[3]);
              u32x4 xh, xl;
              xh.x = cvtpk(x[0], x[1]); xh.y = cvtpk(x[2], x[3]); xh.z = cvtpk(x[4], x[5]); xh.w = cvtpk(x[6], x[7]);
              xl.x = cvtpk(x[0] - __uint_as_float(xh.x << 16), x[1] - __uint_as_float(xh.x & 0xffff0000u)); xl.y = cvtpk(x[2] - __uint_as_float(xh.y << 16), x[3] - __uint_as_float(xh.y & 0xffff0000u));
              xl.z = cvtpk(x[4] - __uint_as_float(xh.z << 16), x[5] - __uint_as_float(xh.z & 0xffff0000u)); xl.w = cvtpk(x[6] - __uint_as_float(xh.w << 16), x[7] - __uint_as_float(xh.w & 0xffff0000u));
              const bf16x8 xhf = __builtin_bit_cast(bf16x8, xh), xlf = __builtin_bit_cast(bf16x8, xl);
              const bf16x8 wh0 = *(const bf16x8*)(wh + ks * 16), wl0 = *(const bf16x8*)(wl + ks * 16);
              const bf16x8 wh1 = *(const bf16x8*)(wh + (size_t)32 * D_MODEL + ks * 16), wl1 = *(const bf16x8*)(wl + (size_t)32 * D_MODEL + ks * 16);
              d0 = __builtin_amdgcn_mfma_f32_32x32x16_bf16(wh0, xhf, d0, 0, 0, 0); d0 = __builtin_amdgcn_mfma_f32_32x32x16_bf16(wl0, xhf, d0, 0, 0, 0); d0 = __builtin_amdgcn_mfma_f32_32x32x16_bf16(wh0, xlf, d0, 0, 0, 0);
              d1 = __builtin_amdgcn_mfma_f32_32x32x16_bf16(wh1, xhf, d1, 0, 0, 0); d1 = __builtin_amdgcn_mfma_f32_32x32x16_bf16(wl1, xhf, d1, 0, 0, 0); d1 = __builtin_amdgcn_mfma_f32_32x32x16_bf16(wh1, xlf, d1, 0, 0, 0); }
          float* pw = part + ((size_t)(wid * 32 + j)) * 40;
#pragma unroll
          for (int r = 0; r < 16; ++r) pw[(r & 3) + 8 * (r >> 2) + 4 * hi] = d0[r];
          if (hi == 0) {
#pragma unroll
              for (int r = 0; r < 4; ++r) pw[32 + r] = d1[r]; } }
        __syncthreads();
        for (int idx = tid; idx < 32 * 36; idx += NTHREADS) { const int row = idx / 36, e = idx - row * 36; float s = 0.f;
#pragma unroll
            for (int w = 0; w < 8; ++w) s += part[(size_t)(w * 32 + row) * 40 + e];
            fin[idx] = s; }
        __syncthreads();
        if (tid < 32 && nrows + tid < NR_MAXROWS) { float acc[36];
#pragma unroll
            for (int e = 0; e < 36; ++e) acc[e] = fin[tid * 36 + e];
            route_decide(p, layer, acc, &dec[nrows + tid]); dtok[nrows + tid] = rb * (8 * NRW) + tid; }
        __syncthreads();
    }
    __syncthreads();
    if (nrows > NR_MAXROWS) nrows = NR_MAXROWS;
    if (tid < nrows) { posa[tid] = atomicAdd(&hist[dec[tid].ea], 1); posb[tid] = atomicAdd(&hist[dec[tid].eb], 1); }
    __syncthreads();
    if (tid < 32) { const int c = hist[tid]; hist[32 + tid] = c ? (int)atomicAdd(p.cnt + layer * 32 + tid, (unsigned)c) : 0; }
    __syncthreads();
    if (tid < nrows) { const RouteDec d = dec[tid]; const int tok = dtok[tid];
        const int ra = hist[32 + d.ea] + posa[tid], rb2 = hist[32 + d.eb] + posb[tid];
        p.list_tok[d.ea * LIST_CAP + ra] = tok; p.list_w[d.ea * LIST_CAP + ra] = d.wa;
        p.list_tok[d.eb * LIST_CAP + rb2] = tok; p.list_w[d.eb * LIST_CAP + rb2] = d.wb;
        p.slot_ref[tok * 2 + 0] = (d.ea << 16) | ra; p.slot_ref[tok * 2 + 1] = (d.eb << 16) | rb2; }
    __syncthreads();
}
template <int MODE>
__device__ __forceinline__ void phase_combine(CParams& p, const bf16_t* hold, bf16_t* hnew, const float* w, const int layer, char* lds) {
    MoeTab* tb = (MoeTab*)lds; (void)layer;
    const int wid = tidx() >> 6, lane = tidx() & 63;
#define CB_FIN(row, v) do { \
        if (MODE == 0) { \
            _Pragma("unroll") for (int i = 0; i < 8; ++i) { u32x2 o; o.x = cvtpk(v[i][0], v[i][1]); o.y = cvtpk(v[i][2], v[i][3]); *(u32x2*)(hnew + (size_t)(row) * D_MODEL + (i * 64 + lane) * 4) = o; } \
            const float rs = row_rstd(v); \
            norm_store_bf16(v, rs, w, p.xn + (size_t)(row) * D_MODEL, lane); \
        } else { \
            const float rs = row_rstd(v); \
            _Pragma("unroll") for (int i = 0; i < 8; ++i) { const f32x4 wv = *(const f32x4*)(w + (i * 64 + lane) * 4); \
                f32x4 o; o[0] = v[i][0] * rs * wv[0]; o[1] = v[i][1] * rs * wv[1]; o[2] = v[i][2] * rs * wv[2]; o[3] = v[i][3] * rs * wv[3]; \
                *(f32x4*)(p.out + (size_t)(row) * D_MODEL + (i * 64 + lane) * 4) = o; } } } while (0)
    const int rstep = gridDim.x * 8;
    for (int row = blockIdx.x * 8 + wid; row < T_TOK; row += 2 * rstep) {
        const int rowb = row + rstep; const bool hb = rowb < T_TOK; const int rb_ = hb ? rowb : row;
        const int a0 = p.slot_ref[row * 2], a1 = p.slot_ref[row * 2 + 1], b0 = p.slot_ref[rb_ * 2], b1 = p.slot_ref[rb_ * 2 + 1];
        f32x4 va[8], vb[8];
        load_row_bf16(hold + (size_t)row * D_MODEL, lane, va); load_row_bf16(hold + (size_t)rb_ * D_MODEL, lane, vb);
        const int ra0 = tb->rbase[a0 >> 16] + (a0 & 0xffff), ra1 = tb->rbase[a1 >> 16] + (a1 & 0xffff);
        const int rb0 = tb->rbase[b0 >> 16] + (b0 & 0xffff), rb1 = tb->rbase[b1 >> 16] + (b1 & 0xffff);
        add_bf16_row(p.ybuf + (size_t)ra0 * D_MODEL, lane, va); add_bf16_row(p.ybuf + (size_t)rb0 * D_MODEL, lane, vb);
        add_bf16_row(p.ybuf + (size_t)ra1 * D_MODEL, lane, va); add_bf16_row(p.ybuf + (size_t)rb1 * D_MODEL, lane, vb);
        CB_FIN(row, va);
        if (hb) CB_FIN(rowb, vb);
    }
#undef CB_FIN
    __syncthreads();
}

#define GEMM_LDS_OFF 1024
#ifdef PROBE_QKV_GT
__device__ __forceinline__ void phase_qkv(CParams& p, char* lds) {
    for (int u = blockIdx.x; u < 32 * 48; u += gridDim.x) { const int mt = u & 31, nt = u >> 5;
        gemm_tile(ARows{p.xn, D_MODEL, mt * 256, T_TOK}, BBf16T{p.wt_a_in, D_MODEL, nt * 128}, EpBf16{p.qkv, A_IN, mt * 256, nt * 128, T_TOK, A_IN}, D_MODEL, lds + GEMM_LDS_OFF, 0xFu); }
}
#else
__device__ __forceinline__ void phase_qkv(CParams& p, char* lds) {
    int it = 0; const int myslot = blockIdx.x & 3;
    for (int u = wgid_v(lds); u < 32 * 24; u += gridDim.x, ++it) { int pm, pn; g8_order_c(u, 32, 24, pm, pn);
        if (CONV_MODE == 1 && it == myslot) moe_convert<1>(p, 0, 16, lds);
        unsigned ao[2][2], bo[2]; g8_offsets2(ao[0], pm * 256, D_MODEL); ao[1][0] = ao[1][1] = 0u; g8_offsets2_perm(bo, pn * 256, D_MODEL);
        gemm8_unit<false>(p.xn, ao, D_MODEL, p.wt_a_in, bo, D_MODEL, lds + GEMM_LDS_OFF, E8Bf16{p.qkv, A_IN, pm * 256, pn * 256, A_IN}, true); }
    if (CONV_MODE == 1 && myslot >= it) moe_convert<1>(p, 0, 16, lds);
}
#endif
template <bool RB>
__device__ __forceinline__ void phase_oproj(CParams& p, const bf16_t* wt, const void* res, bf16_t* hout, char* lds) {
    for (int u = wgid_v(lds); u < 32 * 8; u += gridDim.x) { int pm, pn; g8_order_c(u, 32, 8, pm, pn);
        unsigned ao[2][2], bo[2]; g8_offsets2(ao[0], pm * 256, D_MODEL); ao[1][0] = ao[1][1] = 0u; g8_offsets2_perm(bo, pn * 256, D_MODEL);
        gemm8_unit<false>(p.attn_o, ao, D_MODEL, wt, bo, D_MODEL, lds + GEMM_LDS_OFF, E8ResBf16<RB>{hout, res, pm * 256, pn * 256}, true); }
}
__device__ __forceinline__ void phase_proj(CParams& p, char* lds) {
    int it = 0; const int myslot = blockIdx.x & 3;
    for (int u = wgid_v(lds); u < 32 * 21; u += gridDim.x, ++it) { int pm, pn; g8_order_c(u, 32, 21, pm, pn);
        if (CONV_MODE == 1 && it == myslot) moe_convert<1>(p, 32, 43, lds);
        unsigned ao[2][2], bo[2]; g8_offsets2(ao[0], pm * 256, D_MODEL); ao[1][0] = ao[1][1] = 0u; g8_offsets2_perm(bo, pn * 256, D_MODEL);
        gemm8_unit<false>(p.xn, ao, D_MODEL, p.wt_b_in, bo, D_MODEL, lds + GEMM_LDS_OFF, E8Proj{p.qkv, p.gate, pm * 256, pn * 256}, true); }
    if (CONV_MODE == 1 && myslot >= it) moe_convert<1>(p, 32, 43, lds);
    __syncthreads();
    { const int tid = tidx();
      for (int w = (int)gridDim.x - 1 - wgid_v(lds); w < 64; w += gridDim.x) {
        const int o = tid & 7, ks = tid >> 3, out = w * 8 + o, t = out >> 8, n = out & 255;
        const float* pe = p.b_cmp_pos + (size_t)t * 4096; const float* w1 = p.b_cmp_w1 + (size_t)t * 4096 * 256 + n;
        float s = 0.f;
        for (int k = ks; k < 4096; k += 64) s += pe[k] * w1[(size_t)k * 256];
        float* red = (float*)lds; red[tid] = s; __syncthreads();
        if (tid < 8) { float a = 0.f; for (int i = 0; i < 64; ++i) a += red[i * 8 + tid]; p.cbias[w * 8 + tid] = a; }
        __syncthreads();
      } }
}
__device__ __forceinline__ void phase_cmp1(CParams& p, char* lds) {
    for (int u = blockIdx.x; u < 256; u += gridDim.x) { const int sp = u >> 5, t = (u >> 4) & 1, mt = (u >> 1) & 7, nt = u & 1;
        gemm_tile<true>(ACompress{p.qkv, 2048 + t * 512, mt * 256, sp * 512}, BPlain{p.b_cmp_w1 + ((size_t)t * 4096 + sp * 512) * 256, 256, nt * 128, 256},
                  EpF32{p.cslab + ((size_t)sp * 2 + t) * 2048 * 256, 256, mt * 256, nt * 128}, 512, lds + GEMM_LDS_OFF, 0xFu); }
}
__device__ __forceinline__ void phase_cmp_reduce(CParams& p) {
    for (int i = blockIdx.x * NTHREADS + tidx(); i < 2 * 2048 * 256 / 4; i += gridDim.x * NTHREADS) {
        const int c = (i & 63) * 4, t = i >> 17; f32x4 s = *(const f32x4*)(p.cbias + t * 256 + c);
#pragma unroll
        for (int sp = 0; sp < 8; ++sp) s += *(const f32x4*)(p.cslab + (size_t)sp * 2 * 2048 * 256 + (size_t)i * 4);
        u32x2 w; w.x = cvtpk(gelu_tanh(s[0]), gelu_tanh(s[1])); w.y = cvtpk(gelu_tanh(s[2]), gelu_tanh(s[3]));
        *(u32x2*)(p.chid + (size_t)i * 4) = w; }
}
__device__ __forceinline__ void phase_cmp2(CParams& p, char* lds) {
    for (int u = blockIdx.x; u < 16; u += gridDim.x) { const int t = u >> 3, mt = u & 7;
        gemm_tile<true>(ARows{p.chid + (size_t)t * 2048 * 256, 256, mt * 256, 2048}, BPlain{p.b_cmp_w2 + (size_t)t * 256 * 128, 128, 0, 128},
                  EpBf16{p.kvcmp + (size_t)t * 2048 * 128, 128, mt * 256, 0, 2048, 128}, 256, lds + GEMM_LDS_OFF, 0xFu); }
}
__device__ __forceinline__ int moe_first_unit() { const int w = blockIdx.x; return gridDim.x == 256 ? 32 * (w & 7) + (w >> 3) : w; }
__device__ __forceinline__ bool moe_decode(const MoeTab* tb, int u, int& e, int& mt, int& nt) {
    if (u >= tb->ustart[32]) return false;
    e = 0;
#pragma unroll 1
    for (int i = 1; i < 32; ++i) if (u >= tb->ustart[i]) e = i;
    const int loc = u - tb->ustart[e], tiles = (tb->cnt[e] + 255) >> 8;
    nt = loc / tiles; mt = loc - nt * tiles; return true;
}
__device__ __forceinline__ unsigned moe_rowmask(int cnt, int mt) { const int rem = cnt - mt * 256; return rem >= 193 ? 0xFu : rem >= 129 ? 0x7u : rem >= 65 ? 0x3u : 0x1u; }
__device__ __forceinline__ bool moe_decode8(const MoeTab* tb, int u, int& e, int& mt, int& nt);
#define SCAL(v) __builtin_amdgcn_readfirstlane((int)(v))
__device__ __forceinline__ bool moe_decode8(const MoeTab* tb, int u, int& e, int& mt, int& nt);
__device__ __forceinline__ unsigned moe_rowmask(int cnt, int mt);
struct UpUnits { typedef BGateUp256 BFT; typedef EpSiluMul256 EPT; static constexpr size_t LDB = D_EXPERT;
    CParams& p; const MoeTab* tb; int layer; int u, G, nfull; AGather af; BGateUp256 bf; EpSiluMul256 ep; unsigned rowmask;
    __device__ __forceinline__ bool load() { if (u >= nfull) return false; int e, mt, nt; moe_decode8(tb, u, e, mt, nt); e = SCAL(e); mt = SCAL(mt); nt = SCAL(nt);
        const size_t wo = ((size_t)layer * N_EXPERTS + e) * D_MODEL * D_EXPERT; const int cnt = SCAL(tb->cnt[e]), rb = SCAL(tb->rbase[e]);
        af = AGather{p.xn, D_MODEL, p.list_tok + e * LIST_CAP, mt * 256, cnt}; bf = BGateUp256{p.moe_w_gate + wo, (long long)(p.moe_w_up - p.moe_w_gate), D_EXPERT, nt * 128};
        ep = EpSiluMul256{p.hmid, rb + mt * 256, nt * 128}; rowmask = moe_rowmask(cnt, mt); return true; }
    __device__ __forceinline__ bool first() { return load(); }
    __device__ __forceinline__ bool next() { u += G; return load(); }
};
struct DownUnits { typedef BPlain256 BFT; typedef EpScaleRow256 EPT; static constexpr size_t LDB = D_MODEL;
    CParams& p; const MoeTab* tb; int layer; int u, G, nfull; ARows af; BPlain256 bf; EpScaleRow256 ep; unsigned rowmask;
    __device__ __forceinline__ bool load() { if (u >= nfull) return false; int e, mt, nt; moe_decode8(tb, u, e, mt, nt); e = SCAL(e); mt = SCAL(mt); nt = SCAL(nt);
        const size_t wo = ((size_t)layer * N_EXPERTS + e) * D_EXPERT * D_MODEL; const int cnt = SCAL(tb->cnt[e]), rb = SCAL(tb->rbase[e]), r0 = rb + mt * 256;
        af = ARows{p.hmid, D_EXPERT, r0, rb + cnt}; bf = BPlain256{p.moe_w_down + wo, D_MODEL, nt * 256};
        ep = EpScaleRow256{p.ybuf, p.list_w + e * LIST_CAP, mt * 256, cnt, r0, nt * 256}; rowmask = moe_rowmask(cnt, mt); return true; }
    __device__ __forceinline__ bool first() { return load(); }
    __device__ __forceinline__ bool next() { u += G; return load(); }
};
#define SCAL3(a, b, c) do { a = SCAL(a); b = SCAL(b); c = SCAL(c); } while (0)
template <int PROBE = 0>
__device__ __forceinline__ void phase_moe_up_direct(CParams& p, const int layer, char* lds) {
    MoeTab* tb = (MoeTab*)lds; moe_tables(p.cnt + layer * 32, tb);
    const int T = tb->ustart[32] / 2, G = gridDim.x, nfull = (2 * (T % G) > G) ? T : (T / G) * G;
    bf16_t* const hout = PROBE ? (bf16_t*)p.wgu_t : p.hmid;
    int e, mt, nt;
    if (PROBE == 0) { UpUnits un{p, tb, layer, wgid_v(lds), G, nfull, AGather{}, BGateUp256{}, EpSiluMul256{}, 0u}; gemm_tile256_seq(un, D_MODEL, lds + GEMM_LDS_OFF); }
    else
    for (int u = wgid_v(lds); u < nfull; u += G) { moe_decode8(tb, u, e, mt, nt); SCAL3(e, mt, nt);
        const int eb = PROBE >= 2 ? 0 : e, ntb = PROBE >= 2 ? 0 : nt, ea = PROBE >= 3 ? 0 : e, mta = PROBE >= 3 ? 0 : mt;
        const size_t wo = ((size_t)layer * N_EXPERTS + eb) * D_MODEL * D_EXPERT; const int cnt = SCAL(tb->cnt[e]), rb = SCAL(tb->rbase[e]);
        gemm_tile256(AGather{p.xn, D_MODEL, p.list_tok + ea * LIST_CAP, mta * 256, PROBE >= 3 ? 256 : cnt}, BGateUp256{p.moe_w_gate + wo, (long long)(p.moe_w_up - p.moe_w_gate), D_EXPERT, ntb * 128},
                     EpSiluMul256{hout, rb + mt * 256, nt * 128}, D_MODEL, lds + GEMM_LDS_OFF, moe_rowmask(cnt, mt)); }
    for (int j = wgid_v(lds); j < 2 * (T - nfull); j += G) { moe_decode8(tb, nfull + (j >> 1), e, mt, nt); const int n2 = 2 * nt + (j & 1);
        const int eb = PROBE >= 2 ? 0 : e, n2b = PROBE >= 2 ? 0 : n2, ea = PROBE >= 3 ? 0 : e, mta = PROBE >= 3 ? 0 : mt;
        const size_t wo = ((size_t)layer * N_EXPERTS + eb) * D_MODEL * D_EXPERT; const int cnt = tb->cnt[e];
        gemm_tile(AGather{p.xn, D_MODEL, p.list_tok + ea * LIST_CAP, mta * 256, PROBE >= 3 ? 256 : cnt}, BGateUp{p.moe_w_gate + wo, (long long)(p.moe_w_up - p.moe_w_gate), D_EXPERT, n2b * 64},
                  EpSiluMul{hout, tb->rbase[e] + mt * 256, n2 * 64}, D_MODEL, lds + GEMM_LDS_OFF, moe_rowmask(cnt, mt)); }
    __syncthreads();
}
__device__ __forceinline__ void phase_moe_down_direct(CParams& p, const int layer, char* lds) {
    MoeTab* tb = (MoeTab*)lds; (void)layer;
    const int T = tb->ustart[32] / 2, G = gridDim.x, nfull = (2 * (T % G) > G) ? T : (T / G) * G;
    int e, mt, nt;
    { DownUnits un{p, tb, layer, wgid_v(lds), G, nfull, ARows{}, BPlain256{}, EpScaleRow256{}, 0u}; gemm_tile256_seq(un, D_EXPERT, lds + GEMM_LDS_OFF); }
    for (int j = wgid_v(lds); j < 2 * (T - nfull); j += G) { moe_decode8(tb, nfull + (j >> 1), e, mt, nt); const int n2 = 2 * nt + (j & 1);
        const size_t wo = ((size_t)layer * N_EXPERTS + e) * D_EXPERT * D_MODEL; const int cnt = tb->cnt[e], r0 = tb->rbase[e] + mt * 256;
        gemm_tile(ARows{p.hmid, D_EXPERT, r0, tb->rbase[e] + cnt}, BPlain{p.moe_w_down + wo, D_MODEL, n2 * 128, D_MODEL},
                  EpScaleRow{p.ybuf, p.list_w + e * LIST_CAP, mt * 256, cnt, r0, n2 * 128}, D_EXPERT, lds + GEMM_LDS_OFF, moe_rowmask(cnt, mt)); }
    __syncthreads();
}
__device__ __forceinline__ bool moe_decode8(const MoeTab* tb, int u, int& e, int& mt, int& nt) {
    if (2 * u >= tb->ustart[32]) return false;
    { const int l = tidx() & 63; const int us = tb->ustart[l < 32 ? l : 32];
      const unsigned long long m = __ballot(l < 32 && 2 * u >= us);
      e = 63 - __builtin_clzll(m); }
    const int loc = u - tb->ustart[e] / 2, tiles = (tb->cnt[e] + 255) >> 8;
    nt = loc / tiles; mt = loc - nt * tiles; return true;
}
__device__ __forceinline__ void phase_moe_up(CParams& p, const int layer, char* lds) {
    MoeTab* tb = (MoeTab*)lds; moe_tables(p.cnt + layer * 32, tb);
    int e, mt, nt; int it = 0; const int myslot = blockIdx.x & 1;
    for (int u = blockIdx.x; moe_decode8(tb, u, e, mt, nt); u += gridDim.x, ++it) {
        if (CONV_MODE == 1 && it == myslot) moe_convert<2>(p, layer * 32, layer * 32 + 32, lds + 1024);
        const int cnt = tb->cnt[e]; const int* list = p.list_tok + e * LIST_CAP;
        unsigned ao[2][2], bo[2];
        { const int tid = tidx();
#pragma unroll
          for (int i = 0; i < 2; ++i) { int R, C; stage_rc(tid * 16 + i * 8192, R, C);
#pragma unroll
              for (int h = 0; h < 2; ++h) { const int g = mt * 256 + h * 128 + R; const int tok = g < cnt ? list[g] : 0; ao[h][i] = (unsigned)(tok * D_MODEL + C); } } }
        g8_offsets2(bo, nt * 256, D_MODEL);
        gemm8_unit<true>(p.xn, ao, D_MODEL, p.wgu_t + (size_t)(layer * N_EXPERTS + e) * 2048 * 2048, bo, D_MODEL, lds + GEMM_LDS_OFF,
                   E8SiluMul{p.hmid, tb->rbase[e] + mt * 256, nt * 128}, cnt - mt * 256 > 128); }
    if (CONV_MODE == 1 && myslot >= it) moe_convert<2>(p, layer * 32, layer * 32 + 32, lds + 1024);
    __syncthreads();
}
__device__ __forceinline__ void phase_moe_down(CParams& p, const int layer, char* lds) {
    MoeTab* tb = (MoeTab*)lds; moe_tables(p.cnt + layer * 32, tb);
    int e, mt, nt;
    for (int u = blockIdx.x; moe_decode8(tb, u, e, mt, nt); u += gridDim.x) {
        const int cnt = tb->cnt[e], r0 = tb->rbase[e] + mt * 256;
        unsigned ao[2][2], bo[2]; g8_offsets2(ao[0], r0, D_EXPERT); ao[1][0] = ao[1][1] = 0u; g8_offsets2(bo, nt * 256, D_EXPERT);
        gemm8_unit<false>(p.hmid, ao, D_EXPERT, p.wd_t + (size_t)(layer * N_EXPERTS + e) * 2048 * 1024, bo, D_EXPERT, lds + GEMM_LDS_OFF,
                   E8ScaleRow{p.ybuf, p.list_w + e * LIST_CAP, mt * 256, cnt, r0, nt * 256}, cnt - mt * 256 > 128); }
    __syncthreads();
}

#define NPHASE 18
template <int PH> __device__ __forceinline__ void run_phase(CParams& p, char* lds) {
    if (PH == 0) phase_first(p, lds);
    if (PH == 1) phase_qkv(p, lds);
    if (PH == 2) phase_diff_attn(p, lds);
    if (PH == 3) phase_oproj<false>(p, p.wt_a_out, p.x, p.h1, lds);
    if (PH == 4) phase_norm_route(p, p.h1, 0, lds);
    if (PH == 5) { if (MOE_G8) phase_moe_up(p, 0, lds); else phase_moe_up_direct(p, 0, lds); }
    if (PH == 6) { if (MOE_G8) phase_moe_down(p, 0, lds); else phase_moe_down_direct(p, 0, lds); }
    if (PH == 7) phase_combine<0>(p, p.h1, p.h2, p.attn_norm_w + D_MODEL, 0, lds);
    if (PH == 8) phase_proj(p, lds);
    if (PH == 9) phase_cmp1(p, lds);
    if (PH == 10) phase_cmp_reduce(p);
    if (PH == 11) phase_cmp2(p, lds);
    if (PH == 12) phase_nsa(p, lds);
    if (PH == 13) phase_oproj<true>(p, p.wt_b_out, p.h2, p.h1, lds);
    if (PH == 14) phase_norm_route(p, p.h1, 1, lds);
    if (PH == 15) { if (MOE_G8) phase_moe_up(p, 1, lds); else phase_moe_up_direct(p, 1, lds); }
    if (PH == 16) { if (MOE_G8) phase_moe_down(p, 1, lds); else phase_moe_down_direct(p, 1, lds); }
    if (PH == 17) phase_combine<1>(p, p.h1, nullptr, p.final_norm_w, 1, lds);
}
#if defined(ONLY_PH)
#define PHASE(PH) do { if (PH == ONLY_PH) { CParams* q_ = kp; asm volatile("" : "+s"(q_)); run_phase<PH>(*q_, lds); } } while (0)
#elif N_LAUNCH_MODE == 1
#ifndef DUP_MASK
#define DUP_MASK 0
#endif
#define PHASE(PH) do { { CParams* q_ = kp; asm volatile("" : "+s"(q_)); run_phase<PH>(*q_, lds); } \
        if ((DUP_MASK >> PH) & 1) { xcd_barrier(bar); CParams* q_ = kp; asm volatile("" : "+s"(q_)); run_phase<PH>(*q_, lds); } \
        if (PH + 1 < NPHASE) xcd_barrier(bar); } while (0)
#else
#define PHASE(PH) do { if (kp->phase_lo == PH) { CParams* q_ = kp; asm volatile("" : "+s"(q_)); run_phase<PH>(*q_, lds); } } while (0)
#endif
__global__ void __launch_bounds__(NTHREADS, 2) fwd_kernel(Params p_unused) {
    extern __shared__ __attribute__((aligned(16))) char lds[];
    CParams* kp = (CParams*)__builtin_amdgcn_kernarg_segment_ptr();
    if (threadIdx.x == 0) *(uint4*)(lds + LDS_BYTES - 16) = make_uint4(0u, 0u, 0u, 0u);
    __syncthreads();
    XcdBarrier bar = xcd_barrier_post(kp->bar, (volatile LAS unsigned*)(lds + LDS_BYTES - 16));
    (void)bar;
    PHASE(0);
#if N_LAUNCH_MODE == 1 && !defined(ONLY_PH)
    { volatile LAS unsigned* st_ = (volatile LAS unsigned*)(lds + LDS_BYTES - 16);
      if (threadIdx.x == 0) { unsigned base_ = 0u;
          _Pragma("unroll") for (unsigned j = 0; j < 16; ++j) { const unsigned c_ = xb_ld(&bar.bar[XB_XCNT(j)]); base_ += j < bar.x ? c_ : 0u; }
          st_[2] = base_ + bar.rank; }
      __syncthreads(); }
#endif
    PHASE(1); PHASE(2); PHASE(3); PHASE(4); PHASE(5);
#if defined(PROBE_UP) && N_LAUNCH_MODE == 1 && !defined(ONLY_PH)
    { CParams* q_ = kp; asm volatile("" : "+s"(q_)); phase_moe_up_direct<PROBE_UP>(*q_, 0, lds); xcd_barrier(bar); }
#endif
    PHASE(6); PHASE(7); PHASE(8);
    PHASE(9); PHASE(10); PHASE(11); PHASE(12); PHASE(13); PHASE(14); PHASE(15); PHASE(16); PHASE(17);
}

static inline size_t al256(size_t v) { return (v + 255) & ~(size_t)255; }
extern "C" void kernel_launch(void* const* d_in, const int* in_sizes, int n_in, void* d_out, int out_size, void* d_ws, size_t ws_size, hipStream_t stream) {
    (void)in_sizes; (void)n_in; (void)out_size; (void)ws_size;
    Params p; memset(&p, 0, sizeof(p));
    p.x = (const float*)d_in[0]; p.attn_norm_w = (const float*)d_in[1]; p.ffn_norm_w = (const float*)d_in[2]; p.final_norm_w = (const float*)d_in[3];
    p.a_w_in = (const float*)d_in[4]; p.a_lambda = (const float*)d_in[5]; p.a_subln_w = (const float*)d_in[6]; p.a_w_out = (const float*)d_in[7];
    p.b_w_in = (const float*)d_in[8]; p.b_cmp_pos = (const float*)d_in[9]; p.b_cmp_w1 = (const float*)d_in[10]; p.b_cmp_w2 = (const float*)d_in[11]; p.b_w_out = (const float*)d_in[12];
    p.moe_w_group = (const float*)d_in[13]; p.moe_b_group = (const float*)d_in[14]; p.moe_w_expert = (const float*)d_in[15]; p.moe_b_expert = (const float*)d_in[16];
    p.moe_w_gate = (const float*)d_in[17]; p.moe_w_up = (const float*)d_in[18]; p.moe_w_down = (const float*)d_in[19];
    p.out = (float*)d_out;
    char* w = (char*)d_ws; size_t off = 0;
#define CARVE(ptr, type, bytes) do { ptr = (type)(w + off); off = al256(off + (size_t)(bytes)); } while (0)
    CARVE(p.bar, unsigned*, XCD_BAR_WORDS * 4);
    CARVE(p.cnt, unsigned*, 128 * 4);
    CARVE(p.rw_hi, bf16_t*, (size_t)2 * 64 * D_MODEL * 2);
    CARVE(p.rw_lo, bf16_t*, (size_t)2 * 64 * D_MODEL * 2);
    CARVE(p.diag, unsigned*, 256 * 4);
    CARVE(p.xn, bf16_t*, (size_t)T_TOK * D_MODEL * 2);
    CARVE(p.qkv, bf16_t*, (size_t)T_TOK * A_IN * 2);
    CARVE(p.gate, float*, (size_t)T_TOK * 48 * 4);
    CARVE(p.attn_o, bf16_t*, (size_t)T_TOK * D_MODEL * 2);
    CARVE(p.h1, bf16_t*, (size_t)T_TOK * D_MODEL * 2);
    CARVE(p.h2, bf16_t*, (size_t)T_TOK * D_MODEL * 2);
    CARVE(p.hmid, bf16_t*, (size_t)MAX_ROWS * D_EXPERT * 2);
    CARVE(p.ybuf, bf16_t*, (size_t)MAX_ROWS * D_MODEL * 2);
    CARVE(p.list_tok, int*, (size_t)32 * LIST_CAP * 4);
    CARVE(p.list_w, float*, (size_t)32 * LIST_CAP * 4);
    CARVE(p.slot_ref, int*, (size_t)T_TOK * 2 * 4);
    CARVE(p.cbias, float*, 512 * 4);
    CARVE(p.cslab, float*, (size_t)8 * 2 * 2048 * 256 * 4);
    CARVE(p.chid, bf16_t*, (size_t)2 * 2048 * 256 * 2);
    CARVE(p.kvcmp, bf16_t*, (size_t)2 * 2048 * 128 * 2);
    CARVE(p.wt_a_in, bf16_t*, (size_t)A_IN * D_MODEL * 2);
    CARVE(p.wt_a_out, bf16_t*, (size_t)D_MODEL * D_MODEL * 2);
    CARVE(p.wt_b_in, bf16_t*, (size_t)5376 * D_MODEL * 2);
    CARVE(p.wt_b_out, bf16_t*, (size_t)D_MODEL * D_MODEL * 2);
    CARVE(p.wgu_t, bf16_t*, (size_t)64 * 2048 * 2048 * 2);
    CARVE(p.wd_t, bf16_t*, (size_t)64 * 2048 * 1024 * 2);
    static int grid = 0;
    if (!grid) {
        (void)hipFuncSetAttribute((const void*)fwd_kernel, hipFuncAttributeMaxDynamicSharedMemorySize, LDS_BYTES);
        int dev = 0, cus = 0, per_cu = 0;
        (void)hipGetDevice(&dev);
        if (hipDeviceGetAttribute(&cus, hipDeviceAttributeMultiprocessorCount, dev) != hipSuccess || cus <= 0) cus = 256;
        if (hipOccupancyMaxActiveBlocksPerMultiprocessor(&per_cu, (const void*)fwd_kernel, NTHREADS, LDS_BYTES) != hipSuccess || per_cu < 1) per_cu = 1;
        grid = cus * 1;
        if (grid > 256) grid = 256;
    }
    (void)hipMemsetAsync(p.bar, 0, XCD_BAR_WORDS * 4, stream);
#if N_LAUNCH_MODE == 1
    p.phase_lo = 0; p.phase_hi = NPHASE;
    hipLaunchKernelGGL(fwd_kernel, dim3(grid), dim3(NTHREADS), LDS_BYTES, stream, p);
#else
    for (int ph = 0; ph < NPHASE; ++ph) { p.phase_lo = ph; p.phase_hi = ph + 1; hipLaunchKernelGGL(fwd_kernel, dim3(grid), dim3(NTHREADS), LDS_BYTES, stream, p); }
#endif
}
```

```cpp
#include <hip/hip_runtime.h>
#include <stdint.h>
#include <stdio.h>
#include <string.h>

#ifndef CONV_MODE
#define CONV_MODE 2
#endif
#ifndef MOE_G8
#define MOE_G8 0
#endif
#ifndef PP_MODE
#define PP_MODE 1
#endif
#ifndef N_LAUNCH_MODE
#define N_LAUNCH_MODE 1
#endif

#define D_MODEL 2048
#define BATCH 2
#define SEQ 4096
#define T_TOK (BATCH * SEQ)
#define A_HEADS 8
#define A_IN 6144
#define B_HEADS 16
#define B_GROUPS 4
#define B_IN 5168
#define B_MAIN 5120
#define NC 255
#define N_EXPERTS 32
#define D_EXPERT 1024
#define LIST_CAP 8192
#define MAX_ROWS (16384 + 32 * 256)
#define EPS 1e-6f

typedef unsigned short bf16_t;
typedef short bf16x8 __attribute__((ext_vector_type(8)));
typedef short s16x4 __attribute__((ext_vector_type(4)));
typedef float f32x4 __attribute__((ext_vector_type(4)));
typedef float f32x16 __attribute__((ext_vector_type(16)));
typedef unsigned u32x4 __attribute__((ext_vector_type(4)));
typedef unsigned u32x2 __attribute__((ext_vector_type(2)));

#define NTHREADS 512
#define LDS_BYTES (160 * 1024 - 256)

__device__ __forceinline__ unsigned cvtpk(float lo, float hi) {
    unsigned r; asm volatile("v_cvt_pk_bf16_f32 %0, %1, %2" : "=v"(r) : "v"(lo), "v"(hi)); return r;
}
__device__ __forceinline__ float bf2f(bf16_t v) { return __uint_as_float(((unsigned)v) << 16); }
__device__ __forceinline__ bf16_t f2bf(float f) { return (bf16_t)(cvtpk(f, 0.f) & 0xffffu); }
__device__ __forceinline__ int tidx() { int t = threadIdx.x; asm volatile("" : "+v"(t)); return t; }
template <int O> __device__ __forceinline__ int shx_i(int v) {
    if constexpr (O < 32) return __builtin_amdgcn_ds_swizzle(v, (O << 10) | 0x1f);
    else { const int l = tidx(); return __builtin_amdgcn_ds_bpermute(((l & 63) ^ 32) << 2, v); }
}
template <int O> __device__ __forceinline__ float shx(float v) { return __int_as_float(shx_i<O>(__float_as_int(v))); }
__device__ __forceinline__ float wave_sum(float v) {
    v += shx<32>(v); v += shx<16>(v); v += shx<8>(v); v += shx<4>(v); v += shx<2>(v); v += shx<1>(v);
    return v;
}

#define XB_TMO      128
#define XB_XCNT(j)  (256  + 64 * (j))
#define XB_XSUB(j)  (1280 + 64 * (j))
#define XB_XGEN(j)  (2304 + 64 * (j))
#define XB_TOP      3328
#define XB_TOPGEN   3392
#define XCD_BAR_WORDS 3456
#define XB_SPIN_CAP (1u << 22)
#define LAS __attribute__((address_space(3)))

__device__ __forceinline__ unsigned xb_ld(unsigned* p)              { return __hip_atomic_load(p, __ATOMIC_RELAXED, __HIP_MEMORY_SCOPE_AGENT); }
__device__ __forceinline__ unsigned xb_add(unsigned* p, unsigned v) { return __hip_atomic_fetch_add(p, v, __ATOMIC_RELAXED, __HIP_MEMORY_SCOPE_AGENT); }
__device__ __forceinline__ unsigned xb_xcc_id() { return (unsigned)__builtin_amdgcn_s_getreg((3 << 11) | 20) & 0xFu; }
#define XB_SPIN(cond, bar) do { unsigned _sp = 0; while (cond) { __builtin_amdgcn_s_sleep(1); \
    if ((++_sp & 255u) == 0u) { if (xb_ld(&(bar)[XB_TMO])) break; if (_sp > XB_SPIN_CAP) { atomicAdd(&(bar)[XB_TMO], 1u); break; } } } } while (0)

struct XcdBarrier { unsigned* bar; unsigned x; volatile LAS unsigned* st; unsigned rank; };

__device__ __forceinline__ XcdBarrier xcd_barrier_post(unsigned* bar, volatile LAS unsigned* st) {
    XcdBarrier b; b.bar = bar; b.x = xb_xcc_id(); b.st = st; b.rank = 0u;
    if (threadIdx.x == 0) b.rank = xb_add(&bar[XB_XCNT(b.x)], 1u);
    return b;
}
__device__ __forceinline__ void xcd_barrier_complete(unsigned* bar, unsigned x, unsigned& nloc, unsigned& nx) {
    const unsigned G = gridDim.x * gridDim.y * gridDim.z;
    unsigned sum, cnt, mine, sp = 0u;
    for (;;) {
        sum = 0u; cnt = 0u; mine = 0u;
#pragma unroll
        for (unsigned j = 0; j < 16; ++j) { const unsigned c = xb_ld(&bar[XB_XCNT(j)]); sum += c; cnt += (c > 0u) ? 1u : 0u; mine = (j == x) ? c : mine; }
        if (sum == G) break;
        __builtin_amdgcn_s_sleep(1);
        if ((++sp & 255u) == 0u) { if (xb_ld(&bar[XB_TMO])) break; if (sp > XB_SPIN_CAP) { atomicAdd(&bar[XB_TMO], 1u); break; } }
    }
    nloc = mine > 0u ? mine : 1u; nx = cnt > 0u ? cnt : 1u;
}
__device__ __forceinline__ void xcd_barrier(const XcdBarrier& b) {
    asm volatile("s_waitcnt vmcnt(0)" ::: "memory");
    __syncthreads();
    if (threadIdx.x == 0) {
        unsigned* bar = b.bar;
        __builtin_amdgcn_s_waitcnt(0);
        unsigned nloc = b.st[0], nx = b.st[1];
        if (nloc == 0u) { xcd_barrier_complete(bar, b.x, nloc, nx); b.st[0] = nloc; b.st[1] = nx; }
        const unsigned old = xb_add(&bar[XB_XSUB(b.x)], 1u);
        const unsigned gen = old / nloc;
        if (old + 1u == (gen + 1u) * nloc) {
            __builtin_amdgcn_fence(__ATOMIC_RELEASE, "agent");
            asm volatile("s_waitcnt vmcnt(0)" ::: "memory");
            const unsigned og = xb_add(&bar[XB_TOP], 1u);
            const unsigned tg = og / nx;
            if (og + 1u == (tg + 1u) * nx) xb_add(&bar[XB_TOPGEN], 1u);
            else XB_SPIN(xb_ld(&bar[XB_TOPGEN]) == tg, bar);
            __builtin_amdgcn_fence(__ATOMIC_ACQUIRE, "agent");
            xb_add(&bar[XB_XGEN(b.x)], 1u);
            asm volatile("s_waitcnt vmcnt(0)" ::: "memory");
        } else {
            XB_SPIN(xb_ld(&bar[XB_XGEN(b.x)]) == gen, bar);
            __builtin_amdgcn_fence(__ATOMIC_ACQUIRE, "agent");
            asm volatile("s_waitcnt vmcnt(0)" ::: "memory");
        }
    }
    __syncthreads();
}

__device__ __forceinline__ int wgid_v(char* lds);
struct Params {
    const float* x; const float* attn_norm_w; const float* ffn_norm_w; const float* final_norm_w;
    const float* a_w_in; const float* a_lambda; const float* a_subln_w; const float* a_w_out;
    const float* b_w_in; const float* b_cmp_pos; const float* b_cmp_w1; const float* b_cmp_w2; const float* b_w_out;
    const float* moe_w_group; const float* moe_b_group; const float* moe_w_expert; const float* moe_b_expert;
    const float* moe_w_gate; const float* moe_w_up; const float* moe_w_down;
    float* out;
    unsigned* bar;
    unsigned* cnt;
    bf16_t* xn;
    bf16_t* qkv;
    float* gate;
    bf16_t* attn_o;
    bf16_t* h1;
    bf16_t* h2;
    bf16_t* rw_hi;
    bf16_t* rw_lo;
    bf16_t* hmid;
    bf16_t* ybuf;
    int* list_tok;
    float* list_w;
    int* slot_ref;
    float* cbias;
    float* cslab;
    bf16_t* chid;
    bf16_t* kvcmp;
    bf16_t* wt_a_in; bf16_t* wt_a_out; bf16_t* wt_b_in; bf16_t* wt_b_out;
    bf16_t* wgu_t; bf16_t* wd_t;
    unsigned* diag;
    int phase_lo, phase_hi;
};
typedef const __attribute__((address_space(4))) Params CParams;

__device__ __forceinline__ int lds_byte(int r, int c) { const int st = (r >> 4) * 2 + (c >> 5), rr = r & 15, cc = c & 31, ob = rr * 64 + cc * 2; return st * 1024 + (ob ^ (((ob >> 9) & 1) << 5)); }

#define G_BM 256
#define G_BN 128
#define G_BK 64
#define G_ABYTES (G_BM * G_BK * 2)
#define G_BBYTES (G_BN * G_BK * 2)
#define G_BUF (G_ABYTES + G_BBYTES)

template <bool LIGHT = false, class AF, class BF, class EP>
__device__ __forceinline__ void gemm_tile(const AF& af, const BF& bf, const EP& ep, const int K, char* lds, const unsigned rowmask  ) {
    const int tid = tidx(), wid = tid >> 6, lane = tid & 63, wr = wid >> 1, wc = wid & 1, fr = lane & 15, fq = lane >> 4;
    f32x4 acc[4][4];
#pragma unroll
    for (int m = 0; m < 4; ++m)
#pragma unroll
        for (int n = 0; n < 4; ++n) acc[m][n] = (f32x4){0.f, 0.f, 0.f, 0.f};
    const int a_r0 = tid >> 3, a_kc = (tid & 7) * 8;
    const bf16_t* ap[4]; unsigned avm = 0u;
#pragma unroll
    for (int i = 0; i < 4; ++i) { ap[i] = af.a_row(a_r0 + 64 * i); if (ap[i]) avm |= 1u << i; else ap[i] = af.safe(); }
    const int b_nb = (lane & 7) + 8 * (wid >> 1), b_kb = (lane >> 3) + 8 * (wid & 1);
    const float* bp = bf.colptr(4 * b_nb); const bool bvm = bp != nullptr; if (!bvm) bp = bf.safe();
    const bf16_t* bt16 = bf.bt16();
    const size_t ldb = bf.ldb;
    u32x4 ar0[4], ar1[4], ar2[4]; f32x4 br0[4], br1[4], br2[4];
    const int nk = K / G_BK;
    const bool act = (rowmask >> wr) & 1u;
    const int sa_base = lds_byte(a_r0, a_kc), sb_base = lds_byte(4 * b_nb, 4 * b_kb);
    const int fa_base = lds_byte(wr * 64 + fr, fq * 8), fb_base = lds_byte(wc * 64 + fr, fq * 8);

#define G_LOAD(kt, AR, BR) do { const int k0_ = (kt) * G_BK; const int ko_ = af.koff(k0_) + a_kc; \
        _Pragma("unroll") for (int i = 0; i < 4; ++i) AR[i] = *(const u32x4*)(ap[i] + ko_); \
        if (BF::IS_BF16) { _Pragma("unroll") for (int i = 0; i < 2; ++i) BR[i] = *(const f32x4*)(bt16 + (size_t)(a_r0 + 64 * i) * ldb + k0_ + a_kc); } \
        else { _Pragma("unroll") for (int i = 0; i < 4; ++i) BR[i] = *(const f32x4*)(bp + (size_t)(k0_ + 4 * b_kb + i) * ldb); } } while (0)
#define G_STORE(kt, AR, BR) do { char* A_ = lds + ((kt) & 1) * G_BUF; char* B_ = A_ + G_ABYTES; \
        _Pragma("unroll") for (int i = 0; i < 4; ++i) *(u32x4*)(A_ + sa_base + i * 8192) = ((avm >> i) & 1u) ? AR[i] : (u32x4){0u, 0u, 0u, 0u}; \
        _Pragma("unroll") for (int j = 0; j < 4; ++j) { u32x2 w_; w_.x = cvtpk(BR[0][j], BR[1][j]); w_.y = cvtpk(BR[2][j], BR[3][j]); if (!bvm) { w_.x = 0u; w_.y = 0u; } \
            *(u32x2*)(B_ + sb_base + j * 64) = w_; } } while (0)
#define G_COMPUTE(kt) do { if (act) { const char* A_ = lds + ((kt) & 1) * G_BUF; const char* B_ = A_ + G_ABYTES; \
        _Pragma("unroll") for (int ks = 0; ks < 2; ++ks) { bf16x8 a[4], b[4]; \
            _Pragma("unroll") for (int m = 0; m < 4; ++m) a[m] = *(const bf16x8*)(A_ + fa_base + m * 2048 + ks * 1024); \
            _Pragma("unroll") for (int n = 0; n < 4; ++n) b[n] = *(const bf16x8*)(B_ + fb_base + n * 2048 + ks * 1024); \
            _Pragma("unroll") for (int m = 0; m < 4; ++m) _Pragma("unroll") for (int n = 0; n < 4; ++n) \
                acc[m][n] = __builtin_amdgcn_mfma_f32_16x16x32_bf16(b[n], a[m], acc[m][n], 0, 0, 0); } } } while (0)
#define G_STEP(kt, ARc, BRc, ARn, BRn) do { G_LOAD((kt) + 3, ARc, BRc); G_COMPUTE(kt); G_STORE((kt) + 1, ARn, BRn); __syncthreads(); } while (0)
#define G_TAIL(kt, ARn, BRn) do { if ((kt) < nk) { G_COMPUTE(kt); if ((kt) + 1 < nk) G_STORE((kt) + 1, ARn, BRn); __syncthreads(); } } while (0)

    if (LIGHT) {
        G_LOAD(0, ar0, br0); G_STORE(0, ar0, br0); __syncthreads();
        for (int k1 = 0; k1 < nk; ++k1) { if (k1 + 1 < nk) G_LOAD(k1 + 1, ar0, br0); G_COMPUTE(k1); if (k1 + 1 < nk) G_STORE(k1 + 1, ar0, br0); __syncthreads(); }
        if (act) ep(acc, wr, wc, fr, fq);
        __syncthreads();
        return;
    }
#if PP_MODE == 0
    G_LOAD(0, ar0, br0); G_LOAD(1, ar1, br1); G_LOAD(2, ar2, br2);
    G_STORE(0, ar0, br0);
    __syncthreads();
    { int kt = 0;
      for (; kt + 5 < nk; kt += 3) { G_STEP(kt, ar0, br0, ar1, br1); G_STEP(kt + 1, ar1, br1, ar2, br2); G_STEP(kt + 2, ar2, br2, ar0, br0); }
      if (kt + 3 < nk) G_LOAD(kt + 3, ar0, br0);
      G_COMPUTE(kt); if (kt + 1 < nk) G_STORE(kt + 1, ar1, br1); __syncthreads();
      if (kt + 4 < nk) G_LOAD(kt + 4, ar1, br1);
      G_TAIL(kt + 1, ar2, br2); G_TAIL(kt + 2, ar0, br0); G_TAIL(kt + 3, ar1, br1); G_TAIL(kt + 4, ar2, br2); }
#else
#define PP_STAGE(t) (lds + ((t) % 3) * G_BUF)
#define PP_STORE(t, AR, BR) do { char* A_ = PP_STAGE(t); char* B_ = A_ + G_ABYTES; \
        _Pragma("unroll") for (int i = 0; i < 4; ++i) *(u32x4*)(A_ + sa_base + i * 8192) = ((avm >> i) & 1u) ? AR[i] : (u32x4){0u, 0u, 0u, 0u}; \
        if (BF::IS_BF16) { _Pragma("unroll") for (int i = 0; i < 2; ++i) *(f32x4*)(B_ + sa_base + i * 8192) = BR[i]; } \
        else { _Pragma("unroll") for (int j = 0; j < 4; ++j) { u32x2 w_; w_.x = cvtpk(BR[0][j], BR[1][j]); w_.y = cvtpk(BR[2][j], BR[3][j]); if (!bvm) { w_.x = 0u; w_.y = 0u; } \
            *(u32x2*)(B_ + sb_base + j * 64) = w_; } } } while (0)
#define PP_READ(t, ks) do { if (act) { const char* A_ = PP_STAGE(t); const char* B_ = A_ + G_ABYTES; \
        _Pragma("unroll") for (int m = 0; m < 4; ++m) fa[m] = *(const bf16x8*)(A_ + fa_base + m * 2048 + (ks) * 1024); \
        _Pragma("unroll") for (int n = 0; n < 4; ++n) fb[n] = *(const bf16x8*)(B_ + fb_base + n * 2048 + (ks) * 1024); } } while (0)
#define PP_MMA() do { if (act) { __builtin_amdgcn_s_setprio(1); \
        _Pragma("unroll") for (int m = 0; m < 4; ++m) _Pragma("unroll") for (int n = 0; n < 4; ++n) \
            acc[m][n] = __builtin_amdgcn_mfma_f32_16x16x32_bf16(fb[n], fa[m], acc[m][n], 0, 0, 0); \
        __builtin_amdgcn_s_setprio(0); } } while (0)
#define PP_BAR() __builtin_amdgcn_s_barrier()
#define PP_WL() asm volatile("s_waitcnt lgkmcnt(0)" ::: "memory")
#define PP_STEP(kt, ARs, BRs, DOLOAD, DOSTORE) do { \
        PP_READ(kt, 0); PP_BAR(); PP_WL(); PP_MMA(); PP_BAR(); \
        PP_READ(kt, 1); if (DOSTORE) PP_STORE((kt) + 2, ARs, BRs); if (DOLOAD) G_LOAD((kt) + 5, ARs, BRs); PP_BAR(); PP_WL(); PP_MMA(); PP_BAR(); } while (0)
    bf16x8 fa[4], fb[4];
    const bool grp1 = wid >= 4;
    G_LOAD(0, ar0, br0); G_LOAD(1, ar1, br1); G_LOAD(2, ar2, br2);
    PP_STORE(0, ar0, br0); G_LOAD(3, ar0, br0);
    PP_STORE(1, ar1, br1); G_LOAD(4, ar1, br1);
    asm volatile("s_waitcnt lgkmcnt(0)" ::: "memory");
    __syncthreads();
    if (grp1) PP_BAR();
    int kt = 0;
    for (; kt + 7 < nk; kt += 3) {
        PP_STEP(kt, ar2, br2, true, true);
        PP_STEP(kt + 1, ar0, br0, true, true);
        PP_STEP(kt + 2, ar1, br1, true, true);
    }
#define PP_TAIL(kk, ARs, BRs) do { if ((kk) < nk) { const bool ld_ = (kk) + 5 < nk, st_ = (kk) + 2 < nk; \
        PP_READ(kk, 0); PP_BAR(); PP_WL(); PP_MMA(); PP_BAR(); \
        PP_READ(kk, 1); if (st_) PP_STORE((kk) + 2, ARs, BRs); if (ld_) G_LOAD((kk) + 5, ARs, BRs); PP_BAR(); PP_WL(); PP_MMA(); PP_BAR(); } } while (0)
    PP_TAIL(kt, ar2, br2); PP_TAIL(kt + 1, ar0, br0); PP_TAIL(kt + 2, ar1, br1);
    PP_TAIL(kt + 3, ar2, br2); PP_TAIL(kt + 4, ar0, br0); PP_TAIL(kt + 5, ar1, br1); PP_TAIL(kt + 6, ar2, br2);
    if (!grp1) PP_BAR();
#endif
#undef PP_STAGE
#undef PP_STORE
#undef PP_READ
#undef PP_MMA
#undef PP_BAR
#undef PP_WL
#undef PP_STEP
#undef PP_TAIL
#undef G_LOAD
#undef G_STORE
#undef G_COMPUTE
#undef G_STEP
#undef G_TAIL
    if (act) ep(acc, wr, wc, fr, fq);
    __syncthreads();
}

#define G2_BUF (G_ABYTES + 2 * G_BBYTES)
__device__ __forceinline__ void stage_rc(int b, int& R, int& C);
__device__ __forceinline__ void glds16_asm(const void* gsrc, unsigned lds_dst) {
    unsigned keep;
    asm volatile("s_mov_b32 %0, m0\n\ts_mov_b32 m0, %2\n\ts_nop 0\n\tglobal_load_lds_dwordx4 %1, off\n\ts_mov_b32 m0, %0" : "=&s"(keep) : "v"(gsrc), "s"(lds_dst) : "memory");
}
__device__ __forceinline__ void glds16_asm_s(const void* sbase, unsigned voff, unsigned lds_dst) {
    unsigned keep;
    asm volatile("s_mov_b32 %0, m0\n\ts_mov_b32 m0, %3\n\ts_nop 0\n\tglobal_load_lds_dwordx4 %1, %2\n\ts_mov_b32 m0, %0" : "=&s"(keep) : "v"(voff), "s"(sbase), "s"(lds_dst) : "memory");
}
template <class AF, class BF, class EP>
__device__ __forceinline__ void gemm_tile256(const AF& af, const BF& bf, const EP& ep, const int K, char* lds, const unsigned rowmask) {
    const int tid = tidx(), wid = __builtin_amdgcn_readfirstlane(tid >> 6), lane = tid & 63, wr = wid >> 1, wc = wid & 1, fr = lane & 15, fq = lane >> 4;
    f32x4 acc[4][8];
#pragma unroll
    for (int m = 0; m < 4; ++m)
#pragma unroll
        for (int n = 0; n < 8; ++n) acc[m][n] = (f32x4){0.f, 0.f, 0.f, 0.f};
    const bf16_t* abase = af.safe(); unsigned aoff[4];
#pragma unroll
    for (int i = 0; i < 4; ++i) { int R, C; stage_rc(tid * 16 + (i & 1) * 8192, R, C);
        aoff[i] = 2u * (af.a_off((i >> 1) * 128 + R) + (unsigned)C); }
    const unsigned lds_a = (unsigned)(uintptr_t)lds + (unsigned)wid * 1024u;
    const int b_nl = (lane & 3) + 4 * ((lane >> 5) & 1), b_kl = ((lane >> 2) & 3) + 4 * ((lane >> 4) & 1);
    const size_t ldb = bf.ldb;
    const unsigned boff = (unsigned)((4 * (b_kl + 8 * (wid & 1))) * (int)ldb + 4 * (b_nl + 8 * (wid >> 1))) * 4u;
    const __amdgpu_buffer_rsrc_t rs0 = __builtin_amdgcn_make_buffer_rsrc((void*)bf.base(0), 0, 0x7fffffff, 0x00020000);
    const __amdgpu_buffer_rsrc_t rs1 = __builtin_amdgcn_make_buffer_rsrc((void*)bf.base(1), 0, 0x7fffffff, 0x00020000);
    const unsigned lpk = (unsigned)lds_byte(lane & 15, (lane >> 4) * 8) | ((unsigned)lds_byte((lane & 15) ^ ((lane >> 2) & 1), (lane >> 4) * 8) << 10)
                       | ((unsigned)(lds_byte(4 * b_nl, 4 * b_kl) + (lane & 1) * 64) << 20);
    const int s_fa = (wid >> 1) * 8192, s_fb = (wid & 1) * 16384, s_sb = lds_byte(BF::wrow(wid >> 1), 32 * (wid & 1));
    f32x4 br[8];
    const int nk = K / G_BK;
    const bool act = __builtin_amdgcn_readfirstlane((int)((rowmask >> wr) & 1u)) != 0;
#define G2_SB() ((int)(lpk >> 20) + s_sb)
#define G2_SB1(sb0_) ((sb0_) ^ 64)
#define G2_FA() ((int)(lpk & 1023u) + s_fa)
#define G2_FB() ((int)((lpk >> 10) & 1023u) + s_fb)
#define G2_ADMA(kt) do { const int ko_ = af.koff((kt) * G_BK); const unsigned d_ = lds_a + (unsigned)(((kt) & 1) * G2_BUF); \
        _Pragma("unroll") for (int i = 0; i < 4; ++i) glds16_asm_s(abase + ko_, aoff[i], d_ + (unsigned)(i * 8192)); } while (0)
#define G2_BLOADH(kt, hh) do { const int so_ = (kt) * G_BK * (int)ldb * 4; \
        _Pragma("unroll") for (int i = 0; i < 4; ++i) br[4 * (hh) + i] = __builtin_bit_cast(f32x4, __builtin_amdgcn_raw_buffer_load_b128((hh) ? rs1 : rs0, (int)boff, so_ + i * (int)ldb * 4, 0)); } while (0)
#define G2_PIECE(Bw_, sb_, sb1_, pc) do { u32x2 w_; \
        w_.x = cvtpk(br[4 * ((pc) >> 2) + 0][(pc) & 3], br[4 * ((pc) >> 2) + 1][(pc) & 3]); w_.y = cvtpk(br[4 * ((pc) >> 2) + 2][(pc) & 3], br[4 * ((pc) >> 2) + 3][(pc) & 3]); \
        *(u32x2*)(Bw_ + (((pc) & 1) ? sb1_ : sb_) + ((pc) >> 2) * (BF::HROW * 128) + (((pc) >> 1) & 1) * 128) = w_; } while (0)
#define G2_BSTORE(kt) do { char* Bw_ = lds + ((kt) & 1) * G2_BUF + G_ABYTES; const int sb_ = G2_SB(), sb1_ = G2_SB1(sb_); \
        _Pragma("unroll") for (int pc = 0; pc < 8; ++pc) G2_PIECE(Bw_, sb_, sb1_, pc); } while (0)
#define G2_COMPUTE(kt, ST, RL, ACT, DMA) do { char* Bw_ = lds + (((kt) + 1) & 1) * G2_BUF + G_ABYTES; const int sb_ = (ST) ? G2_SB() : 0, sb1_ = (ST) ? G2_SB1(sb_) : 0; \
        const char* A_ = lds + ((kt) & 1) * G2_BUF; const char* B_ = A_ + G_ABYTES; const int fa_base = (ACT) ? G2_FA() : 0, fb_base = (ACT) ? G2_FB() : 0; \
        bf16x8 a[4], bc; \
        if (ACT) { _Pragma("unroll") for (int m = 0; m < 4; ++m) a[m] = *(const bf16x8*)(A_ + fa_base + m * 2048); \
                   bc = *(const bf16x8*)(B_ + fb_base); } \
        if (DMA) G2_ADMA((kt) + 1);                                  \
        __builtin_amdgcn_sched_barrier(0); \
        _Pragma("unroll") for (int ks = 0; ks < 2; ++ks) { \
            _Pragma("unroll") for (int n = 0; n < 8; ++n) { \
                if (ACT) { const bf16x8 bn = bc; \
                    if (n < 7) bc = *(const bf16x8*)(B_ + fb_base + (n + 1) * 2048 + ks * 1024); \
                    else if (ks == 0) bc = *(const bf16x8*)(B_ + fb_base + 1024); \
                    __builtin_amdgcn_s_setprio(1); \
                    _Pragma("unroll") for (int m = 0; m < 4; ++m) { acc[m][n] = __builtin_amdgcn_mfma_f32_16x16x32_bf16(bn, a[m], acc[m][n], 0, 0, 0); \
                        if (ks == 0 && n == 7) { __builtin_amdgcn_sched_barrier(0); a[m] = *(const bf16x8*)(A_ + fa_base + m * 2048 + 1024); } }     \
                    __builtin_amdgcn_s_setprio(0); } \
                if ((ST) && (n & 1)) G2_PIECE(Bw_, sb_, sb1_, ks * 4 + (n >> 1)); \
                if ((RL) && n == 7) G2_BLOADH((kt) + 2, ks); \
                __builtin_amdgcn_sched_barrier(0); } } } while (0)
    G2_ADMA(0); G2_BLOADH(0, 0); G2_BLOADH(0, 1);
    G2_BSTORE(0);
    __builtin_amdgcn_sched_barrier(0);
    if (nk > 1) { G2_BLOADH(1, 0); G2_BLOADH(1, 1); asm volatile("s_waitcnt vmcnt(8)" ::: "memory"); }
    else asm volatile("s_waitcnt vmcnt(0)" ::: "memory");
    __syncthreads();
#define G2_LOOP(ACT) do { int kt = 0; \
    for (; kt + 2 < nk; ++kt) { G2_COMPUTE(kt, 1, 1, ACT, 1); asm volatile("s_waitcnt vmcnt(8)" ::: "memory"); __syncthreads(); } \
    if (kt + 1 < nk) { G2_COMPUTE(kt, 1, 0, ACT, 1); asm volatile("s_waitcnt vmcnt(0)" ::: "memory"); __syncthreads(); ++kt; } \
    G2_COMPUTE(kt, 0, 0, ACT, 0); \
    __syncthreads(); } while (0)
    if (act) G2_LOOP(1); else G2_LOOP(0);
#undef G2_LOOP
#undef G2_BLOADH
#undef G2_PIECE
#undef G2_SB
#undef G2_SB1
#undef G2_FA
#undef G2_FB
#undef G2_ADMA
#undef G2_BSTORE
#undef G2_COMPUTE
    { const int l2_ = tidx() & 63; if (act) ep(acc, wr, wc, l2_ & 15, l2_ >> 4); }
    __syncthreads();
}
template <class UN>
__device__ __forceinline__ void gemm_tile256_seq(UN& un, const int K, char* lds) {
    typedef typename UN::BFT BF;
    const int tid = tidx(), wid = __builtin_amdgcn_readfirstlane(tid >> 6), lane = tid & 63, wr = wid >> 1, wc = wid & 1, fr = lane & 15, fq = lane >> 4;
    f32x4 acc[4][8];
    const bf16_t* abase = nullptr; unsigned aoff[4] = {0u, 0u, 0u, 0u};
    const unsigned lds_a = (unsigned)(uintptr_t)lds + (unsigned)wid * 1024u;
    const int b_nl = (lane & 3) + 4 * ((lane >> 5) & 1), b_kl = ((lane >> 2) & 3) + 4 * ((lane >> 4) & 1);
    const size_t ldb = UN::LDB;
    const int s_bo = ((32 * (wid & 1)) * (int)ldb + 32 * (wid >> 1)) * 4;
    __amdgpu_buffer_rsrc_t rs0 = __builtin_amdgcn_make_buffer_rsrc((void*)nullptr, 0, 0x7fffffff, 0x00020000), rs1 = rs0;
#define T2_SETUP() do { abase = un.af.safe(); \
        _Pragma("unroll") for (int i = 0; i < 4; ++i) { int R, C; stage_rc(tidx() * 16 + (i & 1) * 8192, R, C); aoff[i] = 2u * (un.af.a_off((i >> 1) * 128 + R) + (unsigned)C); } \
        rs0 = __builtin_amdgcn_make_buffer_rsrc((void*)un.bf.base(0), 0, 0x7fffffff, 0x00020000); rs1 = __builtin_amdgcn_make_buffer_rsrc((void*)un.bf.base(1), 0, 0x7fffffff, 0x00020000); } while (0)
    const unsigned lpk = (unsigned)lds_byte(lane & 15, (lane >> 4) * 8) | ((unsigned)lds_byte((lane & 15) ^ ((lane >> 2) & 1), (lane >> 4) * 8) << 10)
                       | ((unsigned)(lds_byte(4 * b_nl, 4 * b_kl) + (lane & 1) * 64) << 20);
    const int s_fa = (wid >> 1) * 8192, s_fb = (wid & 1) * 16384, s_sb = lds_byte(BF::wrow(wid >> 1), 32 * (wid & 1));
    f32x4 br[8];
    const int nk = K / G_BK;
#define G2_SB() ((int)(lpk >> 20) + s_sb)
#define G2_SB1(sb0_) ((sb0_) ^ 64)
#define G2_FA() ((int)(lpk & 1023u) + s_fa)
#define G2_FB() ((int)((lpk >> 10) & 1023u) + s_fb)
#define G2_ADMA(kt) do { const int ko_ = (kt) * G_BK; const unsigned d_ = lds_a + (unsigned)(((kt) & 1) * G2_BUF); \
        _Pragma("unroll") for (int i = 0; i < 4; ++i) glds16_asm_s(abase + ko_, aoff[i], d_ + (unsigned)(i * 8192)); } while (0)
#define G2_BLOADH(kt, hh) do { const int so_ = (kt) * G_BK * (int)ldb * 4 + s_bo; const int l_ = tidx() & 63; \
        const int bo_ = (((l_ >> 2) & 3) + 4 * ((l_ >> 4) & 1)) * (16 * (int)ldb) + ((l_ & 3) + 4 * ((l_ >> 5) & 1)) * 16;        \
        _Pragma("unroll") for (int i = 0; i < 4; ++i) br[4 * (hh) + i] = __builtin_bit_cast(f32x4, __builtin_amdgcn_raw_buffer_load_b128((hh) ? rs1 : rs0, bo_, so_ + i * (int)ldb * 4, 0)); } while (0)
#define G2_PIECE(Bw_, sb_, sb1_, pc) do { u32x2 w_; \
        w_.x = cvtpk(br[4 * ((pc) >> 2) + 0][(pc) & 3], br[4 * ((pc) >> 2) + 1][(pc) & 3]); w_.y = cvtpk(br[4 * ((pc) >> 2) + 2][(pc) & 3], br[4 * ((pc) >> 2) + 3][(pc) & 3]); \
        *(u32x2*)(Bw_ + (((pc) & 1) ? sb1_ : sb_) + ((pc) >> 2) * (BF::HROW * 128) + (((pc) >> 1) & 1) * 128) = w_; } while (0)
#define G2_BSTORE(kt) do { char* Bw_ = lds + ((kt) & 1) * G2_BUF + G_ABYTES; const int sb_ = G2_SB(), sb1_ = G2_SB1(sb_); \
        _Pragma("unroll") for (int pc = 0; pc < 8; ++pc) G2_PIECE(Bw_, sb_, sb1_, pc); } while (0)
#define G2_COMPUTE(kt, ST, RL, ACT, DMA) do { char* Bw_ = lds + (((kt) + 1) & 1) * G2_BUF + G_ABYTES; const int sb_ = (ST) ? G2_SB() : 0, sb1_ = (ST) ? G2_SB1(sb_) : 0; \
        const char* A_ = lds + ((kt) & 1) * G2_BUF; const char* B_ = A_ + G_ABYTES; const int fa_base = (ACT) ? G2_FA() : 0, fb_base = (ACT) ? G2_FB() : 0; \
        bf16x8 a[4], bc; \
        if (ACT) { _Pragma("unroll") for (int m = 0; m < 4; ++m) a[m] = *(const bf16x8*)(A_ + fa_base + m * 2048); \
                   bc = *(const bf16x8*)(B_ + fb_base); } \
        if (DMA) G2_ADMA((kt) + 1);                                  \
        __builtin_amdgcn_sched_barrier(0); \
        _Pragma("unroll") for (int ks = 0; ks < 2; ++ks) { \
            _Pragma("unroll") for (int n = 0; n < 8; ++n) { \
                if (ACT) { const bf16x8 bn = bc; \
                    if (n < 7) bc = *(const bf16x8*)(B_ + fb_base + (n + 1) * 2048 + ks * 1024); \
                    else if (ks == 0) bc = *(const bf16x8*)(B_ + fb_base + 1024); \
                    __builtin_amdgcn_s_setprio(1); \
                    _Pragma("unroll") for (int m = 0; m < 4; ++m) { acc[m][n] = __builtin_amdgcn_mfma_f32_16x16x32_bf16(bn, a[m], acc[m][n], 0, 0, 0); \
                        if (ks == 0 && n == 7) { __builtin_amdgcn_sched_barrier(0); a[m] = *(const bf16x8*)(A_ + fa_base + m * 2048 + 1024); } }     \
                    __builtin_amdgcn_s_setprio(0); } \
                if ((ST) && (n & 1)) G2_PIECE(Bw_, sb_, sb1_, ks * 4 + (n >> 1)); \
                if ((RL) && n == 7) G2_BLOADH((kt) + 2, ks); \
                __builtin_amdgcn_sched_barrier(0); } } } while (0)
#define G2_LOOP(ACT) do { int kt = 0; \
    for (; kt + 2 < nk; ++kt) { G2_COMPUTE(kt, 1, 1, ACT, 1); asm volatile("s_waitcnt vmcnt(8)" ::: "memory"); __syncthreads(); } \
    if (kt + 1 < nk) { G2_COMPUTE(kt, 1, 0, ACT, 1); asm volatile("s_waitcnt vmcnt(0)" ::: "memory"); __syncthreads(); ++kt; } \
    G2_COMPUTE(kt, 0, 0, ACT, 0); \
    __syncthreads(); } while (0)
    bool have = un.first();
    if (have) { T2_SETUP(); G2_ADMA(0); G2_BLOADH(0, 0); G2_BLOADH(0, 1); }
#pragma unroll 1
    while (have) {
        const typename UN::EPT ep = un.ep;
        const bool act = __builtin_amdgcn_readfirstlane((int)((un.rowmask >> wr) & 1u)) != 0;
#pragma unroll
        for (int m = 0; m < 4; ++m)
#pragma unroll
            for (int n = 0; n < 8; ++n) acc[m][n] = (f32x4){0.f, 0.f, 0.f, 0.f};
        G2_BSTORE(0);
        __builtin_amdgcn_sched_barrier(0);
        if (nk > 1) { G2_BLOADH(1, 0); G2_BLOADH(1, 1); asm volatile("s_waitcnt vmcnt(8)" ::: "memory"); }
        else asm volatile("s_waitcnt vmcnt(0)" ::: "memory");
        __syncthreads();
        if (act) G2_LOOP(1); else G2_LOOP(0);
        have = un.next();
        if (have) { T2_SETUP(); G2_ADMA(0); G2_BLOADH(0, 0); G2_BLOADH(0, 1); }
        __builtin_amdgcn_sched_barrier(0);
        { const int l2_ = tidx() & 63; if (act) ep(acc, wr, wc, l2_ & 15, l2_ >> 4); }
    }
    __syncthreads();
#undef G2_LOOP
#undef T2_SETUP
#undef G2_BLOADH
#undef G2_PIECE
#undef G2_SB
#undef G2_SB1
#undef G2_FA
#undef G2_FB
#undef G2_ADMA
#undef G2_BSTORE
#undef G2_COMPUTE
}
struct ARows {
    const bf16_t* base; int lda; int row0; int mlim;
    __device__ __forceinline__ const bf16_t* a_row(int r) const { const int g = row0 + r; return g < mlim ? base + (size_t)g * lda : nullptr; }
    __device__ __forceinline__ unsigned a_off(int r) const { const int g = row0 + r; return g < mlim ? (unsigned)g * (unsigned)lda : 0u; }
    __device__ __forceinline__ const bf16_t* safe() const { return base; }
    __device__ __forceinline__ int koff(int k0) const { return k0; }
};
struct AGather {
    const bf16_t* base; int lda; const int* list; int r0; int cnt;
    __device__ __forceinline__ const bf16_t* a_row(int r) const { const int g = r0 + r; return g < cnt ? base + (size_t)list[g] * lda : nullptr; }
    __device__ __forceinline__ unsigned a_off(int r) const { const int g = r0 + r; return g < cnt ? (unsigned)list[g] * (unsigned)lda : 0u; }
    __device__ __forceinline__ const bf16_t* safe() const { return base; }
    __device__ __forceinline__ int koff(int k0) const { return k0; }
};
struct ACompress {
    const bf16_t* src; int col0; int row0; int kbase;
    __device__ __forceinline__ const bf16_t* a_row(int r) const {
        const int g = row0 + r; const int b = g >> 10, c = (g >> 2) & 255, gg = g & 3;
        if (c >= NC) return nullptr;
        return src + ((size_t)(b * SEQ + 16 * c)) * B_MAIN + col0 + gg * 128;
    }
    __device__ __forceinline__ const bf16_t* safe() const { return src; }
    __device__ __forceinline__ int koff(int k0) const { const int k = kbase + k0; return (k >> 7) * B_MAIN + (k & 127); }
};
struct BPlain {           static constexpr bool IS_BF16 = false;
    const float* base; size_t ldb; int n0; int nlim;
    __device__ __forceinline__ const float* colptr(int nl) const { const int c = n0 + nl; return c < nlim ? base + c : nullptr; }
    __device__ __forceinline__ const float* safe() const { return base; }
    __device__ __forceinline__ const bf16_t* bt16() const { return nullptr; }
};
struct BGateUp {          static constexpr bool IS_BF16 = false;
    const float* wg; long long du; size_t ldb; int c0;
    __device__ __forceinline__ const float* colptr(int nl) const {
        const int wc = nl >> 6, q = (nl >> 4) & 3, w = nl & 15; const int col = c0 + wc * 32 + (q & 1) * 16 + w;
        return wg + (long long)(q >> 1) * du + col;
    }
    __device__ __forceinline__ const float* safe() const { return wg; }
    __device__ __forceinline__ const bf16_t* bt16() const { return nullptr; }
};

struct BGateUp256 {
    static constexpr int HROW = 64;
    const float* wg; long long du; size_t ldb; int c0;
    __device__ __forceinline__ const float* base(int hh) const { return wg + (hh ? du : 0ll) + c0; }
    static __device__ __forceinline__ int wrow(int wq) { return (wq >> 1) * 128 + (wq & 1) * 32; }
};
struct BPlain256 {
    static constexpr int HROW = 128;
    const float* wbase; size_t ldb; int n0;
    __device__ __forceinline__ const float* base(int hh) const { return wbase + n0 + 128 * hh; }
    static __device__ __forceinline__ int wrow(int wq) { return wq * 32; }
};
struct EpSiluMul256 {
    bf16_t* out; int row0; int c0;
    __device__ __forceinline__ void operator()(const f32x4 (&acc)[4][8], int wr, int wc, int fr, int fq) const {
#pragma unroll
        for (int m = 0; m < 4; ++m) { const int r = row0 + wr * 64 + m * 16 + fr;
#pragma unroll
            for (int n = 0; n < 4; ++n) { const int c = c0 + wc * 64 + n * 16 + fq * 4; float hh[4];
#pragma unroll
                for (int j = 0; j < 4; ++j) { const float g = acc[m][n][j]; hh[j] = g / (1.f + __expf(-g)) * acc[m][n + 4][j]; }
                u32x2 w; w.x = cvtpk(hh[0], hh[1]); w.y = cvtpk(hh[2], hh[3]);
                *(u32x2*)(out + (size_t)r * D_EXPERT + c) = w; } }
    }
};
struct EpScaleRow256 {
    bf16_t* out; const float* roww; int rw0; int cnt; int row0; int col0;
    __device__ __forceinline__ void operator()(const f32x4 (&acc)[4][8], int wr, int wc, int fr, int fq) const {
#pragma unroll
        for (int m = 0; m < 4; ++m) { const int rl = wr * 64 + m * 16 + fr; const float s = (rw0 + rl < cnt) ? roww[rw0 + rl] : 0.f; const int r = row0 + rl;
#pragma unroll
            for (int n = 0; n < 8; ++n) { const int c = col0 + wc * 128 + n * 16 + fq * 4;
                u32x2 w; w.x = cvtpk(acc[m][n][0] * s, acc[m][n][1] * s); w.y = cvtpk(acc[m][n][2] * s, acc[m][n][3] * s);
                *(u32x2*)(out + (size_t)r * D_MODEL + c) = w; } }
    }
};
struct BBf16T {           static constexpr bool IS_BF16 = true;
    const bf16_t* base; size_t ldb; int n0;
    __device__ __forceinline__ const float* colptr(int) const { return nullptr; }
    __device__ __forceinline__ const float* safe() const { return nullptr; }
    __device__ __forceinline__ const bf16_t* bt16() const { return base + (size_t)n0 * ldb; }
};
struct EpBf16 {
    bf16_t* out; int ldc; int row0; int col0; int mlim; int nlim;
    __device__ __forceinline__ void operator()(const f32x4 (&acc)[4][4], int wr, int wc, int fr, int fq) const {
#pragma unroll
        for (int m = 0; m < 4; ++m) { const int r = row0 + wr * 64 + m * 16 + fr; if (r >= mlim) continue;
#pragma unroll
            for (int n = 0; n < 4; ++n) { const int c = col0 + wc * 64 + n * 16 + fq * 4; if (c >= nlim) continue;
                u32x2 w; w.x = cvtpk(acc[m][n][0], acc[m][n][1]); w.y = cvtpk(acc[m][n][2], acc[m][n][3]);
                *(u32x2*)(out + (size_t)r * ldc + c) = w; } }
    }
};
struct EpResF32 {
    float* out; const float* res; int ldc; int row0; int col0;
    __device__ __forceinline__ void operator()(const f32x4 (&acc)[4][4], int wr, int wc, int fr, int fq) const {
#pragma unroll
        for (int m = 0; m < 4; ++m) { const int r = row0 + wr * 64 + m * 16 + fr;
#pragma unroll
            for (int n = 0; n < 4; ++n) { const int c = col0 + wc * 64 + n * 16 + fq * 4;
                const f32x4 rv = *(const f32x4*)(res + (size_t)r * ldc + c);
                *(f32x4*)(out + (size_t)r * ldc + c) = rv + acc[m][n]; } }
    }
};
struct EpF32 {
    float* out; int ldc; int row0; int col0;
    __device__ __forceinline__ void operator()(const f32x4 (&acc)[4][4], int wr, int wc, int fr, int fq) const {
#pragma unroll
        for (int m = 0; m < 4; ++m) { const int r = row0 + wr * 64 + m * 16 + fr;
#pragma unroll
            for (int n = 0; n < 4; ++n) { const int c = col0 + wc * 64 + n * 16 + fq * 4; *(f32x4*)(out + (size_t)r * ldc + c) = acc[m][n]; } }
    }
};
struct EpProj {
    bf16_t* out; float* gate; int row0; int col0;
    __device__ __forceinline__ void operator()(const f32x4 (&acc)[4][4], int wr, int wc, int fr, int fq) const {
#pragma unroll
        for (int m = 0; m < 4; ++m) { const int r = row0 + wr * 64 + m * 16 + fr;
#pragma unroll
            for (int n = 0; n < 4; ++n) { const int c = col0 + wc * 64 + n * 16 + fq * 4;
                if (c < B_MAIN) { u32x2 w; w.x = cvtpk(acc[m][n][0], acc[m][n][1]); w.y = cvtpk(acc[m][n][2], acc[m][n][3]);
                    *(u32x2*)(out + (size_t)r * B_MAIN + c) = w; }
                else if (c < B_IN) { f32x4 g;
#pragma unroll
                    for (int j = 0; j < 4; ++j) g[j] = 1.f / (1.f + __expf(-acc[m][n][j]));
                    *(f32x4*)(gate + (size_t)r * 48 + (c - B_MAIN)) = g; } } }
    }
};
struct EpSiluMul {
    bf16_t* out; int row0; int c0;
    __device__ __forceinline__ void operator()(const f32x4 (&acc)[4][4], int wr, int wc, int fr, int fq) const {
#pragma unroll
        for (int m = 0; m < 4; ++m) { const int r = row0 + wr * 64 + m * 16 + fr;
#pragma unroll
            for (int n = 0; n < 2; ++n) { const int c = c0 + wc * 32 + n * 16 + fq * 4; float h[4];
#pragma unroll
                for (int j = 0; j < 4; ++j) { const float g = acc[m][n][j]; h[j] = g / (1.f + __expf(-g)) * acc[m][n + 2][j]; }
                u32x2 w; w.x = cvtpk(h[0], h[1]); w.y = cvtpk(h[2], h[3]);
                *(u32x2*)(out + (size_t)r * D_EXPERT + c) = w; } }
    }
};
struct EpScaleRow {
    bf16_t* out; const float* roww; int rw0; int cnt; int row0; int col0;
    __device__ __forceinline__ void operator()(const f32x4 (&acc)[4][4], int wr, int wc, int fr, int fq) const {
#pragma unroll
        for (int m = 0; m < 4; ++m) { const int rl = wr * 64 + m * 16 + fr; const float s = (rw0 + rl < cnt) ? roww[rw0 + rl] : 0.f; const int r = row0 + rl;
#pragma unroll
            for (int n = 0; n < 4; ++n) { const int c = col0 + wc * 64 + n * 16 + fq * 4;
                u32x2 w; w.x = cvtpk(acc[m][n][0] * s, acc[m][n][1] * s); w.y = cvtpk(acc[m][n][2] * s, acc[m][n][3] * s);
                *(u32x2*)(out + (size_t)r * D_MODEL + c) = w; } }
    }
};
__device__ __forceinline__ float gelu_tanh(float x) {
    const float u = 0.7978845608028654f * (x + 0.044715f * x * x * x);
    const float e = __expf(2.f * u); const float t = 1.f - 2.f / (e + 1.f);
    return 0.5f * x * (1.f + t);
}
struct EpGeluBias {
    bf16_t* out; const float* bias; int row0; int col0;
    __device__ __forceinline__ void operator()(const f32x4 (&acc)[4][4], int wr, int wc, int fr, int fq) const {
#pragma unroll
        for (int m = 0; m < 4; ++m) { const int r = row0 + wr * 64 + m * 16 + fr;
#pragma unroll
            for (int n = 0; n < 4; ++n) { const int c = col0 + wc * 64 + n * 16 + fq * 4; const f32x4 bv = *(const f32x4*)(bias + c); float h[4];
#pragma unroll
                for (int j = 0; j < 4; ++j) h[j] = gelu_tanh(acc[m][n][j] + bv[j]);
                u32x2 w; w.x = cvtpk(h[0], h[1]); w.y = cvtpk(h[2], h[3]);
                *(u32x2*)(out + (size_t)r * 256 + c) = w; } }
    }
};

__device__ __forceinline__ void stage_rc(int b, int& R, int& C) { const int st = b / 1024, sb = b % 1024, swz = sb ^ (((sb >> 9) & 1) << 5); R = (st >> 1) * 16 + swz / 64; C = (st & 1) * 32 + (swz % 64) / 2; }
#define G8_HT 16384
template <bool GATHER, class EP>
__device__ __forceinline__ void gemm8_unit(const bf16_t* __restrict__ A, const unsigned (&ao)[2][2], const int lda, const bf16_t* __restrict__ Bt, const unsigned (&bo2)[2], const int K, char* lds, const EP& ep, const bool hi_act) {
    const int tid = tidx(), wid = tid >> 6, lane = tid & 63, wr = wid >> 2, wc = wid & 3, fr = lane & 15, fq = lane >> 4;
#define SA(b, h) (((b) * 2 + (h)) * G8_HT)
#define SB(b, h) ((4 + (b) * 2 + (h)) * G8_HT)
#define STG(P, BASE, OFF, kt) do { const bf16_t* g_ = (BASE) + (kt) * 64; \
        __builtin_amdgcn_global_load_lds((const unsigned*)(g_ + (OFF)[0]), (unsigned*)(lds + (P) + tid * 16), 16, 0, 0); \
        __builtin_amdgcn_global_load_lds((const unsigned*)(g_ + (OFF)[1]), (unsigned*)(lds + (P) + 8192 + tid * 16), 16, 0, 0); } while (0)
#define LDA(dst, b, h) _Pragma("unroll") for (int m = 0; m < 4; ++m) _Pragma("unroll") for (int k = 0; k < 2; ++k) \
        dst[m][k] = *reinterpret_cast<const bf16x8*>(lds + SA(b, h) + fa_base + m * 2048 + k * 1024)
#define LDB(dst, b, h) _Pragma("unroll") for (int n = 0; n < 2; ++n) _Pragma("unroll") for (int k = 0; k < 2; ++k) \
        dst[n][k] = *reinterpret_cast<const bf16x8*>(lds + SB(b, h) + fb_base + n * 2048 + k * 1024)
#define MMA(ai, bj, At_, Bt_) do { __builtin_amdgcn_s_setprio(1); \
        _Pragma("unroll") for (int m = 0; m < 4; ++m) _Pragma("unroll") for (int n = 0; n < 2; ++n) _Pragma("unroll") for (int k = 0; k < 2; ++k) \
            acc[ai][bj][m][n] = __builtin_amdgcn_mfma_f32_16x16x32_bf16(Bt_[n][k], At_[m][k], acc[ai][bj][m][n], 0, 0, 0); \
        __builtin_amdgcn_s_setprio(0); } while (0)
#define MMAH(bj, At_, Bt_) do { if (hi_act) MMA(1, bj, At_, Bt_); } while (0)
#define WAIT_V(n) asm volatile("s_waitcnt vmcnt(" #n ")" ::: "memory")
#define WAIT_L(n) asm volatile("s_waitcnt lgkmcnt(" #n ")" ::: "memory")
#define BAR __builtin_amdgcn_s_barrier()
#define SCHED __builtin_amdgcn_sched_barrier(0)
    const int fa_base = lds_byte(wr * 64 + fr, fq * 8), fb_base = lds_byte(wc * 32 + fr, fq * 8);
    f32x4 acc[2][2][4][2];
#pragma unroll
    for (int a = 0; a < 2; ++a)
#pragma unroll
        for (int b = 0; b < 2; ++b)
#pragma unroll
            for (int m = 0; m < 4; ++m)
#pragma unroll
                for (int n = 0; n < 2; ++n) acc[a][b][m][n] = (f32x4){0.f, 0.f, 0.f, 0.f};
    bf16x8 At[4][2], B0[2][2], B1[2][2];
    const int nt = K / 64;
    const bf16_t* Bt1 = Bt + (size_t)128 * K;
    const bf16_t* A1 = GATHER ? A : A + (size_t)128 * lda;
#define AO1 ao[GATHER ? 1 : 0]
    STG(SB(0, 0), Bt, bo2, 0); STG(SA(0, 0), A, ao[0], 0);
    STG(SB(0, 1), Bt1, bo2, 0); STG(SA(0, 1), A1, AO1, 0);
    if (wr == 1) BAR;
    WAIT_V(4); BAR;
    STG(SB(1, 0), Bt, bo2, 1); STG(SA(1, 0), A, ao[0], 1); STG(SB(1, 1), Bt1, bo2, 1);
    WAIT_V(6); BAR;
    for (int t = 0; t < nt - 2; t += 2) {
        LDB(B0, 0, 0); SCHED; LDA(At, 0, 0); STG(SA(1, 1), A1, AO1, t + 1);
        WAIT_L(8); BAR; WAIT_L(0); MMA(0, 0, At, B0); BAR; SCHED;
        LDB(B1, 0, 1); STG(SB(0, 0), Bt, bo2, t + 2);
        BAR; WAIT_L(0); MMA(0, 1, At, B1); BAR;
        LDA(At, 0, 1); STG(SA(0, 0), A, ao[0], t + 2);
        BAR; WAIT_L(0); MMAH(0, At, B0); BAR; SCHED;
        STG(SB(0, 1), Bt1, bo2, t + 2);
        WAIT_V(6); BAR; MMAH(1, At, B1); BAR;
        LDB(B0, 1, 0); SCHED; LDA(At, 1, 0); STG(SA(0, 1), A1, AO1, t + 2);
        WAIT_L(8); BAR; WAIT_L(0); MMA(0, 0, At, B0); BAR; SCHED;
        LDB(B1, 1, 1); STG(SB(1, 0), Bt, bo2, t + 3);
        BAR; WAIT_L(0); MMA(0, 1, At, B1); BAR;
        LDA(At, 1, 1); STG(SA(1, 0), A, ao[0], t + 3);
        BAR; WAIT_L(0); MMAH(0, At, B0); BAR; SCHED;
        STG(SB(1, 1), Bt1, bo2, t + 3);
        WAIT_V(6); BAR; MMAH(1, At, B1); BAR;
    }
    { LDB(B0, 0, 0); WAIT_V(0); LDA(At, 0, 0); STG(SA(1, 1), A1, AO1, nt - 1);
      BAR; WAIT_L(0); MMA(0, 0, At, B0); BAR;
      LDB(B1, 0, 1); BAR; WAIT_L(0); MMA(0, 1, At, B1); BAR;
      LDA(At, 0, 1); WAIT_V(4); BAR; WAIT_L(0); MMAH(0, At, B0); MMAH(1, At, B1); BAR; }
    { LDB(B0, 1, 0); LDA(At, 1, 0); WAIT_V(2); BAR; WAIT_L(0); MMA(0, 0, At, B0); BAR;
      LDB(B1, 1, 1); WAIT_V(0); BAR; WAIT_L(0); MMA(0, 1, At, B1); BAR;
      LDA(At, 1, 1); BAR; WAIT_L(0); MMAH(0, At, B0); MMAH(1, At, B1); BAR; }
    if (wr == 0) BAR;
    ep(acc, wr, wc, fr, fq);
    __syncthreads();
#undef SA
#undef AO1
#undef SB
#undef STG
#undef LDA
#undef LDB
#undef MMA
#undef MMAH
#undef WAIT_V
#undef WAIT_L
#undef BAR
#undef SCHED
}
__device__ __forceinline__ void g8_offsets2(unsigned (&o)[2], int row0, int ld) {
    const int tid = tidx();
#pragma unroll
    for (int i = 0; i < 2; ++i) { int R, C; stage_rc(tid * 16 + i * 8192, R, C); o[i] = (unsigned)((row0 + R) * ld + C); }
}
__device__ __forceinline__ void g8_offsets2_perm(unsigned (&o)[2], int row0, int ld) {
    const int tid = tidx();
#pragma unroll
    for (int i = 0; i < 2; ++i) { int R, C; stage_rc(tid * 16 + i * 8192, R, C); const int rho = R & 31, nn = rho >> 4, ii = rho & 15;
        const int Rp = (R & ~31) + 8 * (ii >> 2) + 4 * nn + (ii & 3); o[i] = (unsigned)((row0 + Rp) * ld + C); }
}
__device__ __forceinline__ void g8_offsets(unsigned (&o)[2][2], int row0, int ld) {
    const int tid = tidx();
#pragma unroll
    for (int i = 0; i < 2; ++i) { int R, C; stage_rc(tid * 16 + i * 8192, R, C);
#pragma unroll
        for (int h = 0; h < 2; ++h) o[h][i] = (unsigned)((row0 + h * 128 + R) * ld + C); }
}
__device__ __forceinline__ int wgid_v(char* lds) {
#if N_LAUNCH_MODE == 1
    return __builtin_amdgcn_readfirstlane((int)((volatile LAS unsigned*)(lds + LDS_BYTES - 16))[2]);
#else
    (void)lds; return (int)blockIdx.x;
#endif
}
__device__ __forceinline__ void g8_order_c(int L, int nM, int nN, int& pm, int& pn) {
    const int nig = 8 * nN, gid = L / nig, fm = gid * 8, gsz = (nM - fm) < 8 ? (nM - fm) : 8;
    pm = fm + ((L % nig) % gsz); pn = (L % nig) / gsz;
}
__device__ __forceinline__ void g8_order(int L, int nM, int nN, int& pm, int& pn) {
    const int nwg = nM * nN; int wgid = L; { const int q = nwg / 8, r = nwg % 8, xcd = wgid % 8, off = wgid / 8; wgid = (xcd < r ? xcd * (q + 1) : r * (q + 1) + (xcd - r) * q) + off; }
    const int nig = 8 * nN, gid = wgid / nig, fm = gid * 8, gsz = (nM - fm) < 8 ? (nM - fm) : 8;
    pm = fm + ((wgid % nig) % gsz); pn = (wgid % nig) / gsz;
}
struct E8Bf16 {
    bf16_t* out; int ldc; int row0; int col0; int nlim;
    __device__ __forceinline__ void operator()(const f32x4 (&acc)[2][2][4][2], int wr, int wc, int fr, int fq) const {
#pragma unroll
        for (int ai = 0; ai < 2; ++ai)
#pragma unroll
            for (int m = 0; m < 4; ++m) { const int r = row0 + ai * 128 + wr * 64 + m * 16 + fr;
#pragma unroll
                for (int bj = 0; bj < 2; ++bj) { const int c = col0 + bj * 128 + wc * 32 + 8 * fq; if (c >= nlim) continue;
                    const f32x4 v0 = acc[ai][bj][m][0], v1 = acc[ai][bj][m][1];
                    u32x4 w; w.x = cvtpk(v0[0], v0[1]); w.y = cvtpk(v0[2], v0[3]); w.z = cvtpk(v1[0], v1[1]); w.w = cvtpk(v1[2], v1[3]);
                    *(u32x4*)(out + (size_t)r * ldc + c) = w; } }
    }
};
template <bool RB>
struct E8ResBf16 {
    bf16_t* out; const void* res; int row0; int col0;
    __device__ __forceinline__ void operator()(const f32x4 (&acc)[2][2][4][2], int wr, int wc, int fr, int fq) const {
#pragma unroll
        for (int ai = 0; ai < 2; ++ai)
#pragma unroll
            for (int m = 0; m < 4; ++m) { const int r = row0 + ai * 128 + wr * 64 + m * 16 + fr;
#pragma unroll
                for (int bj = 0; bj < 2; ++bj) { const int c = col0 + bj * 128 + wc * 32 + 8 * fq;
                    f32x4 r0, r1;
                    if (RB) { const u32x4 rw = *(const u32x4*)((const bf16_t*)res + (size_t)r * D_MODEL + c);
                        r0[0] = __uint_as_float(rw.x << 16); r0[1] = __uint_as_float(rw.x & 0xffff0000u); r0[2] = __uint_as_float(rw.y << 16); r0[3] = __uint_as_float(rw.y & 0xffff0000u);
                        r1[0] = __uint_as_float(rw.z << 16); r1[1] = __uint_as_float(rw.z & 0xffff0000u); r1[2] = __uint_as_float(rw.w << 16); r1[3] = __uint_as_float(rw.w & 0xffff0000u); }
                    else { r0 = *(const f32x4*)((const float*)res + (size_t)r * D_MODEL + c); r1 = *(const f32x4*)((const float*)res + (size_t)r * D_MODEL + c + 4); }
                    const f32x4 v0 = r0 + acc[ai][bj][m][0], v1 = r1 + acc[ai][bj][m][1];
                    u32x4 w; w.x = cvtpk(v0[0], v0[1]); w.y = cvtpk(v0[2], v0[3]); w.z = cvtpk(v1[0], v1[1]); w.w = cvtpk(v1[2], v1[3]);
                    *(u32x4*)(out + (size_t)r * D_MODEL + c) = w; } }
    }
};
struct E8Proj {
    bf16_t* out; float* gate; int row0; int col0;
    __device__ __forceinline__ void operator()(const f32x4 (&acc)[2][2][4][2], int wr, int wc, int fr, int fq) const {
#pragma unroll
        for (int ai = 0; ai < 2; ++ai)
#pragma unroll
            for (int m = 0; m < 4; ++m) { const int r = row0 + ai * 128 + wr * 64 + m * 16 + fr;
#pragma unroll
                for (int bj = 0; bj < 2; ++bj) { const int c = col0 + bj * 128 + wc * 32 + 8 * fq; const f32x4 v0 = acc[ai][bj][m][0], v1 = acc[ai][bj][m][1];
                    if (c < B_MAIN) { u32x4 w; w.x = cvtpk(v0[0], v0[1]); w.y = cvtpk(v0[2], v0[3]); w.z = cvtpk(v1[0], v1[1]); w.w = cvtpk(v1[2], v1[3]);
                        *(u32x4*)(out + (size_t)r * B_MAIN + c) = w; }
                    else if (c < B_IN) { f32x4 g0, g1;
#pragma unroll
                        for (int j = 0; j < 4; ++j) { g0[j] = 1.f / (1.f + __expf(-v0[j])); g1[j] = 1.f / (1.f + __expf(-v1[j])); }
                        *(f32x4*)(gate + (size_t)r * 48 + (c - B_MAIN)) = g0; *(f32x4*)(gate + (size_t)r * 48 + (c - B_MAIN) + 4) = g1; } } }
    }
};
template <int MODE>
__device__ __forceinline__ void convert_weight(const float* __restrict__ src, const int K, const int N, bf16_t* __restrict__ dst, int& job, const int stride, char* lds) {
    (void)lds;
    const int tid = tidx(), kb = (tid >> 2) & 7, nb = (tid & 3) + 4 * (tid >> 5); const int nK = K / 64, nN = (N + 255) / 256; const int njobs = nK * nN;
    for (; job < njobs;) {
        const int j1 = job + stride; const bool two = j1 < njobs;
        const int kt0 = job % nK, nt0 = job / nK, kt1 = two ? j1 % nK : kt0, nt1 = two ? j1 / nK : nt0;
        f32x4 v[2][8];
#pragma unroll
        for (int jj = 0; jj < 2; ++jj) { const int kt = jj ? kt1 : kt0, ntl = jj ? nt1 : nt0;
            const int n = ntl * 256 + nb * 4; const float* s = src + (size_t)(kt * 64 + 8 * kb) * N + n;
#pragma unroll
            for (int i = 0; i < 8; ++i) v[jj][i] = n < N ? *(const f32x4*)(s + (size_t)i * N) : (f32x4){0.f, 0.f, 0.f, 0.f}; }
#pragma unroll
        for (int jj = 0; jj < 2; ++jj) { if (jj == 1 && !two) break;
            const int kt = jj ? kt1 : kt0, ntl = jj ? nt1 : nt0; const int n = ntl * 256 + nb * 4;
#pragma unroll
            for (int j = 0; j < 4; ++j) { const int ng = n + j;
                const int drow = MODE == 0 ? ng : ((ng >> 7) * 256 + (ng & 127) + (MODE == 2 ? 128 : 0));
                u32x4 w; w.x = cvtpk(v[jj][0][j], v[jj][1][j]); w.y = cvtpk(v[jj][2][j], v[jj][3][j]); w.z = cvtpk(v[jj][4][j], v[jj][5][j]); w.w = cvtpk(v[jj][6][j], v[jj][7][j]);
                *(u32x4*)(dst + (size_t)drow * K + kt * 64 + 8 * kb) = w; } }
        job += two ? 2 * stride : stride;
    }
    job -= njobs;
}
struct E8SiluMul {
    bf16_t* out; int row0; int c0;
    __device__ __forceinline__ void operator()(const f32x4 (&acc)[2][2][4][2], int wr, int wc, int fr, int fq) const {
#pragma unroll
        for (int ai = 0; ai < 2; ++ai)
#pragma unroll
            for (int m = 0; m < 4; ++m) { const int r = row0 + ai * 128 + wr * 64 + m * 16 + fr;
#pragma unroll
                for (int n = 0; n < 2; ++n) { const int c = c0 + wc * 32 + n * 16 + fq * 4; float h[4];
#pragma unroll
                    for (int j = 0; j < 4; ++j) { const float g = acc[ai][0][m][n][j]; h[j] = g / (1.f + __expf(-g)) * acc[ai][1][m][n][j]; }
                    u32x2 w; w.x = cvtpk(h[0], h[1]); w.y = cvtpk(h[2], h[3]);
                    *(u32x2*)(out + (size_t)r * D_EXPERT + c) = w; } }
    }
};
struct E8ScaleRow {
    bf16_t* out; const float* roww; int rw0; int cnt; int row0; int col0;
    __device__ __forceinline__ void operator()(const f32x4 (&acc)[2][2][4][2], int wr, int wc, int fr, int fq) const {
#pragma unroll
        for (int ai = 0; ai < 2; ++ai)
#pragma unroll
            for (int m = 0; m < 4; ++m) { const int rl = ai * 128 + wr * 64 + m * 16 + fr; const float s = (rw0 + rl < cnt) ? roww[rw0 + rl] : 0.f; const int r = row0 + rl;
#pragma unroll
                for (int bj = 0; bj < 2; ++bj)
#pragma unroll
                    for (int n = 0; n < 2; ++n) { const int c = col0 + bj * 128 + wc * 32 + n * 16 + fq * 4; const f32x4 v = acc[ai][bj][m][n];
                        u32x2 w; w.x = cvtpk(v[0] * s, v[1] * s); w.y = cvtpk(v[2] * s, v[3] * s);
                        *(u32x2*)(out + (size_t)r * D_MODEL + c) = w; } }
    }
};

template <int WHICH>
__device__ __forceinline__ void moe_convert(CParams& p, const int le0, const int le1, char* lds, int job = -1, int stride = 0) {
    if (job < 0) { job = blockIdx.x; stride = gridDim.x; }
#pragma unroll 1
    for (int le = le0; le < le1; ++le) {
        if (WHICH & 1) {
            convert_weight<1>(p.moe_w_gate + (size_t)le * D_MODEL * D_EXPERT, D_MODEL, D_EXPERT, p.wgu_t + (size_t)le * 2048 * 2048, job, stride, lds);
            convert_weight<2>(p.moe_w_up + (size_t)le * D_MODEL * D_EXPERT, D_MODEL, D_EXPERT, p.wgu_t + (size_t)le * 2048 * 2048, job, stride, lds); }
        if (WHICH & 2)
            convert_weight<0>(p.moe_w_down + (size_t)le * D_EXPERT * D_MODEL, D_EXPERT, D_MODEL, p.wd_t + (size_t)le * 2048 * 1024, job, stride, lds);
    }
    __syncthreads();
}
#define KSWZ(row, colB) ((row) * 256 + ((colB) ^ (((row) & 7) << 4)))
#define SBAR() __builtin_amdgcn_sched_barrier(0)
#define TILE_B 16384
__device__ __forceinline__ int v_rd_base(int lane) { return ((lane & 3) << 3) | (((lane >> 2) & 3) << 6) | (((lane >> 4) & 1) << 5) | (((lane >> 5) & 1) << 8); }
constexpr int v_rd_off(int d0, int ks, int half) { return d0 * 512 + ks * 4096 + half * 2048; }
__device__ __forceinline__ int crow(int r, int hi) { return (r & 3) + 8 * (r >> 2) + 4 * hi; }

__device__ __forceinline__ unsigned fill_koff(int tid, int ld) { const int row = tid >> 4, cp = tid & 15; return (unsigned)(row * ld + ((cp ^ (row & 7)) << 3)); }
__device__ __forceinline__ unsigned fill_voff(int tid, int ld) { const int L = tid; const int kk = ((L >> 7) << 3) | ((L >> 2) & 7), c = (((L >> 5) & 3) << 5) | ((L & 3) << 3);
    const int k = (kk & ~0xC) | ((kk & 4) << 1) | ((kk & 8) >> 1); return (unsigned)(k * ld + c); }
__device__ __forceinline__ void fill_tile(const bf16_t* src, unsigned off, int ld, char* dst, int tid) {
    __builtin_amdgcn_global_load_lds((const unsigned*)(src + off), (unsigned*)(dst + tid * 16), 16, 0, 0);
    __builtin_amdgcn_global_load_lds((const unsigned*)(src + 32 * ld + off), (unsigned*)(dst + 8192 + tid * 16), 16, 0, 0);
}
__device__ __forceinline__ void qkt(f32x16& p0, f32x16& p1, const char* Kt, int r32, int hi, const bf16x8* qr) {
    p0 = f32x16{}; p1 = f32x16{};
    const char* kb[4];
#pragma unroll
    for (int dd = 0; dd < 4; ++dd) kb[dd] = Kt + KSWZ(r32, (dd * 16 + hi * 8) * 2);
    __builtin_amdgcn_s_setprio(1);
#pragma unroll
    for (int d0 = 0; d0 < 8; ++d0) { const char* a = kb[d0 & 3] + (d0 >> 2) * 128;
        bf16x8 b0 = *reinterpret_cast<const bf16x8*>(a);
        bf16x8 b1 = *reinterpret_cast<const bf16x8*>(a + 32 * 256);
        p0 = __builtin_amdgcn_mfma_f32_32x32x16_bf16(b0, qr[d0], p0, 0, 0, 0);
        p1 = __builtin_amdgcn_mfma_f32_32x32x16_bf16(b1, qr[d0], p1, 0, 0, 0); }
    __builtin_amdgcn_s_setprio(0);
}
__device__ __forceinline__ void qkt_lds(f32x16& p0, f32x16& p1, const char* Kt, int r32, int hi, const char* qb) {
    p0 = f32x16{}; p1 = f32x16{};
    const char* kb[4];
#pragma unroll
    for (int dd = 0; dd < 4; ++dd) kb[dd] = Kt + KSWZ(r32, (dd * 16 + hi * 8) * 2);
#pragma unroll
    for (int d0 = 0; d0 < 8; ++d0) { const char* a = kb[d0 & 3] + (d0 >> 2) * 128;
        bf16x8 b0 = *reinterpret_cast<const bf16x8*>(a);
        bf16x8 b1 = *reinterpret_cast<const bf16x8*>(a + 32 * 256);
        bf16x8 q = *reinterpret_cast<const bf16x8*>(qb + d0 * 1024);
        p0 = __builtin_amdgcn_mfma_f32_32x32x16_bf16(b0, q, p0, 0, 0, 0);
        p1 = __builtin_amdgcn_mfma_f32_32x32x16_bf16(b1, q, p1, 0, 0, 0); }
}
__device__ __forceinline__ void pv_tile(f32x16* o, int vb0, bf16x8 pa0, bf16x8 pa1, bf16x8 pa2, bf16x8 pa3) {
#define TRRD(dst, off) asm volatile("ds_read_b64_tr_b16 %0, %1 offset:%2" : "=&v"(dst) : "v"(vb0), "i"(off) : "memory")
#define PV_D0(d0) do { s16x4 l0, l1, l2, l3, h0, h1, h2, h3; constexpr int b_ = v_rd_off(d0, 0, 0); \
        TRRD(l0, b_); TRRD(h0, b_ + 2048); TRRD(l1, b_ + 4096); TRRD(h1, b_ + 6144); TRRD(l2, b_ + 8192); TRRD(h2, b_ + 10240); TRRD(l3, b_ + 12288); TRRD(h3, b_ + 14336); \
        asm volatile("s_waitcnt lgkmcnt(0)" ::: "memory"); SBAR(); \
        o[d0] = __builtin_amdgcn_mfma_f32_32x32x16_bf16(pa0, (bf16x8){l0[0], l0[1], l0[2], l0[3], h0[0], h0[1], h0[2], h0[3]}, o[d0], 0, 0, 0); \
        o[d0] = __builtin_amdgcn_mfma_f32_32x32x16_bf16(pa1, (bf16x8){l1[0], l1[1], l1[2], l1[3], h1[0], h1[1], h1[2], h1[3]}, o[d0], 0, 0, 0); \
        o[d0] = __builtin_amdgcn_mfma_f32_32x32x16_bf16(pa2, (bf16x8){l2[0], l2[1], l2[2], l2[3], h2[0], h2[1], h2[2], h2[3]}, o[d0], 0, 0, 0); \
        o[d0] = __builtin_amdgcn_mfma_f32_32x32x16_bf16(pa3, (bf16x8){l3[0], l3[1], l3[2], l3[3], h3[0], h3[1], h3[2], h3[3]}, o[d0], 0, 0, 0); } while (0)
    __builtin_amdgcn_s_setprio(1);
    PV_D0(0); PV_D0(1); PV_D0(2); PV_D0(3);
    __builtin_amdgcn_s_setprio(0);
#undef PV_D0
#undef TRRD
}
__device__ __forceinline__ float half_max(float v) { auto rr = __builtin_amdgcn_permlane32_swap(__float_as_uint(v), __float_as_uint(v), false, false); return fmaxf(__uint_as_float(rr[0]), __uint_as_float(rr[1])); }
__device__ __forceinline__ float half_sum(float v) { auto rr = __builtin_amdgcn_permlane32_swap(__float_as_uint(v), __float_as_uint(v), false, false); return __uint_as_float(rr[0]) + __uint_as_float(rr[1]); }
__device__ __forceinline__ void pack_p(const f32x16& p0, const f32x16& p1, bf16x8& pa0, bf16x8& pa1, bf16x8& pa2, bf16x8& pa3) {
#define PK4(P, B_, OUT) do { unsigned a0 = cvtpk(P[B_+0], P[B_+1]), a1 = cvtpk(P[B_+2], P[B_+3]);                          \
        unsigned b0 = cvtpk(P[B_+4], P[B_+5]), b1 = cvtpk(P[B_+6], P[B_+7]);                                             \
        auto r0 = __builtin_amdgcn_permlane32_swap(a0, b0, false, false); auto r1 = __builtin_amdgcn_permlane32_swap(a1, b1, false, false); \
        u32x4 w = {r0[0], r1[0], r0[1], r1[1]}; OUT = *reinterpret_cast<bf16x8*>(&w); } while (0)
    PK4(p0, 0, pa0); PK4(p0, 8, pa1); PK4(p1, 0, pa2); PK4(p1, 8, pa3);
#undef PK4
}
__device__ __forceinline__ float online_sm(f32x16& p0, f32x16& p1, float& m_reg, float& l_reg) {
    float pmax = p0[0];
#pragma unroll
    for (int r = 1; r < 16; ++r) pmax = fmaxf(pmax, p0[r]);
#pragma unroll
    for (int r = 0; r < 16; ++r) pmax = fmaxf(pmax, p1[r]);
    pmax = half_max(pmax);
    float mn, alpha;
    if (__all(pmax - m_reg <= 8.f)) { mn = m_reg; alpha = 1.f; }
    else { mn = fmaxf(m_reg, pmax); alpha = __builtin_amdgcn_exp2f(m_reg - mn); m_reg = mn; }
    float ps = 0.f;
#pragma unroll
    for (int r = 0; r < 16; ++r) { p0[r] = __builtin_amdgcn_exp2f(p0[r] - mn); ps += p0[r]; }
#pragma unroll
    for (int r = 0; r < 16; ++r) { p1[r] = __builtin_amdgcn_exp2f(p1[r] - mn); ps += p1[r]; }
    ps = half_sum(ps);
    l_reg = l_reg * alpha + ps;
    return alpha;
}
#define ROWX(scr, val, out16) do { if (hi == 0) (scr)[r32] = (val); asm volatile("s_waitcnt lgkmcnt(0)" ::: "memory"); \
        _Pragma("unroll") for (int r_ = 0; r_ < 16; ++r_) (out16)[r_] = (scr)[crow(r_, hi)]; asm volatile("s_waitcnt lgkmcnt(0)" ::: "memory"); } while (0)

__device__ __forceinline__ void diff_attn_unit(CParams& p, const int b, const int h, const int qb, char* lds, const float lam, const float one_m_li) {
    const int tid = tidx(), wid = __builtin_amdgcn_readfirstlane(tid >> 6), lane = tid & 63, r32 = lane & 31, hi = lane >> 5;
    const int rg = wid & 3, comp = wid >> 2;
    const int P0 = qb * 128, qlo = P0 + rg * 32, qpos = qlo + r32;
    const bf16_t* base = p.qkv + (size_t)b * SEQ * A_IN;
    const bf16_t* Kc0 = base + 2048 + (h * 2 + 0) * 128;
    const bf16_t* Vb = base + 4096 + h * 256;
    bf16x8 qr[8];
    { const bf16_t* qp = base + (size_t)qpos * A_IN + (h * 2 + comp) * 128 + hi * 8;
#pragma unroll
        for (int d0 = 0; d0 < 8; ++d0) qr[d0] = *(const bf16x8*)(qp + d0 * 16); }
    const int NT = 2 * qb + 2;
    const float slope = exp2f(-(float)(h + 1));
    const float C2 = 1.4426950408889634f * 0.08838834764831845f, sl2 = 1.4426950408889634f * slope;
    float m_reg = -1e30f, l_reg = 0.f; f32x16 o[8];
#pragma unroll
    for (int d = 0; d < 8; ++d) o[d] = f32x16{};
    const unsigned ko = fill_koff(tid, A_IN), vo = fill_voff(tid, A_IN);
#define DA_FILLK(t, bf) do { const size_t ro_ = (size_t)(t) * 64 * A_IN; char* B_ = lds + (bf) * 4 * TILE_B; \
        fill_tile(Kc0 + ro_, ko, A_IN, B_, tid); fill_tile(Kc0 + ro_ + 128, ko, A_IN, B_ + TILE_B, tid); } while (0)
#define DA_FILLV(t, bf) do { const size_t ro_ = (size_t)(t) * 64 * A_IN; char* B_ = lds + (bf) * 4 * TILE_B; \
        fill_tile(Vb + ro_, vo, A_IN, B_ + 2 * TILE_B, tid); fill_tile(Vb + ro_ + 128, vo, A_IN, B_ + 3 * TILE_B, tid); } while (0)
    DA_FILLK(0, 0); DA_FILLV(0, 0);
    __syncthreads();
    if (comp == 1) __syncthreads();
    for (int t = 0; t < NT; ++t) {
        const int bf = t & 1;
        const int kb = t * 64;
        const bool active = kb <= qlo + 31;
        bf16x8 pa0, pa1, pa2, pa3;
        if (t + 1 < NT) DA_FILLK(t + 1, bf ^ 1);
        if (active) {
            float* scr = (float*)(lds + 8 * TILE_B) + wid * 32;
            f32x16 p0, p1;
            qkt(p0, p1, lds + bf * 4 * TILE_B + comp * TILE_B, r32, hi, qr);
            float sl = sl2; asm volatile("" : "+v"(sl));
            const float bb = sl * (float)(kb - P0 + 4 * hi);
#pragma unroll
            for (int r = 0; r < 16; ++r) { const int c = (r & 3) + 8 * (r >> 2);
                p0[r] = fmaf(p0[r], C2, fmaf(sl, (float)c, bb)); p1[r] = fmaf(p1[r], C2, fmaf(sl, (float)(c + 32), bb)); }
            if (kb + 63 > qlo) {
                const int dq = qpos - kb - 4 * hi;
#pragma unroll
                for (int r = 0; r < 16; ++r) { const int c = (r & 3) + 8 * (r >> 2);
                    if (c > dq) p0[r] = -__builtin_inff();
                    if (c + 32 > dq) p1[r] = -__builtin_inff(); }
            }
            const float alpha = online_sm(p0, p1, m_reg, l_reg);
            if (__any(alpha < 1.f)) { float al[16]; ROWX(scr, alpha, al);
#pragma unroll
                for (int d = 0; d < 8; ++d)
#pragma unroll
                    for (int r = 0; r < 16; ++r) o[d][r] *= al[r]; }
            pack_p(p0, p1, pa0, pa1, pa2, pa3);
        }
        __syncthreads();
        if (t + 1 < NT) DA_FILLV(t + 1, bf ^ 1);
        if (active) {
            const int vb_lane = (int)(uintptr_t)lds + v_rd_base(lane) + bf * 4 * TILE_B;
            pv_tile(o, vb_lane + 2 * TILE_B, pa0, pa1, pa2, pa3);
            pv_tile(o + 4, vb_lane + 3 * TILE_B, pa0, pa1, pa2, pa3);
        }
        __syncthreads();
    }
    if (comp == 0) __syncthreads();
#undef DA_FILLK
#undef DA_FILLV
    int tz = tidx(); asm volatile("" : "+v"(tz));
    const int lane2 = tz & 63, r2 = lane2 & 31, h2 = lane2 >> 5, wid2 = tz >> 6, rg2 = wid2 & 3, comp2 = wid2 >> 2;
    { float il[16];
      { float* scr = (float*)(lds + 8 * TILE_B) + wid2 * 32; const int r32 = r2, hi = h2; ROWX(scr, 1.f / l_reg, il); }
#pragma unroll
      for (int d = 0; d < 8; ++d)
#pragma unroll
          for (int r = 0; r < 16; ++r) o[d][r] *= il[r]; }
    float* xch = (float*)lds + rg2 * 8192;
    if (comp2 == 1) {
#pragma unroll
        for (int d = 0; d < 8; ++d)
#pragma unroll
            for (int r = 0; r < 16; ++r) xch[(d * 16 + r) * 64 + lane2] = o[d][r];
    }
    __syncthreads();
    if (comp2 == 0) {
        float ssq[16];
#pragma unroll
        for (int r = 0; r < 16; ++r) ssq[r] = 0.f;
#pragma unroll
        for (int d = 0; d < 8; ++d) {
#pragma unroll
            for (int r = 0; r < 16; ++r) { float* q = xch + (d * 16 + r) * 64 + lane2; const float v = o[d][r] - lam * *q; *q = v; ssq[r] = fmaf(v, v, ssq[r]); }
            SBAR(); }
        float* rsc = (float*)(lds + 8 * TILE_B) + wid2 * 32;
#pragma unroll
        for (int r = 0; r < 16; ++r) {
            ssq[r] += shx<1>(ssq[r]); ssq[r] += shx<2>(ssq[r]); ssq[r] += shx<4>(ssq[r]); ssq[r] += shx<8>(ssq[r]); ssq[r] += shx<16>(ssq[r]);
            if (r2 == 0) rsc[crow(r, h2)] = rsqrtf(ssq[r] * (1.f / 256.f) + EPS) * one_m_li; }
        asm volatile("s_waitcnt lgkmcnt(0)" ::: "memory");
        bf16_t* ob = p.attn_o + ((size_t)b * SEQ + qb * 128 + rg2 * 32) * D_MODEL + h * 256;
#pragma unroll 4
        for (int i = 0; i < 16; ++i) { const int id = i * 64 + lane2, row = id >> 5, cc = id & 31;
            const int hh_ = (row >> 2) & 1, rr_ = (row & 3) + 4 * (row >> 3);
            const float* q = xch + ((cc >> 2) * 16 + rr_) * 64 + hh_ * 32 + (cc & 3) * 8;
            const f32x4 a = *(const f32x4*)q, c4 = *(const f32x4*)(q + 4);
            const f32x4 w0 = *(const f32x4*)(p.a_subln_w + cc * 8), w1 = *(const f32x4*)(p.a_subln_w + cc * 8 + 4);
            const float rs = rsc[row];
            u32x4 o4; o4.x = cvtpk(a[0] * rs * w0[0], a[1] * rs * w0[1]); o4.y = cvtpk(a[2] * rs * w0[2], a[3] * rs * w0[3]);
            o4.z = cvtpk(c4[0] * rs * w1[0], c4[1] * rs * w1[1]); o4.w = cvtpk(c4[2] * rs * w1[2], c4[3] * rs * w1[3]);
            *(u32x4*)(ob + (size_t)row * D_MODEL + cc * 8) = o4; }
    }
    __syncthreads();
}
__device__ __forceinline__ void phase_diff_attn(CParams& p, char* lds) {
    float lam;
    { const int lane = tidx() & 63; const float* L = p.a_lambda;
        float s1 = L[lane] * L[128 + lane] + L[64 + lane] * L[128 + 64 + lane];
        float s2 = L[256 + lane] * L[384 + lane] + L[256 + 64 + lane] * L[384 + 64 + lane];
        s1 = wave_sum(s1); s2 = wave_sum(s2);
        lam = __expf(s1) - __expf(s2) + 0.2f; }
    int it = 0; const int myslot = blockIdx.x % 3;
#pragma unroll 1
    for (int w = wgid_v(lds); w < 512; w += gridDim.x, ++it) {
        if (CONV_MODE == 1 && it == myslot) moe_convert<1>(p, 16, 32, lds);
        const int ww = w & 255, b = ww >> 7, h = (ww >> 4) & 7, qp = ww & 15;
        diff_attn_unit(p, b, h, w < 256 ? 31 - qp : qp, lds, lam, 0.8f);
    }
    if (CONV_MODE == 1 && myslot >= it) moe_convert<1>(p, 16, 32, lds);
}
#define NSA_IMP_OFF (4 * TILE_B)
#define NSA_SEL_OFF (8 * TILE_B)
#define NSA_UM_OFF (8 * TILE_B + 512)
#define NSA_SCR_OFF (8 * TILE_B + 1024)
#define NSA_LANE() int tz_ = tidx(); asm volatile("" : "+v"(tz_)); const int tid = tz_, wid = __builtin_amdgcn_readfirstlane(tz_ >> 6), lane = tz_ & 63, r32 = lane & 31, hi = lane >> 5; \
    const int hh = wid >> 1, th = wid & 1, tl = th * 32 + r32, pos = P0 + tl, Hh = g * 4 + hh; (void)tid; (void)hh; (void)th; (void)tl; (void)pos; (void)Hh; (void)hi; \
    float* scr = (float*)(lds + NSA_SCR_OFF) + wid * 32; (void)scr; const int vb_lane = (int)(uintptr_t)lds + v_rd_base(lane); (void)vb_lane; \
    const float sl2 = 1.4426950408889634f * exp2f(-0.5f * (float)(Hh + 1)); (void)sl2;
#define NSA_C2 (1.4426950408889634f * 0.08838834764831845f)
#define NSA_RESCALE(o, alpha) do { if (__any((alpha) < 1.f)) { float al_[16]; ROWX(scr, (alpha), al_); \
        _Pragma("unroll") for (int d_ = 0; d_ < 4; ++d_) _Pragma("unroll") for (int r_ = 0; r_ < 16; ++r_) (o)[d_][r_] *= al_[r_]; } } while (0)
#define NSA_ACCUM(tot, o, fac, first) do { float f_[16]; ROWX(scr, (fac), f_); \
        _Pragma("unroll") for (int d_ = 0; d_ < 4; ++d_) _Pragma("unroll") for (int q_ = 0; q_ < 8; ++q_) { \
            float a_ = (o)[d_][2 * q_] * f_[2 * q_], b_ = (o)[d_][2 * q_ + 1] * f_[2 * q_ + 1]; \
            if (!(first)) { a_ += __uint_as_float((tot)[d_][q_] << 16); b_ += __uint_as_float((tot)[d_][q_] & 0xffff0000u); } \
            (tot)[d_][q_] = cvtpk(a_, b_); } } while (0)

__device__ __forceinline__ void nsa_unit(CParams& p, const int b, const int g, const int qb, char* lds) {
    const int P0 = qb * 64;
    const bf16_t* proj = p.qkv + (size_t)b * SEQ * B_MAIN;
    bf16x8 qr[8];
    unsigned tot[4][8];
    {   NSA_LANE();
        const bf16_t* qp = proj + (size_t)pos * B_MAIN + Hh * 128 + hi * 8;
#pragma unroll
        for (int d0 = 0; d0 < 8; ++d0) qr[d0] = *(const bf16x8*)(qp + d0 * 16);
        float* ir = (float*)(lds + NSA_IMP_OFF) + ((size_t)hh * 64 + tl) * 64 + hi * 32;
#pragma unroll
        for (int i = 0; i < 8; ++i) *(f32x4*)(ir + 4 * i) = (f32x4){0.f, 0.f, 0.f, 0.f};
    }
    {   NSA_LANE();
        const bf16_t* kcmp = p.kvcmp + ((size_t)(b * 256) * 4 + g) * 128;
        const bf16_t* vcmp = kcmp + (size_t)2048 * 128;
        const unsigned ko = fill_koff(tid, 512), vo = fill_voff(tid, 512);
        const int NTc = (4 * qb + 2) / 64 + 1;
        const int cmaxl = pos >= 31 ? ((pos - 31) >> 4) : -1;
        float m_c = -1e30f, l_c = 0.f;
#define CMP_SCORES(t) do { float sl_ = sl2 * 16.f; asm volatile("" : "+v"(sl_)); const float bb = sl_ * (float)((t) * 64 + 4 * hi); const int dq = cmaxl - (t) * 64 - 4 * hi; \
        _Pragma("unroll") for (int r = 0; r < 16; ++r) { const int c = (r & 3) + 8 * (r >> 2); \
            p0[r] = c > dq ? -__builtin_inff() : fmaf(p0[r], NSA_C2, fmaf(sl_, (float)c, bb)); \
            p1[r] = c + 32 > dq ? -__builtin_inff() : fmaf(p1[r], NSA_C2, fmaf(sl_, (float)(c + 32), bb)); } } while (0)
        fill_tile(kcmp, ko, 512, lds, tid);
        __syncthreads();
        for (int t = 0; t < NTc; ++t) {
            const int bf = t & 1;
            if (t + 1 < NTc) fill_tile(kcmp + (size_t)(t + 1) * 64 * 512, ko, 512, lds + (bf ^ 1) * 2 * TILE_B, tid);
            f32x16 p0, p1;
            qkt(p0, p1, lds + bf * 2 * TILE_B, r32, hi, qr);
            CMP_SCORES(t);
            (void)online_sm(p0, p1, m_c, l_c);
            __syncthreads();
        }
        const float inv_l = l_c > 0.f ? 1.f / l_c : 0.f;
        f32x16 o[4];
#pragma unroll
        for (int d = 0; d < 4; ++d) o[d] = f32x16{};
        float carry = 0.f;
        fill_tile(kcmp, ko, 512, lds, tid); fill_tile(vcmp, vo, 512, lds + TILE_B, tid);
        __syncthreads();
        for (int t = 0; t < NTc; ++t) {
            const int bf = t & 1;
            if (t + 1 < NTc) { fill_tile(kcmp + (size_t)(t + 1) * 64 * 512, ko, 512, lds + (bf ^ 1) * 2 * TILE_B, tid);
                               fill_tile(vcmp + (size_t)(t + 1) * 64 * 512, vo, 512, lds + (bf ^ 1) * 2 * TILE_B + TILE_B, tid); }
            f32x16 p0, p1;
            qkt(p0, p1, lds + bf * 2 * TILE_B, r32, hi, qr);
            CMP_SCORES(t);
#pragma unroll
            for (int r = 0; r < 16; ++r) { p0[r] = __builtin_amdgcn_exp2f(p0[r] - m_c) * inv_l; p1[r] = __builtin_amdgcn_exp2f(p1[r] - m_c) * inv_l; }
            { float mv[8], sp[8], ps[8];
#pragma unroll
                for (int q = 0; q < 4; ++q) { sp[q] = 0.5f * p0[4 * q + 3]; mv[q] = p0[4 * q] + p0[4 * q + 1] + p0[4 * q + 2] + sp[q];
                                              sp[4 + q] = 0.5f * p1[4 * q + 3]; mv[4 + q] = p1[4 * q] + p1[4 * q + 1] + p1[4 * q + 2] + sp[4 + q]; }
#pragma unroll
                for (int q = 0; q < 8; ++q) ps[q] = shx<32>(sp[q]);
                float* ir = (float*)(lds + NSA_IMP_OFF) + ((size_t)hh * 64 + tl) * 64 + 16 * t + hi;
#pragma unroll
                for (int q = 0; q < 8; ++q) { const float lo = q > 0 ? ps[q > 0 ? q - 1 : 0] : carry; ir[2 * q] = mv[q] + (hi ? ps[q] : lo); }
                carry = ps[7]; }
            bf16x8 pa0, pa1, pa2, pa3; pack_p(p0, p1, pa0, pa1, pa2, pa3);
            pv_tile(o, vb_lane + bf * 2 * TILE_B + TILE_B, pa0, pa1, pa2, pa3);
            __syncthreads();
        }
#undef CMP_SCORES
        const float g0 = p.gate[((size_t)b * SEQ + pos) * 48 + Hh * 3 + 0];
        NSA_ACCUM(tot, o, g0, true);
    }
    {
        const int lane = tidx() & 63, wid = __builtin_amdgcn_readfirstlane(tidx() >> 6);
        const float* imp = (const float*)(lds + NSA_IMP_OFF);
        unsigned long long* selm = (unsigned long long*)(lds + NSA_SEL_OFF);
#pragma unroll 1
        for (int i0 = 0; i0 < 8; i0 += 8) { const int j = lane;
            unsigned key[8], thr[8];
#pragma unroll
            for (int q = 0; q < 8; ++q) { const int tk = wid * 8 + i0 + q;
                const float* ir = imp + (size_t)tk * 64 + j;
                const float v = ((ir[0] + ir[64 * 64]) + ir[2 * 64 * 64]) + ir[3 * 64 * 64];
                const bool forced = (j == 0) || (j == qb) || (j == qb - 1);
                const float sc = forced ? 1e4f : (j <= qb ? v : -1e4f);
                unsigned k_ = __float_as_uint(sc); key[q] = (k_ & 0x80000000u) ? ~k_ : (k_ | 0x80000000u); thr[q] = 0u; }
#pragma unroll 1
            for (int bit = 31; bit >= 0; --bit) {
#pragma unroll
                for (int q = 0; q < 8; ++q) { const unsigned cand = thr[q] | (1u << bit);
                    if (__popcll(__ballot(key[q] >= cand)) >= 16) thr[q] = cand; } }
#pragma unroll
            for (int q = 0; q < 8; ++q) { const int tk = wid * 8 + i0 + q;
                const unsigned long long gt = __ballot(key[q] > thr[q]), eq = __ballot(key[q] == thr[q]);
                const int need = 16 - __popcll(gt);
                const bool sel = (key[q] > thr[q]) || (key[q] == thr[q] && __popcll(eq & ((1ull << j) - 1ull)) < need);
                const unsigned long long sm = __ballot(sel && j <= qb);
                if (lane == 0) selm[tk] = sm; } }
        __syncthreads();
        if (wid == 0) { unsigned long long u = selm[lane];
#define UM_STEP(S) do { const unsigned lo = (unsigned)shx_i<S>((int)(unsigned)u), hi2 = (unsigned)shx_i<S>((int)(unsigned)(u >> 32)); u |= ((unsigned long long)hi2 << 32) | lo; } while (0)
            UM_STEP(32); UM_STEP(16); UM_STEP(8); UM_STEP(4); UM_STEP(2); UM_STEP(1);
#undef UM_STEP
            if (lane == 0) *(unsigned long long*)(lds + NSA_UM_OFF) = u; }
        { char* qd = lds + NSA_IMP_OFF + wid * 8192 + lane * 16;
#pragma unroll
            for (int d0 = 0; d0 < 8; ++d0) *(bf16x8*)(qd + d0 * 1024) = qr[d0]; }
        __syncthreads();
    }
    {   NSA_LANE();
        const unsigned long long mysel = ((const unsigned long long*)(lds + NSA_SEL_OFF))[tl];
        unsigned long long um = *(const unsigned long long*)(lds + NSA_UM_OFF);
        um = ((unsigned long long)__builtin_amdgcn_readfirstlane((unsigned)(um >> 32)) << 32) | (unsigned)__builtin_amdgcn_readfirstlane((unsigned)um);
        const bf16_t* Ks = proj + 3072 + g * 128; const bf16_t* Vs = proj + 3584 + g * 128;
        const unsigned ko = fill_koff(tid, B_MAIN), vo = fill_voff(tid, B_MAIN);
        float m_s = -1e30f, l_s = 0.f; f32x16 o[4];
#pragma unroll
        for (int d = 0; d < 4; ++d) o[d] = f32x16{};
        int j = __builtin_ctzll(um); um &= um - 1; int idx = 0;
        fill_tile(Ks + (size_t)j * 64 * B_MAIN, ko, B_MAIN, lds, tid); fill_tile(Vs + (size_t)j * 64 * B_MAIN, vo, B_MAIN, lds + TILE_B, tid);
        __syncthreads();
        for (;;) {
            const int bf = idx & 1; int jn = -1;
            if (um) { jn = __builtin_ctzll(um); um &= um - 1;
                fill_tile(Ks + (size_t)jn * 64 * B_MAIN, ko, B_MAIN, lds + (bf ^ 1) * 2 * TILE_B, tid); fill_tile(Vs + (size_t)jn * 64 * B_MAIN, vo, B_MAIN, lds + (bf ^ 1) * 2 * TILE_B + TILE_B, tid); }
            const bool ms = (mysel >> j) & 1ull;
            if (__any(ms)) {
                f32x16 p0, p1;
                qkt_lds(p0, p1, lds + bf * 2 * TILE_B, r32, hi, lds + NSA_IMP_OFF + wid * 8192 + lane * 16);
                float sl_ = sl2; asm volatile("" : "+v"(sl_));
                const float bb = sl_ * (float)(j * 64 - P0 + 4 * hi); const int dq = !ms ? -1000 : (j == qb) ? (tl - 4 * hi) : 1000;
#pragma unroll
                for (int r = 0; r < 16; ++r) { const int c = (r & 3) + 8 * (r >> 2);
                    p0[r] = (c > dq) ? -__builtin_inff() : fmaf(p0[r], NSA_C2, fmaf(sl_, (float)c, bb));
                    p1[r] = (c + 32 > dq) ? -__builtin_inff() : fmaf(p1[r], NSA_C2, fmaf(sl_, (float)(c + 32), bb)); }
                const float alpha = online_sm(p0, p1, m_s, l_s);
                NSA_RESCALE(o, alpha);
                bf16x8 pa0, pa1, pa2, pa3; pack_p(p0, p1, pa0, pa1, pa2, pa3);
                pv_tile(o, vb_lane + bf * 2 * TILE_B + TILE_B, pa0, pa1, pa2, pa3);
            }
            __syncthreads();
            if (jn < 0) break;
            j = jn; ++idx;
        }
        const float g1 = p.gate[((size_t)b * SEQ + pos) * 48 + Hh * 3 + 1];
        NSA_ACCUM(tot, o, g1 / l_s, false);
    }
    {   NSA_LANE();
        const bf16_t* Kw = proj + 4096 + g * 128; const bf16_t* Vw = proj + 4608 + g * 128;
        const unsigned ko = fill_koff(tid, B_MAIN), vo = fill_voff(tid, B_MAIN);
        float m_w = -1e30f, l_w = 0.f; f32x16 o[4];
#pragma unroll
        for (int d = 0; d < 4; ++d) o[d] = f32x16{};
        const int j0 = qb >= 8 ? qb - 8 : 0, NTw = qb - j0 + 1;
        fill_tile(Kw + (size_t)j0 * 64 * B_MAIN, ko, B_MAIN, lds, tid); fill_tile(Vw + (size_t)j0 * 64 * B_MAIN, vo, B_MAIN, lds + TILE_B, tid);
        __syncthreads();
        for (int t = 0; t < NTw; ++t) {
            const int bf = t & 1, j = j0 + t;
            if (t + 1 < NTw) { fill_tile(Kw + (size_t)(j + 1) * 64 * B_MAIN, ko, B_MAIN, lds + (bf ^ 1) * 2 * TILE_B, tid); fill_tile(Vw + (size_t)(j + 1) * 64 * B_MAIN, vo, B_MAIN, lds + (bf ^ 1) * 2 * TILE_B + TILE_B, tid); }
            f32x16 p0, p1;
            qkt_lds(p0, p1, lds + bf * 2 * TILE_B, r32, hi, lds + NSA_IMP_OFF + wid * 8192 + lane * 16);
            float sl_ = sl2; asm volatile("" : "+v"(sl_));
            const float bb = sl_ * (float)(j * 64 - P0 + 4 * hi);
#pragma unroll
            for (int r = 0; r < 16; ++r) { const int c = (r & 3) + 8 * (r >> 2);
                p0[r] = fmaf(p0[r], NSA_C2, fmaf(sl_, (float)c, bb)); p1[r] = fmaf(p1[r], NSA_C2, fmaf(sl_, (float)(c + 32), bb)); }
            if (j == qb || j == qb - 8) { const int dq = pos - j * 64 - 4 * hi;
#pragma unroll
                for (int r = 0; r < 16; ++r) { const int c = (r & 3) + 8 * (r >> 2);
                    if ((unsigned)(dq - c) >= 512u) p0[r] = -__builtin_inff();
                    if ((unsigned)(dq - c - 32) >= 512u) p1[r] = -__builtin_inff(); } }
            const float alpha = online_sm(p0, p1, m_w, l_w);
            NSA_RESCALE(o, alpha);
            bf16x8 pa0, pa1, pa2, pa3; pack_p(p0, p1, pa0, pa1, pa2, pa3);
            pv_tile(o, vb_lane + bf * 2 * TILE_B + TILE_B, pa0, pa1, pa2, pa3);
            __syncthreads();
        }
        const float g2 = p.gate[((size_t)b * SEQ + pos) * 48 + Hh * 3 + 2];
        NSA_ACCUM(tot, o, g2 / l_w, false);
    }
    {   NSA_LANE();
        bf16_t* st = (bf16_t*)(lds + wid * 8192);
#pragma unroll
        for (int d = 0; d < 4; ++d) {
#pragma unroll
            for (int r = 0; r < 16; ++r) st[crow(r, hi) * 128 + d * 32 + r32] = (bf16_t)((r & 1) ? (tot[d][r >> 1] >> 16) : (tot[d][r >> 1] & 0xffffu));
            SBAR(); }
        asm volatile("s_waitcnt lgkmcnt(0)" ::: "memory");
        bf16_t* ob = p.attn_o + ((size_t)b * SEQ + P0 + th * 32) * D_MODEL + Hh * 128;
#pragma unroll
        for (int i = 0; i < 8; ++i) { const int id = i * 64 + lane, row = id >> 4, cc = id & 15;
            *(u32x4*)(ob + (size_t)row * D_MODEL + cc * 8) = *(const u32x4*)(st + row * 128 + cc * 8); }
    }
    __syncthreads();
}
__device__ __forceinline__ void phase_nsa(CParams& p, char* lds) {
    int it = 0; const int myslot = blockIdx.x % 3;
#pragma unroll 1
    for (int w = wgid_v(lds); w < 512; w += gridDim.x, ++it) {
        if (CONV_MODE == 1 && it == myslot) moe_convert<1>(p, 54, 64, lds);
        const int ww = w & 255, b = ww >> 7, g = (ww >> 5) & 3, qp = ww & 31;
        nsa_unit(p, b, g, w < 256 ? 63 - qp : qp, lds);
    }
    if (CONV_MODE == 1 && myslot >= it) moe_convert<1>(p, 54, 64, lds);
}
__device__ __forceinline__ void load_row(const float* src, int lane, f32x4 (&v)[8]) {
#pragma unroll
    for (int i = 0; i < 8; ++i) v[i] = *(const f32x4*)(src + (i * 64 + lane) * 4);
}
__device__ __forceinline__ void load_row_bf16(const bf16_t* src, int lane, f32x4 (&v)[8]) {
#pragma unroll
    for (int i = 0; i < 8; ++i) { const u32x2 w = *(const u32x2*)(src + (i * 64 + lane) * 4);
        v[i][0] = __uint_as_float(w.x << 16); v[i][1] = __uint_as_float(w.x & 0xffff0000u);
        v[i][2] = __uint_as_float(w.y << 16); v[i][3] = __uint_as_float(w.y & 0xffff0000u); }
}
__device__ __forceinline__ void add_bf16_row(const bf16_t* src, int lane, f32x4 (&v)[8]) {
#pragma unroll
    for (int i = 0; i < 8; ++i) { const u32x2 w = *(const u32x2*)(src + (i * 64 + lane) * 4);
        v[i][0] += __uint_as_float(w.x << 16); v[i][1] += __uint_as_float(w.x & 0xffff0000u);
        v[i][2] += __uint_as_float(w.y << 16); v[i][3] += __uint_as_float(w.y & 0xffff0000u); }
}
__device__ __forceinline__ float row_rstd(const f32x4 (&v)[8]) {
    float ss = 0.f;
#pragma unroll
    for (int i = 0; i < 8; ++i) ss += v[i][0] * v[i][0] + v[i][1] * v[i][1] + v[i][2] * v[i][2] + v[i][3] * v[i][3];
    ss = wave_sum(ss); return rsqrtf(ss * (1.f / D_MODEL) + EPS);
}
__device__ __forceinline__ void norm_store_bf16(f32x4 (&v)[8], float rs, const float* w, bf16_t* dst, int lane) {
#pragma unroll
    for (int i = 0; i < 8; ++i) { const f32x4 wv = *(const f32x4*)(w + (i * 64 + lane) * 4);
        v[i][0] *= rs * wv[0]; v[i][1] *= rs * wv[1]; v[i][2] *= rs * wv[2]; v[i][3] *= rs * wv[3];
        u32x2 o; o.x = cvtpk(v[i][0], v[i][1]); o.y = cvtpk(v[i][2], v[i][3]);
        *(u32x2*)(dst + (i * 64 + lane) * 4) = o; }
}
struct MoeTab { int cnt[32]; int rbase[32]; int ustart[33]; int next; };
__device__ __forceinline__ void moe_tables(const unsigned* cnt, MoeTab* tb) {
    if (tidx() == 0) { int acc = 0;
        for (int e = 0; e < 32; ++e) { const int c = (int)cnt[e]; tb->cnt[e] = c; tb->rbase[e] = acc * 256; tb->ustart[e] = acc * 16; acc += (c + 255) >> 8; }
        tb->ustart[32] = acc * 16; }
    __syncthreads();
}

__device__ __forceinline__ void phase_first(CParams& p, char* lds) {
    const int tid = tidx(), wid = tid >> 6, lane = tid & 63;
    if (blockIdx.x == 0 && tid < 128) p.cnt[tid] = 0u;
    for (int i = blockIdx.x * NTHREADS + tid; i < 2 * 64 * D_MODEL; i += gridDim.x * NTHREADS) { const int l = i >> 17, e = (i >> 11) & 63, k = i & 2047;
        const float w = e < 4 ? p.moe_w_group[((size_t)l * D_MODEL + k) * 4 + e] : e < 36 ? p.moe_w_expert[((size_t)l * D_MODEL + k) * 32 + (e - 4)] : 0.f;
        const bf16_t whi = f2bf(w); p.rw_hi[i] = whi; p.rw_lo[i] = f2bf(w - bf2f(whi)); }
    { const int rstep = gridDim.x * 8;
      for (int row = blockIdx.x * 8 + wid; row < T_TOK; row += 2 * rstep) {
        const int rowb = row + rstep; const bool hb = rowb < T_TOK; const int rb_ = hb ? rowb : row;
        f32x4 va[8], vb[8]; load_row(p.x + (size_t)row * D_MODEL, lane, va); load_row(p.x + (size_t)rb_ * D_MODEL, lane, vb);
        const float rsa = row_rstd(va), rsb = row_rstd(vb);
        norm_store_bf16(va, rsa, p.attn_norm_w, p.xn + (size_t)row * D_MODEL, lane);
        if (hb) norm_store_bf16(vb, rsb, p.attn_norm_w, p.xn + (size_t)rowb * D_MODEL, lane);
      } }
    __syncthreads();
    int job = blockIdx.x; const int stride = gridDim.x;
    convert_weight<0>(p.a_w_in, D_MODEL, A_IN, p.wt_a_in, job, stride, lds);
    convert_weight<0>(p.a_w_out, D_MODEL, D_MODEL, p.wt_a_out, job, stride, lds);
    convert_weight<0>(p.b_w_in, D_MODEL, B_IN, p.wt_b_in, job, stride, lds);
    convert_weight<0>(p.b_w_out, D_MODEL, D_MODEL, p.wt_b_out, job, stride, lds);
    __syncthreads();
#if CONV_MODE == 0
    moe_convert<3>(p, 0, 64, lds);
#endif
}

struct RouteDec { int ea, eb; float wa, wb; };
__device__ __forceinline__ void route_decide(CParams& p, const int layer, const float (&acc)[36], RouteDec* out) {
    const float* bg = p.moe_b_group + layer * 4; const float* be = p.moe_b_expert + layer * 32;
    float lg[4];
#pragma unroll
    for (int j = 0; j < 4; ++j) lg[j] = acc[j] + bg[j];
    int gt = 0; float gm = lg[0];
#pragma unroll
    for (int j = 1; j < 4; ++j) if (lg[j] > gm) { gm = lg[j]; gt = j; }
    float gs = 0.f;
#pragma unroll
    for (int j = 0; j < 4; ++j) gs += __expf(lg[j] - gm);
    const float wgp = 1.f / gs;
    int ea = 0, eb = -1; float m0 = -3.0e38f, m1 = -3.0e38f;
#pragma unroll
    for (int k = 0; k < 32; ++k) { const float v = ((k >> 3) == gt) ? acc[4 + k] + be[k] : -3.0e38f; if (v > m0) { m0 = v; ea = k; } }
#pragma unroll
    for (int k = 0; k < 32; ++k) { const float v = ((k >> 3) == gt && k != ea) ? acc[4 + k] + be[k] : -3.0e38f; if (v > m1) { m1 = v; eb = k; } }
    const float e1 = __expf(m1 - m0);
    out->ea = ea; out->eb = eb; out->wa = wgp / (1.f + e1); out->wb = wgp * e1 / (1.f + e1);
}
#define DPP_ADD(v, CTRL) v += __int_as_float(__builtin_amdgcn_update_dpp(0, __float_as_int(v), CTRL, 0xf, 0xf, false))
__device__ __forceinline__ void reduce36(float (&a)[36]) {
    float u[9];
#pragma unroll
    for (int i = 0; i < 9; ++i) {
        float z[2];
#pragma unroll
        for (int h = 0; h < 2; ++h) {
            const u32x2 s = __builtin_amdgcn_permlane32_swap(__float_as_uint(a[4 * i + 2 * h]), __float_as_uint(a[4 * i + 2 * h + 1]), false, false);
            z[h] = __uint_as_float(s[0]) + __uint_as_float(s[1]); }
        const u32x2 t = __builtin_amdgcn_permlane16_swap(__float_as_uint(z[0]), __float_as_uint(z[1]), false, false);
        float x = __uint_as_float(t[0]) + __uint_as_float(t[1]);
        DPP_ADD(x, 0x128); DPP_ADD(x, 0x124); DPP_ADD(x, 0x122); DPP_ADD(x, 0x121);
        u[i] = x; }
#pragma unroll
    for (int i = 0; i < 9; ++i) {
        a[4 * i + 0] = __int_as_float(__builtin_amdgcn_readlane(__float_as_int(u[i]), 0));  a[4 * i + 2] = __int_as_float(__builtin_amdgcn_readlane(__float_as_int(u[i]), 16));
        a[4 * i + 1] = __int_as_float(__builtin_amdgcn_readlane(__float_as_int(u[i]), 32)); a[4 * i + 3] = __int_as_float(__builtin_amdgcn_readlane(__float_as_int(u[i]), 48)); }
}
#define NR_MAXROWS 512
#define NRW 4
__device__ __forceinline__ void phase_norm_route(CParams& p, const bf16_t* h, const int layer, char* lds) {
    const int tid = tidx(), wid = tid >> 6, lane = tid & 63;
    const float* nw = p.ffn_norm_w + layer * D_MODEL;
    float* fin = (float*)lds;
    float* rsl = (float*)(lds + 57344);
    float* part = (float*)(lds + 65536);
    RouteDec* dec = (RouteDec*)(lds + 40960);
    int* dtok = (int*)(lds + 40960 + NR_MAXROWS * 16);
    int* hist = dtok + NR_MAXROWS;
    int* posa = hist + 64; int* posb = posa + NR_MAXROWS;
    if (tid < 64) hist[tid] = 0;
    int nrows = 0;
    for (int rb = blockIdx.x; rb < T_TOK / (8 * NRW); rb += gridDim.x, nrows += 8 * NRW) {
        const int row0 = rb * (8 * NRW) + wid * NRW;
        float rs[NRW];
#pragma unroll
        for (int r = 0; r < NRW; r += 2) { f32x4 va[8], vb[8];
            load_row_bf16(h + (size_t)(row0 + r) * D_MODEL, lane, va); load_row_bf16(h + (size_t)(row0 + r + 1) * D_MODEL, lane, vb);
            rs[r] = row_rstd(va); rs[r + 1] = row_rstd(vb);
            norm_store_bf16(va, rs[r], nw, p.xn + (size_t)(row0 + r) * D_MODEL, lane);
            norm_store_bf16(vb, rs[r + 1], nw, p.xn + (size_t)(row0 + r + 1) * D_MODEL, lane); }
        if (lane == 0) {
#pragma unroll
            for (int r = 0; r < NRW; ++r) rsl[wid * NRW + r] = rs[r]; }
        __syncthreads();
        { const int j = lane & 31, hi = lane >> 5; const float rsj = rsl[j];
          f32x16 d0 = {}, d1 = {};
          const bf16_t* hrow = h + (size_t)(rb * (8 * NRW) + j) * D_MODEL + wid * 256 + 8 * hi;
          const float* nwp = nw + wid * 256 + 8 * hi;
          const bf16_t* wh = p.rw_hi + ((size_t)(layer * 64 + j) * D_MODEL) + wid * 256 + 8 * hi; const bf16_t* wl = p.rw_lo + ((size_t)(layer * 64 + j) * D_MODEL) + wid * 256 + 8 * hi;
#pragma unroll 4
          for (int ks = 0; ks < 16; ++ks) {
              const u32x4 hv = *(const u32x4*)(hrow + ks * 16); const f32x4 na = *(const f32x4*)(nwp + ks * 16), nb = *(const f32x4*)(nwp + ks * 16 + 4);
              float x[8];
              x[0] = __uint_as_float(hv.x << 16) * (rsj * na[0]); x[1] = __uint_as_float(hv.x & 0xffff0000u) * (rsj * na[1]);
              x[2] = __uint_as_float(hv.y << 16) * (rsj * na[2]); x[3] = __uint_as_float(hv.y & 0xffff0000u) * (rsj * na[3]);
              x[4] = __uint_as_float(hv.z << 16) * (rsj * nb[0]); x[5] = __uint_as_float(hv.z & 0xffff0000u) * (rsj * nb[1]);
              x[6] = __uint_as_float(hv.w << 16) * (rsj * nb[2]); x[7] = __uint_as_float(hv.w & 0xffff0000u) * (rsj * nb[3]);
              u32x4 xh, xl;
              xh.x = cvtpk(x[0], x[1]); xh.y = cvtpk(x[2], x[3]); xh.z = cvtpk(x[4], x[5]); xh.w = cvtpk(x[6], x[7]);
              xl.x = cvtpk(x[0] - __uint_as_float(xh.x << 16), x[1] - __uint_as_float(xh.x & 0xffff0000u)); xl.y = cvtpk(x[2] - __uint_as_float(xh.y << 16), x[3] - __uint_as_float(xh.y & 0xffff0000u));
              xl.z = cvtpk(x[4] - __uint_as_float(xh.z << 16), x[5] - __uint_as_float(xh.z & 0xffff0000u)); xl.w = cvtpk(x[6] - __uint_as_float(xh.w << 16), x[7] - __uint_as_float(xh.w & 0xffff0000u));
              const bf16x8 xhf = __builtin_bit_cast(bf16x8, xh), xlf = __builtin_bit_cast(bf16x8, xl);
              const bf16x8 wh0 = *(const bf16x8*)(wh + ks * 16), wl0 = *(const bf16x8*)(wl + ks * 16);
              const bf16x8 wh1 = *(const bf16x8*)(wh + (size_t)32 * D_MODEL + ks * 16), wl1 = *(const bf16x8*)(wl + (size_t)32 * D_MODEL + ks * 16);
              d0 = __builtin_amdgcn_mfma_f32_32x32x16_bf16(wh0, xhf, d0, 0, 0, 0); d0 = __builtin_amdgcn_mfma_f32_32x32x16_bf16(wl0, xhf, d0, 0, 0, 0); d0 = __builtin_amdgcn_mfma_f32_32x32x16_bf16(wh0, xlf, d0, 0, 0, 0);
              d1 = __builtin_amdgcn_mfma_f32_32x32x16_bf16(wh1, xhf, d1, 0, 0, 0); d1 = __builtin_amdgcn_mfma_f32_32x32x16_bf16(wl1, xhf, d1, 0, 0, 0); d1 = __builtin_amdgcn_mfma_f32_32x32x16_bf16(wh1, xlf, d1, 0, 0, 0); }
          float* pw = part + ((size_t)(wid * 32 + j)) * 40;
#pragma unroll
          for (int r = 0; r < 16; ++r) pw[(r & 3) + 8 * (r >> 2) + 4 * hi] = d0[r];
          if (hi == 0) {
#pragma unroll
              for (int r = 0; r < 4; ++r) pw[32 + r] = d1[r]; } }
        __syncthreads();
        for (int idx = tid; idx < 32 * 36; idx += NTHREADS) { const int row = idx / 36, e = idx - row * 36; float s = 0.f;
#pragma unroll
            for (int w = 0; w < 8; ++w) s += part[(size_t)(w * 32 + row) * 40 + e];
            fin[idx] = s; }
        __syncthreads();
        if (tid < 32 && nrows + tid < NR_MAXROWS) { float acc[36];
#pragma unroll
            for (int e = 0; e < 36; ++e) acc[e] = fin[tid * 36 + e];
            route_decide(p, layer, acc, &dec[nrows + tid]); dtok[nrows + tid] = rb * (8 * NRW) + tid; }
        __syncthreads();
    }
    __syncthreads();
    if (nrows > NR_MAXROWS) nrows = NR_MAXROWS;
    if (tid < nrows) { posa[tid] = atomicAdd(&hist[dec[tid].ea], 1); posb[tid] = atomicAdd(&hist[dec[tid].eb], 1); }
    __syncthreads();
    if (tid < 32) { const int c = hist[tid]; hist[32 + tid] = c ? (int)atomicAdd(p.cnt + layer * 32 + tid, (unsigned)c) : 0; }
    __syncthreads();
    if (tid < nrows) { const RouteDec d = dec[tid]; const int tok = dtok[tid];
        const int ra = hist[32 + d.ea] + posa[tid], rb2 = hist[32 + d.eb] + posb[tid];
        p.list_tok[d.ea * LIST_CAP + ra] = tok; p.list_w[d.ea * LIST_CAP + ra] = d.wa;
        p.list_tok[d.eb * LIST_CAP + rb2] = tok; p.list_w[d.eb * LIST_CAP + rb2] = d.wb;
        p.slot_ref[tok * 2 + 0] = (d.ea << 16) | ra; p.slot_ref[tok * 2 + 1] = (d.eb << 16) | rb2; }
    __syncthreads();
}
template <int MODE>
__device__ __forceinline__ void phase_combine(CParams& p, const bf16_t* hold, bf16_t* hnew, const float* w, const int layer, char* lds) {
    MoeTab* tb = (MoeTab*)lds; (void)layer;
    const int wid = tidx() >> 6, lane = tidx() & 63;
#define CB_FIN(row, v) do { \
        if (MODE == 0) { \
            _Pragma("unroll") for (int i = 0; i < 8; ++i) { u32x2 o; o.x = cvtpk(v[i][0], v[i][1]); o.y = cvtpk(v[i][2], v[i][3]); *(u32x2*)(hnew + (size_t)(row) * D_MODEL + (i * 64 + lane) * 4) = o; } \
            const float rs = row_rstd(v); \
            norm_store_bf16(v, rs, w, p.xn + (size_t)(row) * D_MODEL, lane); \
        } else { \
            const float rs = row_rstd(v); \
            _Pragma("unroll") for (int i = 0; i < 8; ++i) { const f32x4 wv = *(const f32x4*)(w + (i * 64 + lane) * 4); \
                f32x4 o; o[0] = v[i][0] * rs * wv[0]; o[1] = v[i][1] * rs * wv[1]; o[2] = v[i][2] * rs * wv[2]; o[3] = v[i][3] * rs * wv[3]; \
                *(f32x4*)(p.out + (size_t)(row) * D_MODEL + (i * 64 + lane) * 4) = o; } } } while (0)
    const int rstep = gridDim.x * 8;
    for (int row = blockIdx.x * 8 + wid; row < T_TOK; row += 4 * rstep) {
        int rw[4]; bool hv[4]; int sa[4], sb[4];
#pragma unroll
        for (int q = 0; q < 4; ++q) { const int rq = row + q * rstep; hv[q] = rq < T_TOK; rw[q] = hv[q] ? rq : row; sa[q] = p.slot_ref[rw[q] * 2]; sb[q] = p.slot_ref[rw[q] * 2 + 1]; }
        u32x2 hraw[4][8];
#pragma unroll
        for (int q = 0; q < 4; ++q)
#pragma unroll
            for (int i = 0; i < 8; ++i) hraw[q][i] = *(const u32x2*)(hold + (size_t)rw[q] * D_MODEL + (i * 64 + lane) * 4);
        int ya[4], yb[4];
#pragma unroll
        for (int q = 0; q < 4; ++q) { ya[q] = tb->rbase[sa[q] >> 16] + (sa[q] & 0xffff); yb[q] = tb->rbase[sb[q] >> 16] + (sb[q] & 0xffff); }
        u32x2 y0[4][8], y1[4][8];
#pragma unroll
        for (int q = 0; q < 4; ++q)
#pragma unroll
            for (int i = 0; i < 8; ++i) { y0[q][i] = *(const u32x2*)(p.ybuf + (size_t)ya[q] * D_MODEL + (i * 64 + lane) * 4); y1[q][i] = *(const u32x2*)(p.ybuf + (size_t)yb[q] * D_MODEL + (i * 64 + lane) * 4); }
#pragma unroll
        for (int q = 0; q < 4; ++q) { if (!hv[q]) continue; f32x4 v[8];
#pragma unroll
            for (int i = 0; i < 8; ++i) {
                v[i][0] = __uint_as_float(hraw[q][i].x << 16) + __uint_as_float(y0[q][i].x << 16) + __uint_as_float(y1[q][i].x << 16);
                v[i][1] = __uint_as_float(hraw[q][i].x & 0xffff0000u) + __uint_as_float(y0[q][i].x & 0xffff0000u) + __uint_as_float(y1[q][i].x & 0xffff0000u);
                v[i][2] = __uint_as_float(hraw[q][i].y << 16) + __uint_as_float(y0[q][i].y << 16) + __uint_as_float(y1[q][i].y << 16);
                v[i][3] = __uint_as_float(hraw[q][i].y & 0xffff0000u) + __uint_as_float(y0[q][i].y & 0xffff0000u) + __uint_as_float(y1[q][i].y & 0xffff0000u); }
            CB_FIN(rw[q], v); }
    }
#undef CB_FIN
    __syncthreads();
}

#define GEMM_LDS_OFF 1024
#ifdef PROBE_QKV_GT
__device__ __forceinline__ void phase_qkv(CParams& p, char* lds) {
    for (int u = blockIdx.x; u < 32 * 48; u += gridDim.x) { const int mt = u & 31, nt = u >> 5;
        gemm_tile(ARows{p.xn, D_MODEL, mt * 256, T_TOK}, BBf16T{p.wt_a_in, D_MODEL, nt * 128}, EpBf16{p.qkv, A_IN, mt * 256, nt * 128, T_TOK, A_IN}, D_MODEL, lds + GEMM_LDS_OFF, 0xFu); }
}
#else
__device__ __forceinline__ void phase_qkv(CParams& p, char* lds) {
    int it = 0; const int myslot = blockIdx.x & 3;
    for (int u = wgid_v(lds); u < 32 * 24; u += gridDim.x, ++it) { int pm, pn; g8_order_c(u, 32, 24, pm, pn);
        if (CONV_MODE == 1 && it == myslot) moe_convert<1>(p, 0, 16, lds);
        unsigned ao[2][2], bo[2]; g8_offsets2(ao[0], pm * 256, D_MODEL); ao[1][0] = ao[1][1] = 0u; g8_offsets2_perm(bo, pn * 256, D_MODEL);
        gemm8_unit<false>(p.xn, ao, D_MODEL, p.wt_a_in, bo, D_MODEL, lds + GEMM_LDS_OFF, E8Bf16{p.qkv, A_IN, pm * 256, pn * 256, A_IN}, true); }
    if (CONV_MODE == 1 && myslot >= it) moe_convert<1>(p, 0, 16, lds);
}
#endif
template <bool RB>
__device__ __forceinline__ void phase_oproj(CParams& p, const bf16_t* wt, const void* res, bf16_t* hout, char* lds) {
    for (int u = wgid_v(lds); u < 32 * 8; u += gridDim.x) { int pm, pn; g8_order_c(u, 32, 8, pm, pn);
        unsigned ao[2][2], bo[2]; g8_offsets2(ao[0], pm * 256, D_MODEL); ao[1][0] = ao[1][1] = 0u; g8_offsets2_perm(bo, pn * 256, D_MODEL);
        gemm8_unit<false>(p.attn_o, ao, D_MODEL, wt, bo, D_MODEL, lds + GEMM_LDS_OFF, E8ResBf16<RB>{hout, res, pm * 256, pn * 256}, true); }
}
__device__ __forceinline__ void phase_proj(CParams& p, char* lds) {
    int it = 0; const int myslot = blockIdx.x & 3;
    for (int u = wgid_v(lds); u < 32 * 21; u += gridDim.x, ++it) { int pm, pn; g8_order_c(u, 32, 21, pm, pn);
        if (CONV_MODE == 1 && it == myslot) moe_convert<1>(p, 32, 43, lds);
        unsigned ao[2][2], bo[2]; g8_offsets2(ao[0], pm * 256, D_MODEL); ao[1][0] = ao[1][1] = 0u; g8_offsets2_perm(bo, pn * 256, D_MODEL);
        gemm8_unit<false>(p.xn, ao, D_MODEL, p.wt_b_in, bo, D_MODEL, lds + GEMM_LDS_OFF, E8Proj{p.qkv, p.gate, pm * 256, pn * 256}, true); }
    if (CONV_MODE == 1 && myslot >= it) moe_convert<1>(p, 32, 43, lds);
    __syncthreads();
    { const int tid = tidx();
      for (int w = (int)gridDim.x - 1 - wgid_v(lds); w < 64; w += gridDim.x) {
        const int o = tid & 7, ks = tid >> 3, out = w * 8 + o, t = out >> 8, n = out & 255;
        const float* pe = p.b_cmp_pos + (size_t)t * 4096; const float* w1 = p.b_cmp_w1 + (size_t)t * 4096 * 256 + n;
        float s = 0.f;
        for (int k = ks; k < 4096; k += 64) s += pe[k] * w1[(size_t)k * 256];
        float* red = (float*)lds; red[tid] = s; __syncthreads();
        if (tid < 8) { float a = 0.f; for (int i = 0; i < 64; ++i) a += red[i * 8 + tid]; p.cbias[w * 8 + tid] = a; }
        __syncthreads();
      } }
}
__device__ __forceinline__ void phase_cmp1(CParams& p, char* lds) {
    for (int u = blockIdx.x; u < 256; u += gridDim.x) { const int sp = u >> 5, t = (u >> 4) & 1, mt = (u >> 1) & 7, nt = u & 1;
        gemm_tile<true>(ACompress{p.qkv, 2048 + t * 512, mt * 256, sp * 512}, BPlain{p.b_cmp_w1 + ((size_t)t * 4096 + sp * 512) * 256, 256, nt * 128, 256},
                  EpF32{p.cslab + ((size_t)sp * 2 + t) * 2048 * 256, 256, mt * 256, nt * 128}, 512, lds + GEMM_LDS_OFF, 0xFu); }
}
__device__ __forceinline__ void phase_cmp_reduce(CParams& p) {
    for (int i = blockIdx.x * NTHREADS + tidx(); i < 2 * 2048 * 256 / 4; i += gridDim.x * NTHREADS) {
        const int c = (i & 63) * 4, t = i >> 17; f32x4 s = *(const f32x4*)(p.cbias + t * 256 + c);
#pragma unroll
        for (int sp = 0; sp < 8; ++sp) s += *(const f32x4*)(p.cslab + (size_t)sp * 2 * 2048 * 256 + (size_t)i * 4);
        u32x2 w; w.x = cvtpk(gelu_tanh(s[0]), gelu_tanh(s[1])); w.y = cvtpk(gelu_tanh(s[2]), gelu_tanh(s[3]));
        *(u32x2*)(p.chid + (size_t)i * 4) = w; }
}
__device__ __forceinline__ void phase_cmp2(CParams& p, char* lds) {
    for (int u = blockIdx.x; u < 16; u += gridDim.x) { const int t = u >> 3, mt = u & 7;
        gemm_tile<true>(ARows{p.chid + (size_t)t * 2048 * 256, 256, mt * 256, 2048}, BPlain{p.b_cmp_w2 + (size_t)t * 256 * 128, 128, 0, 128},
                  EpBf16{p.kvcmp + (size_t)t * 2048 * 128, 128, mt * 256, 0, 2048, 128}, 256, lds + GEMM_LDS_OFF, 0xFu); }
}
__device__ __forceinline__ int moe_first_unit() { const int w = blockIdx.x; return gridDim.x == 256 ? 32 * (w & 7) + (w >> 3) : w; }
__device__ __forceinline__ bool moe_decode(const MoeTab* tb, int u, int& e, int& mt, int& nt) {
    if (u >= tb->ustart[32]) return false;
    e = 0;
#pragma unroll 1
    for (int i = 1; i < 32; ++i) if (u >= tb->ustart[i]) e = i;
    const int loc = u - tb->ustart[e], tiles = (tb->cnt[e] + 255) >> 8;
    nt = loc / tiles; mt = loc - nt * tiles; return true;
}
__device__ __forceinline__ unsigned moe_rowmask(int cnt, int mt) { const int rem = cnt - mt * 256; return rem >= 193 ? 0xFu : rem >= 129 ? 0x7u : rem >= 65 ? 0x3u : 0x1u; }
__device__ __forceinline__ bool moe_decode8(const MoeTab* tb, int u, int& e, int& mt, int& nt);
#define SCAL(v) __builtin_amdgcn_readfirstlane((int)(v))
__device__ __forceinline__ bool moe_decode8(const MoeTab* tb, int u, int& e, int& mt, int& nt);
__device__ __forceinline__ unsigned moe_rowmask(int cnt, int mt);
struct UpUnits { typedef BGateUp256 BFT; typedef EpSiluMul256 EPT; static constexpr size_t LDB = D_EXPERT;
    CParams& p; const MoeTab* tb; int layer; int u, G, nfull; AGather af; BGateUp256 bf; EpSiluMul256 ep; unsigned rowmask;
    __device__ __forceinline__ bool load() { if (u >= nfull) return false; int e, mt, nt; moe_decode8(tb, u, e, mt, nt); e = SCAL(e); mt = SCAL(mt); nt = SCAL(nt);
        const size_t wo = ((size_t)layer * N_EXPERTS + e) * D_MODEL * D_EXPERT; const int cnt = SCAL(tb->cnt[e]), rb = SCAL(tb->rbase[e]);
        af = AGather{p.xn, D_MODEL, p.list_tok + e * LIST_CAP, mt * 256, cnt}; bf = BGateUp256{p.moe_w_gate + wo, (long long)(p.moe_w_up - p.moe_w_gate), D_EXPERT, nt * 128};
        ep = EpSiluMul256{p.hmid, rb + mt * 256, nt * 128}; rowmask = moe_rowmask(cnt, mt); return true; }
    __device__ __forceinline__ bool first() { return load(); }
    __device__ __forceinline__ bool next() { u += G; return load(); }
};
struct DownUnits { typedef BPlain256 BFT; typedef EpScaleRow256 EPT; static constexpr size_t LDB = D_MODEL;
    CParams& p; const MoeTab* tb; int layer; int u, G, nfull; ARows af; BPlain256 bf; EpScaleRow256 ep; unsigned rowmask;
    __device__ __forceinline__ bool load() { if (u >= nfull) return false; int e, mt, nt; moe_decode8(tb, u, e, mt, nt); e = SCAL(e); mt = SCAL(mt); nt = SCAL(nt);
        const size_t wo = ((size_t)layer * N_EXPERTS + e) * D_EXPERT * D_MODEL; const int cnt = SCAL(tb->cnt[e]), rb = SCAL(tb->rbase[e]), r0 = rb + mt * 256;
        af = ARows{p.hmid, D_EXPERT, r0, rb + cnt}; bf = BPlain256{p.moe_w_down + wo, D_MODEL, nt * 256};
        ep = EpScaleRow256{p.ybuf, p.list_w + e * LIST_CAP, mt * 256, cnt, r0, nt * 256}; rowmask = moe_rowmask(cnt, mt); return true; }
    __device__ __forceinline__ bool first() { return load(); }
    __device__ __forceinline__ bool next() { u += G; return load(); }
};
#define SCAL3(a, b, c) do { a = SCAL(a); b = SCAL(b); c = SCAL(c); } while (0)
template <int PROBE = 0>
__device__ __forceinline__ void phase_moe_up_direct(CParams& p, const int layer, char* lds) {
    MoeTab* tb = (MoeTab*)lds; moe_tables(p.cnt + layer * 32, tb);
    const int T = tb->ustart[32] / 2, G = gridDim.x, nfull = (2 * (T % G) > G) ? T : (T / G) * G;
    bf16_t* const hout = PROBE ? (bf16_t*)p.wgu_t : p.hmid;
    int e, mt, nt;
    if (PROBE == 0) { UpUnits un{p, tb, layer, wgid_v(lds), G, nfull, AGather{}, BGateUp256{}, EpSiluMul256{}, 0u}; gemm_tile256_seq(un, D_MODEL, lds + GEMM_LDS_OFF); }
    else
    for (int u = wgid_v(lds); u < nfull; u += G) { moe_decode8(tb, u, e, mt, nt); SCAL3(e, mt, nt);
        const int eb = PROBE >= 2 ? 0 : e, ntb = PROBE >= 2 ? 0 : nt, ea = PROBE >= 3 ? 0 : e, mta = PROBE >= 3 ? 0 : mt;
        const size_t wo = ((size_t)layer * N_EXPERTS + eb) * D_MODEL * D_EXPERT; const int cnt = SCAL(tb->cnt[e]), rb = SCAL(tb->rbase[e]);
        gemm_tile256(AGather{p.xn, D_MODEL, p.list_tok + ea * LIST_CAP, mta * 256, PROBE >= 3 ? 256 : cnt}, BGateUp256{p.moe_w_gate + wo, (long long)(p.moe_w_up - p.moe_w_gate), D_EXPERT, ntb * 128},
                     EpSiluMul256{hout, rb + mt * 256, nt * 128}, D_MODEL, lds + GEMM_LDS_OFF, moe_rowmask(cnt, mt)); }
    for (int j = wgid_v(lds); j < 2 * (T - nfull); j += G) { moe_decode8(tb, nfull + (j >> 1), e, mt, nt); const int n2 = 2 * nt + (j & 1);
        const int eb = PROBE >= 2 ? 0 : e, n2b = PROBE >= 2 ? 0 : n2, ea = PROBE >= 3 ? 0 : e, mta = PROBE >= 3 ? 0 : mt;
        const size_t wo = ((size_t)layer * N_EXPERTS + eb) * D_MODEL * D_EXPERT; const int cnt = tb->cnt[e];
        gemm_tile(AGather{p.xn, D_MODEL, p.list_tok + ea * LIST_CAP, mta * 256, PROBE >= 3 ? 256 : cnt}, BGateUp{p.moe_w_gate + wo, (long long)(p.moe_w_up - p.moe_w_gate), D_EXPERT, n2b * 64},
                  EpSiluMul{hout, tb->rbase[e] + mt * 256, n2 * 64}, D_MODEL, lds + GEMM_LDS_OFF, moe_rowmask(cnt, mt)); }
    __syncthreads();
}
__device__ __forceinline__ void phase_moe_down_direct(CParams& p, const int layer, char* lds) {
    MoeTab* tb = (MoeTab*)lds; (void)layer;
    const int T = tb->ustart[32] / 2, G = gridDim.x, nfull = (2 * (T % G) > G) ? T : (T / G) * G;
    int e, mt, nt;
    { DownUnits un{p, tb, layer, wgid_v(lds), G, nfull, ARows{}, BPlain256{}, EpScaleRow256{}, 0u}; gemm_tile256_seq(un, D_EXPERT, lds + GEMM_LDS_OFF); }
    for (int j = wgid_v(lds); j < 2 * (T - nfull); j += G) { moe_decode8(tb, nfull + (j >> 1), e, mt, nt); const int n2 = 2 * nt + (j & 1);
        const size_t wo = ((size_t)layer * N_EXPERTS + e) * D_EXPERT * D_MODEL; const int cnt = tb->cnt[e], r0 = tb->rbase[e] + mt * 256;
        gemm_tile(ARows{p.hmid, D_EXPERT, r0, tb->rbase[e] + cnt}, BPlain{p.moe_w_down + wo, D_MODEL, n2 * 128, D_MODEL},
                  EpScaleRow{p.ybuf, p.list_w + e * LIST_CAP, mt * 256, cnt, r0, n2 * 128}, D_EXPERT, lds + GEMM_LDS_OFF, moe_rowmask(cnt, mt)); }
    __syncthreads();
}
__device__ __forceinline__ bool moe_decode8(const MoeTab* tb, int u, int& e, int& mt, int& nt) {
    if (2 * u >= tb->ustart[32]) return false;
    { const int l = tidx() & 63; const int us = tb->ustart[l < 32 ? l : 32];
      const unsigned long long m = __ballot(l < 32 && 2 * u >= us);
      e = 63 - __builtin_clzll(m); }
    const int loc = u - tb->ustart[e] / 2, tiles = (tb->cnt[e] + 255) >> 8;
    nt = loc / tiles; mt = loc - nt * tiles; return true;
}
__device__ __forceinline__ void phase_moe_up(CParams& p, const int layer, char* lds) {
    MoeTab* tb = (MoeTab*)lds; moe_tables(p.cnt + layer * 32, tb);
    int e, mt, nt; int it = 0; const int myslot = blockIdx.x & 1;
    for (int u = blockIdx.x; moe_decode8(tb, u, e, mt, nt); u += gridDim.x, ++it) {
        if (CONV_MODE == 1 && it == myslot) moe_convert<2>(p, layer * 32, layer * 32 + 32, lds + 1024);
        const int cnt = tb->cnt[e]; const int* list = p.list_tok + e * LIST_CAP;
        unsigned ao[2][2], bo[2];
        { const int tid = tidx();
#pragma unroll
          for (int i = 0; i < 2; ++i) { int R, C; stage_rc(tid * 16 + i * 8192, R, C);
#pragma unroll
              for (int h = 0; h < 2; ++h) { const int g = mt * 256 + h * 128 + R; const int tok = g < cnt ? list[g] : 0; ao[h][i] = (unsigned)(tok * D_MODEL + C); } } }
        g8_offsets2(bo, nt * 256, D_MODEL);
        gemm8_unit<true>(p.xn, ao, D_MODEL, p.wgu_t + (size_t)(layer * N_EXPERTS + e) * 2048 * 2048, bo, D_MODEL, lds + GEMM_LDS_OFF,
                   E8SiluMul{p.hmid, tb->rbase[e] + mt * 256, nt * 128}, cnt - mt * 256 > 128); }
    if (CONV_MODE == 1 && myslot >= it) moe_convert<2>(p, layer * 32, layer * 32 + 32, lds + 1024);
    __syncthreads();
}
__device__ __forceinline__ void phase_moe_down(CParams& p, const int layer, char* lds) {
    MoeTab* tb = (MoeTab*)lds; moe_tables(p.cnt + layer * 32, tb);
    int e, mt, nt;
    for (int u = blockIdx.x; moe_decode8(tb, u, e, mt, nt); u += gridDim.x) {
        const int cnt = tb->cnt[e], r0 = tb->rbase[e] + mt * 256;
        unsigned ao[2][2], bo[2]; g8_offsets2(ao[0], r0, D_EXPERT); ao[1][0] = ao[1][1] = 0u; g8_offsets2(bo, nt * 256, D_EXPERT);
        gemm8_unit<false>(p.hmid, ao, D_EXPERT, p.wd_t + (size_t)(layer * N_EXPERTS + e) * 2048 * 1024, bo, D_EXPERT, lds + GEMM_LDS_OFF,
                   E8ScaleRow{p.ybuf, p.list_w + e * LIST_CAP, mt * 256, cnt, r0, nt * 256}, cnt - mt * 256 > 128); }
    __syncthreads();
}

#define NPHASE 18
template <int PH> __device__ __forceinline__ void run_phase(CParams& p, char* lds) {
    if (PH == 0) phase_first(p, lds);
    if (PH == 1) phase_qkv(p, lds);
    if (PH == 2) phase_diff_attn(p, lds);
    if (PH == 3) phase_oproj<false>(p, p.wt_a_out, p.x, p.h1, lds);
    if (PH == 4) phase_norm_route(p, p.h1, 0, lds);
    if (PH == 5) { if (MOE_G8) phase_moe_up(p, 0, lds); else phase_moe_up_direct(p, 0, lds); }
    if (PH == 6) { if (MOE_G8) phase_moe_down(p, 0, lds); else phase_moe_down_direct(p, 0, lds); }
    if (PH == 7) phase_combine<0>(p, p.h1, p.h2, p.attn_norm_w + D_MODEL, 0, lds);
    if (PH == 8) phase_proj(p, lds);
    if (PH == 9) phase_cmp1(p, lds);
    if (PH == 10) phase_cmp_reduce(p);
    if (PH == 11) phase_cmp2(p, lds);
    if (PH == 12) phase_nsa(p, lds);
    if (PH == 13) phase_oproj<true>(p, p.wt_b_out, p.h2, p.h1, lds);
    if (PH == 14) phase_norm_route(p, p.h1, 1, lds);
    if (PH == 15) { if (MOE_G8) phase_moe_up(p, 1, lds); else phase_moe_up_direct(p, 1, lds); }
    if (PH == 16) { if (MOE_G8) phase_moe_down(p, 1, lds); else phase_moe_down_direct(p, 1, lds); }
    if (PH == 17) phase_combine<1>(p, p.h1, nullptr, p.final_norm_w, 1, lds);
}
#if defined(ONLY_PH)
#define PHASE(PH) do { if (PH == ONLY_PH) { CParams* q_ = kp; asm volatile("" : "+s"(q_)); run_phase<PH>(*q_, lds); } } while (0)
#elif N_LAUNCH_MODE == 1
#ifndef DUP_MASK
#define DUP_MASK 0
#endif
#define PHASE(PH) do { { CParams* q_ = kp; asm volatile("" : "+s"(q_)); run_phase<PH>(*q_, lds); } \
        if ((DUP_MASK >> PH) & 1) { xcd_barrier(bar); CParams* q_ = kp; asm volatile("" : "+s"(q_)); run_phase<PH>(*q_, lds); } \
        if (PH + 1 < NPHASE) xcd_barrier(bar); } while (0)
#else
#define PHASE(PH) do { if (kp->phase_lo == PH) { CParams* q_ = kp; asm volatile("" : "+s"(q_)); run_phase<PH>(*q_, lds); } } while (0)
#endif
__global__ void __launch_bounds__(NTHREADS, 2) fwd_kernel(Params p_unused) {
    extern __shared__ __attribute__((aligned(16))) char lds[];
    CParams* kp = (CParams*)__builtin_amdgcn_kernarg_segment_ptr();
    if (threadIdx.x == 0) *(uint4*)(lds + LDS_BYTES - 16) = make_uint4(0u, 0u, 0u, 0u);
    __syncthreads();
    XcdBarrier bar = xcd_barrier_post(kp->bar, (volatile LAS unsigned*)(lds + LDS_BYTES - 16));
    (void)bar;
    PHASE(0);
#if N_LAUNCH_MODE == 1 && !defined(ONLY_PH)
    { volatile LAS unsigned* st_ = (volatile LAS unsigned*)(lds + LDS_BYTES - 16);
      if (threadIdx.x == 0) { unsigned base_ = 0u;
          _Pragma("unroll") for (unsigned j = 0; j < 16; ++j) { const unsigned c_ = xb_ld(&bar.bar[XB_XCNT(j)]); base_ += j < bar.x ? c_ : 0u; }
          st_[2] = base_ + bar.rank; }
      __syncthreads(); }
#endif
    PHASE(1); PHASE(2); PHASE(3); PHASE(4); PHASE(5);
#if defined(PROBE_UP) && N_LAUNCH_MODE == 1 && !defined(ONLY_PH)
    { CParams* q_ = kp; asm volatile("" : "+s"(q_)); phase_moe_up_direct<PROBE_UP>(*q_, 0, lds); xcd_barrier(bar); }
#endif
    PHASE(6); PHASE(7); PHASE(8);
    PHASE(9); PHASE(10); PHASE(11); PHASE(12); PHASE(13); PHASE(14); PHASE(15); PHASE(16); PHASE(17);
}

static inline size_t al256(size_t v) { return (v + 255) & ~(size_t)255; }
extern "C" void kernel_launch(void* const* d_in, const int* in_sizes, int n_in, void* d_out, int out_size, void* d_ws, size_t ws_size, hipStream_t stream) {
    (void)in_sizes; (void)n_in; (void)out_size; (void)ws_size;
    Params p; memset(&p, 0, sizeof(p));
    p.x = (const float*)d_in[0]; p.attn_norm_w = (const float*)d_in[1]; p.ffn_norm_w = (const float*)d_in[2]; p.final_norm_w = (const float*)d_in[3];
    p.a_w_in = (const float*)d_in[4]; p.a_lambda = (const float*)d_in[5]; p.a_subln_w = (const float*)d_in[6]; p.a_w_out = (const float*)d_in[7];
    p.b_w_in = (const float*)d_in[8]; p.b_cmp_pos = (const float*)d_in[9]; p.b_cmp_w1 = (const float*)d_in[10]; p.b_cmp_w2 = (const float*)d_in[11]; p.b_w_out = (const float*)d_in[12];
    p.moe_w_group = (const float*)d_in[13]; p.moe_b_group = (const float*)d_in[14]; p.moe_w_expert = (const float*)d_in[15]; p.moe_b_expert = (const float*)d_in[16];
    p.moe_w_gate = (const float*)d_in[17]; p.moe_w_up = (const float*)d_in[18]; p.moe_w_down = (const float*)d_in[19];
    p.out = (float*)d_out;
    char* w = (char*)d_ws; size_t off = 0;
#define CARVE(ptr, type, bytes) do { ptr = (type)(w + off); off = al256(off + (size_t)(bytes)); } while (0)
    CARVE(p.bar, unsigned*, XCD_BAR_WORDS * 4);
    CARVE(p.cnt, unsigned*, 128 * 4);
    CARVE(p.rw_hi, bf16_t*, (size_t)2 * 64 * D_MODEL * 2);
    CARVE(p.rw_lo, bf16_t*, (size_t)2 * 64 * D_MODEL * 2);
    CARVE(p.diag, unsigned*, 256 * 4);
    CARVE(p.xn, bf16_t*, (size_t)T_TOK * D_MODEL * 2);
    CARVE(p.qkv, bf16_t*, (size_t)T_TOK * A_IN * 2);
    CARVE(p.gate, float*, (size_t)T_TOK * 48 * 4);
    CARVE(p.attn_o, bf16_t*, (size_t)T_TOK * D_MODEL * 2);
    CARVE(p.h1, bf16_t*, (size_t)T_TOK * D_MODEL * 2);
    CARVE(p.h2, bf16_t*, (size_t)T_TOK * D_MODEL * 2);
    CARVE(p.hmid, bf16_t*, (size_t)MAX_ROWS * D_EXPERT * 2);
    CARVE(p.ybuf, bf16_t*, (size_t)MAX_ROWS * D_MODEL * 2);
    CARVE(p.list_tok, int*, (size_t)32 * LIST_CAP * 4);
    CARVE(p.list_w, float*, (size_t)32 * LIST_CAP * 4);
    CARVE(p.slot_ref, int*, (size_t)T_TOK * 2 * 4);
    CARVE(p.cbias, float*, 512 * 4);
    CARVE(p.cslab, float*, (size_t)8 * 2 * 2048 * 256 * 4);
    CARVE(p.chid, bf16_t*, (size_t)2 * 2048 * 256 * 2);
    CARVE(p.kvcmp, bf16_t*, (size_t)2 * 2048 * 128 * 2);
    CARVE(p.wt_a_in, bf16_t*, (size_t)A_IN * D_MODEL * 2);
    CARVE(p.wt_a_out, bf16_t*, (size_t)D_MODEL * D_MODEL * 2);
    CARVE(p.wt_b_in, bf16_t*, (size_t)5376 * D_MODEL * 2);
    CARVE(p.wt_b_out, bf16_t*, (size_t)D_MODEL * D_MODEL * 2);
    CARVE(p.wgu_t, bf16_t*, (size_t)64 * 2048 * 2048 * 2);
    CARVE(p.wd_t, bf16_t*, (size_t)64 * 2048 * 1024 * 2);
    static int grid = 0;
    if (!grid) {
        (void)hipFuncSetAttribute((const void*)fwd_kernel, hipFuncAttributeMaxDynamicSharedMemorySize, LDS_BYTES);
        int dev = 0, cus = 0, per_cu = 0;
        (void)hipGetDevice(&dev);
        if (hipDeviceGetAttribute(&cus, hipDeviceAttributeMultiprocessorCount, dev) != hipSuccess || cus <= 0) cus = 256;
        if (hipOccupancyMaxActiveBlocksPerMultiprocessor(&per_cu, (const void*)fwd_kernel, NTHREADS, LDS_BYTES) != hipSuccess || per_cu < 1) per_cu = 1;
        grid = cus * 1;
        if (grid > 256) grid = 256;
    }
    (void)hipMemsetAsync(p.bar, 0, XCD_BAR_WORDS * 4, stream);
#if N_LAUNCH_MODE == 1
    p.phase_lo = 0; p.phase_hi = NPHASE;
    hipLaunchKernelGGL(fwd_kernel, dim3(grid), dim3(NTHREADS), LDS_BYTES, stream, p);
#else
    for (int ph = 0; ph < NPHASE; ++ph) { p.phase_lo = ph; p.phase_hi = ph + 1; hipLaunchKernelGGL(fwd_kernel, dim3(grid), dim3(NTHREADS), LDS_BYTES, stream, p); }
#endif
}
```
